# Optimizing an MI355X kernel written in HIP

```python
import math
import jax
import jax.numpy as jnp
from jax import lax
import numpy as np

D_MODEL = 1024
BATCH = 16
SEQ = 2048
DEPTH = 1

CTX_LEN = 256
GRID_W = 64

N_HEADS = 8
N_KV_HEADS = 2
GQA_GROUP = N_HEADS // N_KV_HEADS
HEAD_DIM = 64
WINDOW = 128
ATTN_BLOCK = 128
ROPE_BASE = 10000.0

HY_WIDTH = 512
HY_ORDER = 2
HY_SHORT_CONV = 3
HY_EMB_DIM = 33
HY_FILTER_HIDDEN = 64
HY_FILTER_OUT_SCALE = 0.05
HY_DECAY_TARGET = 1e-2
HY_FAST_DECAY_PCT = 0.3
HY_SLOW_DECAY_PCT = 1.5

N_BRANCHES = 2

N_EXPERTS = 32
TOP_K = 4
D_FF = 1024
SWIGLU_LIMIT = 7.0
SWIGLU_ALPHA = 1.702
EXPERT_BLOCK = 128

LN_EPS = 1e-5

Q_W = N_HEADS * HEAD_DIM
KV_W = N_KV_HEADS * HEAD_DIM
K_OFF = Q_W
V_OFF = K_OFF + KV_W
HY_OFF = V_OFF + KV_W
GATE_OFF = HY_OFF + (HY_ORDER + 1) * HY_WIDTH
IN_W = GATE_OFF + N_BRANCHES * D_MODEL

DEEPNORM_ALPHA = (2 * DEPTH) ** 0.25
DEEPNORM_BETA = (8 * DEPTH) ** -0.25

kernel_name = 'hybrid_swa_hyena_moe_diffusion_block'


def _layer_norm(x, g=None, b=None):
    xf = x.astype(jnp.float32)
    mu = jnp.mean(xf, axis=-1, keepdims=True)
    var = jnp.mean(jnp.square(xf - mu), axis=-1, keepdims=True)
    y = (xf - mu) * lax.rsqrt(var + LN_EPS)
    if g is not None:
        y = y * g.astype(jnp.float32) + b.astype(jnp.float32)
    return y.astype(x.dtype)


def _modulation(cond, w, b):
    return jax.nn.silu(cond) @ w + b


def _modulate(x, shift, scale):
    return _layer_norm(x) * (1 + scale) + shift


def _axial_rope_tables(rows):
    row = jnp.repeat(jnp.arange(rows, dtype=jnp.float32), GRID_W)
    col = jnp.tile(jnp.arange(GRID_W, dtype=jnp.float32), rows)
    n_freq = HEAD_DIM // 4
    inv_freq = ROPE_BASE ** (-jnp.arange(n_freq, dtype=jnp.float32) / n_freq)
    ang = jnp.stack([row[:, None] * inv_freq, col[:, None] * inv_freq], axis=1)
    return jnp.cos(ang), jnp.sin(ang)


def _apply_axial_rope(x, cos, sin):
    B_, L, H, _ = x.shape
    xr = x.astype(jnp.float32).reshape(B_, L, H, 2, 2, HEAD_DIM // 4)
    x1, x2 = xr[..., 0, :], xr[..., 1, :]
    c = cos[None, :, None]
    s = sin[None, :, None]
    out = jnp.stack([x1 * c - x2 * s, x2 * c + x1 * s], axis=-2)
    return out.reshape(x.shape).astype(x.dtype)


def _split_proj(p):
    return (p[..., :K_OFF], p[..., K_OFF:V_OFF], p[..., V_OFF:HY_OFF],
            p[..., HY_OFF:GATE_OFF], p[..., GATE_OFF:])


def _latent_window_attention(q, k, v, k_ctx, v_ctx, sink):
    B_, L = q.shape[:2]
    n_ctx = k_ctx.shape[1]
    n_blocks = L // ATTN_BLOCK
    span = ATTN_BLOCK + 2 * WINDOW
    pad = ((0, 0), (WINDOW, WINDOW), (0, 0), (0, 0))
    k_pad, v_pad = jnp.pad(k, pad), jnp.pad(v, pad)
    q_blocks = jnp.moveaxis(
        q.reshape(B_, n_blocks, ATTN_BLOCK, N_KV_HEADS, GQA_GROUP, HEAD_DIM), 1, 0)
    qi = jnp.arange(ATTN_BLOCK)[:, None]
    kj = jnp.arange(span)[None, :]
    band = jnp.abs(kj - WINDOW - qi) <= WINDOW
    sink_logit = sink.astype(jnp.float32).reshape(1, N_KV_HEADS, GQA_GROUP, 1, 1)
    scale = HEAD_DIM ** -0.5

    def one_block(args):
        b_idx, q_blk = args
        start = b_idx * ATTN_BLOCK
        k_blk = lax.dynamic_slice_in_dim(k_pad, start, span, axis=1)
        v_blk = lax.dynamic_slice_in_dim(v_pad, start, span, axis=1)
        key_pos = start - WINDOW + kj
        valid = band & (key_pos >= 0) & (key_pos < L)
        s_loc = jnp.einsum('bqhgd,bshd->bhgqs', q_blk, k_blk).astype(jnp.float32) * scale
        s_loc = jnp.where(valid, s_loc, -jnp.inf)
        s_c = jnp.einsum('bqhgd,bchd->bhgqc', q_blk, k_ctx).astype(jnp.float32) * scale
        s_sink = jnp.broadcast_to(sink_logit, s_loc.shape[:-1] + (1,))
        p = jax.nn.softmax(jnp.concatenate([s_loc, s_c, s_sink], axis=-1), axis=-1).astype(v.dtype)
        o = (jnp.einsum('bhgqs,bshd->bqhgd', p[..., :span], v_blk)
             + jnp.einsum('bhgqc,bchd->bqhgd', p[..., span:span + n_ctx], v_ctx))
        return o

    out = lax.map(one_block, (jnp.arange(n_blocks), q_blocks))
    return jnp.moveaxis(out, 0, 1).reshape(B_, L, Q_W)


def _context_attention(q, k, v, sink):
    B_, C = q.shape[:2]
    s = jnp.einsum('bqhgd,bshd->bhgqs', q, k).astype(jnp.float32) * HEAD_DIM ** -0.5
    sink_logit = sink.astype(jnp.float32).reshape(1, N_KV_HEADS, GQA_GROUP, 1, 1)
    s_sink = jnp.broadcast_to(sink_logit, s.shape[:-1] + (1,))
    p = jax.nn.softmax(jnp.concatenate([s, s_sink], axis=-1), axis=-1)[..., :-1].astype(v.dtype)
    return jnp.einsum('bhgqs,bshd->bqhgd', p, v).reshape(B_, C, Q_W)


def _short_conv(u, w, b):
    L = u.shape[1]
    half = HY_SHORT_CONV // 2
    up = jnp.pad(u, ((0, 0), (half, half), (0, 0)))
    out = b
    for i in range(HY_SHORT_CONV):
        out = out + up[:, i:i + L] * w[i]
    return out


def _hyena_filters(L, w1, b1, w2, b2, w3):
    bands = (HY_EMB_DIM - 1) // 2
    t = jnp.linspace(0.0, 1.0, L, dtype=jnp.float32)[:, None]
    omega = 2.0 * math.pi * jnp.arange(L, dtype=jnp.float32)[:, None] / L
    f = jnp.linspace(1e-4, bands - 1, bands, dtype=jnp.float32)[None, :]
    z = jnp.concatenate([t, jnp.cos(f * omega), -jnp.sin(f * omega)], axis=-1)
    h = jnp.sin(z @ w1 + b1)
    h = jnp.sin(h @ w2 + b2)
    h = (h @ w3).astype(jnp.float32).reshape(L, HY_ORDER, 2, HY_WIDTH)
    min_decay = math.log(HY_DECAY_TARGET) / HY_FAST_DECAY_PCT
    max_decay = math.log(HY_DECAY_TARGET) / HY_SLOW_DECAY_PCT
    deltas = jnp.abs(jnp.linspace(min_decay, max_decay, HY_WIDTH, dtype=jnp.float32))
    h = h * jnp.exp(-t * deltas)[:, None, None, :]
    fwd, bwd = h[:, :, 0], h[:, :, 1]
    return jnp.concatenate([fwd, jnp.zeros_like(fwd[:1]), bwd[:0:-1]], axis=0)


def _hyena(u, conv_w, conv_b, fw1, fb1, fw2, fb2, fw3, skip):
    L = u.shape[1]
    n_fft = 2 * L
    streams = jnp.split(_short_conv(u, conv_w, conv_b).astype(jnp.float32), HY_ORDER + 1, axis=-1)
    filt_f = jnp.fft.rfft(_hyena_filters(L, fw1, fb1, fw2, fb2, fw3), axis=0)
    z = streams[-1]
    for o in range(HY_ORDER):
        conv = jnp.fft.irfft(jnp.fft.rfft(z, n=n_fft, axis=1) * filt_f[None, :, o],
                             n=n_fft, axis=1)[:, :L]
        z = streams[o] * (conv + skip[o].astype(jnp.float32) * z)
    return z.astype(u.dtype)


def _merge_branches(att, hy, gate_pre, w_ba, w_bh, w_o):
    g_att, g_hy = jnp.split(jax.nn.sigmoid(gate_pre), N_BRANCHES, axis=-1)
    return (g_att * (att @ w_ba) + g_hy * (hy @ w_bh)) @ w_o


def _moe(h, router_w, router_b, w1, b1, w2, b2):
    B_, L, D = h.shape
    T = B_ * L
    xt = h.reshape(T, D)
    logits = (xt @ router_w + router_b).astype(jnp.float32)
    top_vals, top_idx = lax.top_k(logits, TOP_K)
    gate = jax.nn.softmax(top_vals, axis=-1)
    A = T * TOP_K
    expert_ids = top_idx.reshape(A).astype(jnp.int32)
    token_ids = (jnp.arange(A, dtype=jnp.int32) // TOP_K)
    weights = gate.reshape(A)
    order = jnp.argsort(expert_ids)
    e_sorted = expert_ids[order]
    counts = jnp.bincount(expert_ids, length=N_EXPERTS).astype(jnp.int32)
    starts = jnp.cumsum(counts) - counts
    padded = (counts + EXPERT_BLOCK - 1) // EXPERT_BLOCK * EXPERT_BLOCK
    pad_end = jnp.cumsum(padded)
    pad_start = pad_end - padded
    dest = pad_start[e_sorted] + (jnp.arange(A, dtype=jnp.int32) - starts[e_sorted])
    n_blocks = A // EXPERT_BLOCK + N_EXPERTS
    n_slots = n_blocks * EXPERT_BLOCK
    slot_tok = jnp.full((n_slots,), T, jnp.int32).at[dest].set(token_ids[order])
    slot_w = jnp.zeros((n_slots,), jnp.float32).at[dest].set(weights[order])
    block_start = jnp.arange(n_blocks, dtype=jnp.int32) * EXPERT_BLOCK
    block_exp = jnp.minimum(jnp.searchsorted(pad_end, block_start, side='right'), N_EXPERTS - 1)
    x_pad = jnp.concatenate([xt, jnp.zeros((1, D), xt.dtype)], axis=0)

    def step(acc, blk):
        tok, wt, e = blk
        hb = x_pad[tok] @ w1[e] + b1[e]
        glu, lin = jnp.split(hb.astype(jnp.float32), 2, axis=-1)
        glu = jnp.minimum(glu, SWIGLU_LIMIT)
        lin = jnp.clip(lin, -SWIGLU_LIMIT, SWIGLU_LIMIT)
        act = (glu * jax.nn.sigmoid(SWIGLU_ALPHA * glu) * (lin + 1.0)).astype(h.dtype)
        yb = (act @ w2[e] + b2[e]).astype(jnp.float32)
        return acc.at[tok].add(yb * wt[:, None]), None

    acc0 = jnp.zeros((T + 1, D), jnp.float32)
    acc, _ = lax.scan(step, acc0, (slot_tok.reshape(n_blocks, EXPERT_BLOCK),
                                   slot_w.reshape(n_blocks, EXPERT_BLOCK), block_exp))
    return acc[:T].reshape(B_, L, D).astype(h.dtype)


def setup_inputs(seed: int = 0) -> dict:
    key = jax.random.key(seed)
    ks = jax.random.split(key, 32)
    D = D_MODEL
    hy_in = (HY_ORDER + 1) * HY_WIDTH
    filt_out = HY_ORDER * 2 * HY_WIDTH

    def nrm(k, shape, s):
        return jax.random.normal(k, shape, jnp.float32) * s

    return {
        'x': nrm(ks[0], (BATCH, SEQ, D), 1.0),
        'c': nrm(ks[1], (BATCH, D), 1.0),
        'ctx': nrm(ks[2], (BATCH, CTX_LEN, D), 1.0),
        'c_ctx': nrm(ks[3], (D,), 1.0),
        'w_mod': nrm(ks[4], (DEPTH, D, 6 * D), D ** -0.5),
        'b_mod': nrm(ks[5], (DEPTH, 6 * D), 0.02),
        'w_in': nrm(ks[6], (DEPTH, D, IN_W), D ** -0.5),
        'attn_sink': nrm(ks[7], (DEPTH, N_HEADS), 0.5),
        'hy_conv_w': nrm(ks[8], (DEPTH, HY_SHORT_CONV, hy_in), HY_SHORT_CONV ** -0.5),
        'hy_conv_b': nrm(ks[9], (DEPTH, hy_in), 0.02),
        'hy_filt_w1': nrm(ks[10], (DEPTH, HY_EMB_DIM, HY_FILTER_HIDDEN), HY_EMB_DIM ** -0.5),
        'hy_filt_b1': nrm(ks[11], (DEPTH, HY_FILTER_HIDDEN), 0.1),
        'hy_filt_w2': nrm(ks[12], (DEPTH, HY_FILTER_HIDDEN, HY_FILTER_HIDDEN), HY_FILTER_HIDDEN ** -0.5),
        'hy_filt_b2': nrm(ks[13], (DEPTH, HY_FILTER_HIDDEN), 0.1),
        'hy_filt_w3': nrm(ks[14], (DEPTH, HY_FILTER_HIDDEN, filt_out),
                          HY_FILTER_HIDDEN ** -0.5 * HY_FILTER_OUT_SCALE),
        'hy_skip': nrm(ks[15], (DEPTH, HY_ORDER, HY_WIDTH), 0.5),
        'w_branch_attn': nrm(ks[16], (DEPTH, Q_W, D), Q_W ** -0.5 * DEEPNORM_BETA),
        'w_branch_hyena': nrm(ks[17], (DEPTH, HY_WIDTH, D), HY_WIDTH ** -0.5 * DEEPNORM_BETA),
        'w_out': nrm(ks[18], (DEPTH, D, D), D ** -0.5 * DEEPNORM_BETA),
        'ln1_g': 1.0 + nrm(ks[19], (DEPTH, D), 0.02),
        'ln1_b': nrm(ks[20], (DEPTH, D), 0.02),
        'router_w': nrm(ks[21], (DEPTH, D, N_EXPERTS), D ** -0.5),
        'router_b': nrm(ks[22], (DEPTH, N_EXPERTS), 0.01),
        'exp_w1': nrm(ks[23], (DEPTH, N_EXPERTS, D, 2 * D_FF), D ** -0.5),
        'exp_b1': nrm(ks[24], (DEPTH, N_EXPERTS, 2 * D_FF), 0.02),
        'exp_w2': nrm(ks[25], (DEPTH, N_EXPERTS, D_FF, D), D_FF ** -0.5 * DEEPNORM_BETA),
        'exp_b2': nrm(ks[26], (DEPTH, N_EXPERTS, D), 0.02),
        'ln2_g': 1.0 + nrm(ks[27], (DEPTH, D), 0.02),
        'ln2_b': nrm(ks[28], (DEPTH, D), 0.02),
    }


def reference(x, c, ctx, c_ctx, w_mod, b_mod, w_in, attn_sink, hy_conv_w, hy_conv_b,
              hy_filt_w1, hy_filt_b1, hy_filt_w2, hy_filt_b2, hy_filt_w3, hy_skip,
              w_branch_attn, w_branch_hyena, w_out, ln1_g, ln1_b,
              router_w, router_b, exp_w1, exp_b1, exp_w2, exp_b2, ln2_g, ln2_b):
    B_, L, _ = x.shape
    C = ctx.shape[1]
    rows = L // GRID_W
    cos, sin = _axial_rope_tables(rows)
    s_ctx = ctx
    for l in range(DEPTH):
        w_in_l = w_in[l]
        filt = (hy_filt_w1[l], hy_filt_b1[l], hy_filt_w2[l], hy_filt_b2[l], hy_filt_w3[l])
        mod_x = _modulation(c, w_mod[l], b_mod[l])[:, None, :]
        mod_c = _modulation(c_ctx[None], w_mod[l], b_mod[l])[:, None, :]
        sh1, sc1, g1, sh2, sc2, g2 = jnp.split(mod_x, 6, axis=-1)
        csh1, csc1, cg1, csh2, csc2, cg2 = jnp.split(mod_c, 6, axis=-1)
        last = l + 1 == DEPTH

        hc = _modulate(s_ctx, csh1, csc1)
        if last:
            kv_c = hc @ w_in_l[:, K_OFF:HY_OFF]
            k_c, v_c = kv_c[..., :KV_W], kv_c[..., KV_W:]
        else:
            q_c, k_c, v_c, u_hy_c, gate_c = _split_proj(hc @ w_in_l)
        k_c = k_c.reshape(B_, C, N_KV_HEADS, HEAD_DIM)
        v_c = v_c.reshape(B_, C, N_KV_HEADS, HEAD_DIM)

        hx = _modulate(x, sh1, sc1)
        q, k, v, u_hy, gate_x = _split_proj(hx @ w_in_l)
        q = _apply_axial_rope(q.reshape(B_, L, N_HEADS, HEAD_DIM), cos, sin)
        q = q.reshape(B_, L, N_KV_HEADS, GQA_GROUP, HEAD_DIM)
        k = _apply_axial_rope(k.reshape(B_, L, N_KV_HEADS, HEAD_DIM), cos, sin)
        v = v.reshape(B_, L, N_KV_HEADS, HEAD_DIM)
        att = _latent_window_attention(q, k, v, k_c, v_c, attn_sink[l])
        hy = _hyena(u_hy, hy_conv_w[l], hy_conv_b[l], *filt, hy_skip[l])
        y = _merge_branches(att, hy, gate_x, w_branch_attn[l], w_branch_hyena[l], w_out[l])
        x_mid = _layer_norm(DEEPNORM_ALPHA * x + g1 * y, ln1_g[l], ln1_b[l])

        if not last:
            q_c = q_c.reshape(B_, C, N_KV_HEADS, GQA_GROUP, HEAD_DIM)
            att_c = _context_attention(q_c, k_c, v_c, attn_sink[l])
            hy_c = _hyena(u_hy_c, hy_conv_w[l], hy_conv_b[l], *filt, hy_skip[l])
            y_c = _merge_branches(att_c, hy_c, gate_c, w_branch_attn[l], w_branch_hyena[l], w_out[l])
            c_mid = _layer_norm(DEEPNORM_ALPHA * s_ctx + cg1 * y_c, ln1_g[l], ln1_b[l])
            f_c = _moe(_modulate(c_mid, csh2, csc2), router_w[l], router_b[l],
                       exp_w1[l], exp_b1[l], exp_w2[l], exp_b2[l])
            s_ctx = _layer_norm(DEEPNORM_ALPHA * c_mid + cg2 * f_c, ln2_g[l], ln2_b[l])

        f_x = _moe(_modulate(x_mid, sh2, sc2), router_w[l], router_b[l],
                   exp_w1[l], exp_b1[l], exp_w2[l], exp_b2[l])
        x = _layer_norm(DEEPNORM_ALPHA * x_mid + g2 * f_x, ln2_g[l], ln2_b[l])
    return x
```

```cpp
#include <hip/hip_runtime.h>
#include <cstdio>
#define MK_N_LAUNCHES 10
#include <cstdint>
#include <cmath>
namespace pg8 {
#define PG8_LAS __attribute__((address_space(3)))
typedef unsigned short bf16_t;
typedef short bf16x8 __attribute__((ext_vector_type(8)));
typedef float f32x4 __attribute__((ext_vector_type(4)));
typedef unsigned u32x4 __attribute__((ext_vector_type(4)));
constexpr int BM = 256, BK = 64, HALF = 128, HTB = HALF * BK * 2  , STAGE_BYTES = 8 * HTB, NXCD = 8, WGM = 8;

__host__ __device__ __forceinline__ int lds_byte(int r, int c) { const int st = (r >> 4) * 2 + (c >> 5), rr = r & 15, cc = c & 31, ob = rr * 64 + cc * 2; return st * 1024 + (ob ^ (((ob >> 9) & 1) << 5)); }
__host__ __device__ __forceinline__ void stage_rc(int b, int& R, int& C) { const int st = b / 1024, sb = b % 1024, swz = sb ^ (((sb >> 9) & 1) << 5); R = (st >> 1) * 16 + swz / 64; C = (st & 1) * 32 + (swz % 64) / 2; }
__host__ __device__ __forceinline__ int perm32(int rho) { const int n = rho >> 4, i = rho & 15; return 8 * (i >> 2) + 4 * n + (i & 3); }

struct Unit { int pm, pn; };
struct Gemm { const bf16_t* A; const bf16_t* Bt; int K; };

struct StaticOrder {
    int nM, nN, nwg, G, c;
    __host__ __device__ void init(int nM_, int nN_, int G_, int c_) { nM = nM_; nN = nN_; nwg = nM * nN; G = G_; c = c_; }
    __host__ __device__ bool next(int i, Unit& u) const {
        const long L = (long)i * G + c; if (L >= nwg) return false;
        int wgid = (int)L; { const int q = nwg / NXCD, r = nwg % NXCD, xcd = wgid % NXCD, off = wgid / NXCD; wgid = (xcd < r ? xcd * (q + 1) : r * (q + 1) + (xcd - r) * q) + off; }
        const int nig = WGM * nN, gid = wgid / nig, fm = gid * WGM, gsz = (nM - fm) < WGM ? (nM - fm) : WGM;
        u.pm = fm + ((wgid % nig) % gsz); u.pn = (wgid % nig) / gsz; return true;
    }
};

__device__ __forceinline__ unsigned cvt_pk_bf16(float lo, float hi) { unsigned r; asm volatile("v_cvt_pk_bf16_f32 %0, %1, %2" : "=v"(r) : "v"(lo), "v"(hi)); return r; }

template <class Epi, class Sched, bool ALIGN_EPI, bool GATHER>
__device__ __forceinline__ void gemm_phase(PG8_LAS unsigned char* lds, const Gemm g, const Sched& S, const Epi& E) {
    const int tid = threadIdx.x, wid = __builtin_amdgcn_readfirstlane(tid >> 6), lane = tid & 63, wr = wid >> 2, wc = wid & 3, fr = lane & 15, fq = lane >> 4;
    const int K = g.K, nt = K / BK;
    unsigned voffA[2], voffB[2]; int gR[2]; unsigned gC[2];
#pragma unroll
    for (int i = 0; i < 2; ++i) { int R, C; stage_rc(tid * 16 + i * 8192, R, C); const int Rb = Epi::PERM ? ((R & ~31) + perm32(R & 31)) : R;
        voffA[i] = (unsigned)(R * K + C) * 2u; voffB[i] = (unsigned)(Rb * K + C) * 2u; gR[i] = R; gC[i] = (unsigned)C * 2u; }
    const size_t kstep = (size_t)(BK * 2);
    const size_t hstep = (size_t)HALF * K * 2;
    const size_t tstep = 2 * hstep;
    const unsigned ldsw = (unsigned)wid * 1024u;
    const int aoff = lds_byte(wr * 64 + fr, fq * 8), boff = lds_byte(wc * 32 + fr, fq * 8);
#define PG8_SA(b, h) (((b) * 2 + (h)) * HTB)
#define PG8_SB(b, h) ((4 + (b) * 2 + (h)) * HTB)
#define PG8_STAGE(bufoff, gbase, voff) do { _Pragma("unroll") for (int _i = 0; _i < 2; ++_i) \
        __builtin_amdgcn_global_load_lds((const unsigned*)((const char*)(gbase) + (voff)[_i]), (PG8_LAS unsigned*)(lds + (bufoff) + ldsw + _i * 8192), 16, 0, 0); } while (0)
#define PG8_STAGE_A(b, h, kp, VS) do { if constexpr (GATHER) { PG8_STAGE(PG8_SA(b, h), (kp), VS[h]); } else { PG8_STAGE(PG8_SA(b, h), (kp) + (size_t)(h) * hstep, voffA); } } while (0)
#define PG8_LDA(dst, b, h) do { _Pragma("unroll") for (int m = 0; m < 4; ++m) _Pragma("unroll") for (int k = 0; k < 2; ++k) dst[m][k] = *(const PG8_LAS bf16x8*)(lds + PG8_SA(b, h) + aoff + m * 2048 + k * 1024); } while (0)
#define PG8_LDB(dst, b, h) do { _Pragma("unroll") for (int n = 0; n < 2; ++n) _Pragma("unroll") for (int k = 0; k < 2; ++k) dst[n][k] = *(const PG8_LAS bf16x8*)(lds + PG8_SB(b, h) + boff + n * 2048 + k * 1024); } while (0)
#define PG8_MMA(ai, bj, At, Bt) do { __builtin_amdgcn_s_setprio(1); _Pragma("unroll") for (int m = 0; m < 4; ++m) _Pragma("unroll") for (int n = 0; n < 2; ++n) _Pragma("unroll") for (int k = 0; k < 2; ++k) \
        acc[ai][bj][m][n] = __builtin_amdgcn_mfma_f32_16x16x32_bf16(Bt[n][k], At[m][k], acc[ai][bj][m][n], 0, 0, 0); __builtin_amdgcn_s_setprio(0); } while (0)
#define PG8_WAIT_V(n) asm volatile("s_waitcnt vmcnt(" #n ")" ::: "memory")
#define PG8_WAIT_L(n) asm volatile("s_waitcnt lgkmcnt(" #n ")" ::: "memory")
#define PG8_BAR __builtin_amdgcn_s_barrier()
#define PG8_SCHED __builtin_amdgcn_sched_barrier(0)
    Unit cur, nxt; int ui = 0;
    if (!S.next(0, cur)) return;
    f32x4 acc[2][2][4][2];
#pragma unroll
    for (int a = 0; a < 2; ++a)
#pragma unroll
        for (int b = 0; b < 2; ++b)
#pragma unroll
            for (int m = 0; m < 4; ++m)
#pragma unroll
                for (int n = 0; n < 2; ++n) acc[a][b][m][n] = (f32x4){0.f, 0.f, 0.f, 0.f};
    bf16x8 At[4][2], B0[2][2], B1[2][2];
    unsigned vAc[2][2], vAn[2][2], v2[2][2];
    const char* cA = GATHER ? (const char*)g.A : (const char*)g.A + (size_t)cur.pm * tstep; const char* cB = (const char*)g.Bt + (size_t)cur.pn * tstep;
    if constexpr (GATHER) {
#pragma unroll
        for (int h = 0; h < 2; ++h)
#pragma unroll
            for (int i = 0; i < 2; ++i) vAc[h][i] = (unsigned)S.rowoff(cur, h * HALF + gR[i]) * (unsigned)(K * 2) + gC[i];
    }
    PG8_STAGE(PG8_SB(0, 0), cB, voffB); PG8_STAGE(PG8_SB(0, 1), cB + hstep, voffB); PG8_STAGE_A(0, 0, cA, vAc); PG8_STAGE_A(0, 1, cA, vAc);
    if (wr == 1) PG8_BAR;
    PG8_WAIT_V(2); PG8_BAR;
    PG8_STAGE(PG8_SB(1, 0), cB + kstep, voffB); PG8_STAGE_A(1, 0, cA + kstep, vAc); PG8_STAGE(PG8_SB(1, 1), cB + hstep + kstep, voffB);
    PG8_WAIT_V(6); PG8_BAR;
    for (;;) {
        const bool has_next = S.next(ui + 1, nxt);
        const char* nA = GATHER ? cA : (has_next ? (const char*)g.A + (size_t)nxt.pm * tstep : cA); const char* nB = has_next ? (const char*)g.Bt + (size_t)nxt.pn * tstep : cB;
        if constexpr (GATHER) {
#pragma unroll
            for (int h = 0; h < 2; ++h)
#pragma unroll
                for (int i = 0; i < 2; ++i) { const unsigned nv = has_next ? (unsigned)S.rowoff(nxt, h * HALF + gR[i]) * (unsigned)(K * 2) + gC[i] : vAc[h][i]; vAn[h][i] = nv; }
        }
        for (int t = 0; t < nt; t += 2) {
            const bool last = (t == nt - 2);
            const char* a1 = cA + (size_t)(t + 1) * kstep;
            const char* a2 = last ? nA : cA + (size_t)(t + 2) * kstep; const char* b2 = last ? nB : cB + (size_t)(t + 2) * kstep;
            const char* a3 = a2 + kstep; const char* b3 = b2 + kstep;
            if constexpr (GATHER) {
#pragma unroll
                for (int h = 0; h < 2; ++h)
#pragma unroll
                    for (int i = 0; i < 2; ++i) v2[h][i] = last ? vAn[h][i] : vAc[h][i];
            }
            PG8_LDB(B0, 0, 0); PG8_LDB(B1, 0, 1); PG8_SCHED; PG8_LDA(At, 0, 0); PG8_STAGE_A(1, 1, a1, vAc);
            PG8_WAIT_V(8); PG8_WAIT_L(0); PG8_BAR; PG8_MMA(0, 0, At, B0); PG8_MMA(0, 1, At, B1); PG8_BAR; PG8_SCHED;
            PG8_LDA(At, 0, 1); PG8_STAGE(PG8_SB(0, 0), b2, voffB); PG8_STAGE(PG8_SB(0, 1), b2 + hstep, voffB); PG8_STAGE_A(0, 0, a2, v2);
            PG8_WAIT_V(8); PG8_WAIT_L(0); PG8_BAR; PG8_MMA(1, 0, At, B0); PG8_MMA(1, 1, At, B1); PG8_BAR; PG8_SCHED;
            PG8_LDB(B0, 1, 0); PG8_LDB(B1, 1, 1); PG8_SCHED; PG8_LDA(At, 1, 0); PG8_STAGE_A(0, 1, a2, v2);
            PG8_WAIT_V(8); PG8_WAIT_L(0); PG8_BAR; PG8_MMA(0, 0, At, B0); PG8_MMA(0, 1, At, B1); PG8_BAR; PG8_SCHED;
            PG8_LDA(At, 1, 1); PG8_STAGE(PG8_SB(1, 0), b3, voffB); PG8_STAGE(PG8_SB(1, 1), b3 + hstep, voffB); PG8_STAGE_A(1, 0, a3, v2);
            PG8_WAIT_V(8); PG8_WAIT_L(0); PG8_BAR; PG8_MMA(1, 0, At, B0); PG8_MMA(1, 1, At, B1); PG8_BAR; PG8_SCHED;
        }
        if constexpr (ALIGN_EPI) { if (wr == 0) PG8_BAR; }
        E(acc, cur, wr, wc, fr, fq);
        if (!has_next) break;
#pragma unroll
        for (int a = 0; a < 2; ++a)
#pragma unroll
            for (int b = 0; b < 2; ++b)
#pragma unroll
                for (int m = 0; m < 4; ++m)
#pragma unroll
                    for (int n = 0; n < 2; ++n) acc[a][b][m][n] = (f32x4){0.f, 0.f, 0.f, 0.f};
        cur = nxt; cA = nA; cB = nB; ++ui;
        if constexpr (GATHER) {
#pragma unroll
            for (int h = 0; h < 2; ++h)
#pragma unroll
                for (int i = 0; i < 2; ++i) vAc[h][i] = vAn[h][i];
        }
        if constexpr (ALIGN_EPI) { if (wr == 1) PG8_BAR; }
    }
    PG8_WAIT_V(0);
    if constexpr (!ALIGN_EPI) { if (wr == 0) PG8_BAR; }
    PG8_BAR;
#undef PG8_SA
#undef PG8_SB
#undef PG8_STAGE
#undef PG8_STAGE_A
#undef PG8_LDA
#undef PG8_LDB
#undef PG8_MMA
#undef PG8_WAIT_V
#undef PG8_WAIT_L
#undef PG8_BAR
#undef PG8_SCHED
}
}
#define GAS __attribute__((address_space(1)))
#define LAS __attribute__((address_space(3)))
typedef unsigned short bf16;
typedef unsigned v4u __attribute__((ext_vector_type(4)));
typedef float f32x4 __attribute__((ext_vector_type(4)));
typedef short bf16x8 __attribute__((ext_vector_type(8)));
typedef GAS unsigned gu32;
typedef GAS unsigned long long gu64;
#define RLX_AGENT __ATOMIC_RELAXED, __HIP_MEMORY_SCOPE_AGENT
#define LDS_WAIT() asm volatile("s_waitcnt lgkmcnt(0)" ::: "memory")
#define VM_WAIT() asm volatile("s_waitcnt vmcnt(0)" ::: "memory")
__device__ __forceinline__ unsigned long long rt() { return __builtin_amdgcn_s_memrealtime(); }
__device__ __forceinline__ unsigned f2bf(float f) { unsigned u = __builtin_bit_cast(unsigned, f); return (u + 0x7fffu + ((u >> 16) & 1u)) >> 16; }
__device__ __forceinline__ unsigned pk2(float lo, float hi) { return f2bf(lo) | (f2bf(hi) << 16); }

#define XB_TMO      128
#define XB_XCNT(j)  (256  + 64 * (j))
#define XB_XSUB(j)  (1280 + 64 * (j))
#define XB_XGEN(j)  (2304 + 64 * (j))
#define XB_TOP      3328
#define XB_TOPGEN   3392
#define XCD_BAR_WORDS 3456
#define XB_SPIN_CAP (1u << 18)

__device__ __forceinline__ unsigned xb_ld(unsigned* p)              { return __hip_atomic_load(p, __ATOMIC_RELAXED, __HIP_MEMORY_SCOPE_AGENT); }
__device__ __forceinline__ unsigned xb_add(unsigned* p, unsigned v) { return __hip_atomic_fetch_add(p, v, __ATOMIC_RELAXED, __HIP_MEMORY_SCOPE_AGENT); }
__device__ __forceinline__ unsigned xb_xcc_id() { return (unsigned)__builtin_amdgcn_s_getreg((3 << 11) | 20) & 0xFu; }
#define XB_SPIN(cond, bar) do { unsigned _sp = 0; while (cond) { __builtin_amdgcn_s_sleep(1); \
    if ((++_sp & 255u) == 0u) { if (xb_ld(&(bar)[XB_TMO])) break; if (_sp > XB_SPIN_CAP) { atomicAdd(&(bar)[XB_TMO], 1u); break; } } } } while (0)

struct XcdBarrier {
    unsigned* bar; unsigned x;
    volatile LAS unsigned* st;
};

__device__ __forceinline__ XcdBarrier xcd_barrier_post(unsigned* bar, volatile LAS unsigned* st) {
    XcdBarrier b; b.bar = bar; b.x = xb_xcc_id(); b.st = st;
    if (threadIdx.x == 0) (void)xb_add(&bar[XB_XCNT(b.x)], 1u);
    return b;
}
__device__ __forceinline__ void xcd_barrier_complete(unsigned* bar, unsigned x, unsigned& nloc, unsigned& nx) {
    const unsigned G = gridDim.x * gridDim.y * gridDim.z;
    unsigned sum, cnt, mine, sp = 0u;
    for (;;) {
        sum = 0u; cnt = 0u; mine = 0u;
#pragma unroll
        for (unsigned j = 0; j < 16; ++j) { const unsigned c = xb_ld(&bar[XB_XCNT(j)]); sum += c; cnt += (c > 0u) ? 1u : 0u; mine = (j == x) ? c : mine; }
        if (sum == G) break;
        __builtin_amdgcn_s_sleep(1);
        if ((++sp & 255u) == 0u) { if (xb_ld(&bar[XB_TMO])) break; if (sp > XB_SPIN_CAP) { atomicAdd(&bar[XB_TMO], 1u); break; } }
    }
    nloc = mine > 0u ? mine : 1u; nx = cnt > 0u ? cnt : 1u;
}

__device__ __forceinline__ void xcd_barrier(const XcdBarrier& b) {
    asm volatile("s_waitcnt vmcnt(0)" ::: "memory");
    __syncthreads();
    if (threadIdx.x == 0) {
        unsigned* bar = b.bar;
        __builtin_amdgcn_s_waitcnt(0);
        unsigned nloc = b.st[0], nx = b.st[1];
        if (nloc == 0u) { xcd_barrier_complete(bar, b.x, nloc, nx); b.st[0] = nloc; b.st[1] = nx; }
        const unsigned old = xb_add(&bar[XB_XSUB(b.x)], 1u);
        const unsigned gen = old / nloc;
        if (old + 1u == (gen + 1u) * nloc) {
            __builtin_amdgcn_fence(__ATOMIC_RELEASE, "agent");
            asm volatile("s_waitcnt vmcnt(0)" ::: "memory");
            const unsigned og = xb_add(&bar[XB_TOP], 1u);
            const unsigned tg = og / nx;
            if (og + 1u == (tg + 1u) * nx) xb_add(&bar[XB_TOPGEN], 1u);
            else XB_SPIN(xb_ld(&bar[XB_TOPGEN]) == tg, bar);
            __builtin_amdgcn_fence(__ATOMIC_ACQUIRE, "agent");
            xb_add(&bar[XB_XGEN(b.x)], 1u);
            asm volatile("s_waitcnt vmcnt(0)" ::: "memory");
        } else {
            XB_SPIN(xb_ld(&bar[XB_XGEN(b.x)]) == gen, bar);
            __builtin_amdgcn_fence(__ATOMIC_ACQUIRE, "agent");
            asm volatile("s_waitcnt vmcnt(0)" ::: "memory");
        }
    }
    __syncthreads();
}

constexpr int NWAVES = 8;
constexpr int D = 1024, NB = 16, SEQ = 2048, T = NB * SEQ, CTXL = 256, TC = NB * CTXL;
constexpr int QW = 512, KVW = 128, HYW = 512, INW = 4352, NE = 32, DFF = 1024;
constexpr float LN_EPS = 1e-5f;
constexpr float DN_ALPHA = 1.189207115002721f;
constexpr float LOG2E = 1.4426950408889634f;
constexpr float C2Q = 0.125f * LOG2E;
constexpr int NPH = 10;
#ifndef MK_N_LAUNCHES
#define MK_N_LAUNCHES 1
#endif
constexpr int N_LAUNCHES = MK_N_LAUNCHES;

constexpr size_t MiB = 1u << 20;
constexpr size_t WS_CTL = 0, CTL_ZERO_BYTES = 1 * MiB;
constexpr size_t WS_MODP = 1 * MiB;
constexpr size_t WS_MODF = 8 * MiB;
constexpr size_t WS_ROPE = 9 * MiB;
constexpr size_t WS_ASG = 10 * MiB;
constexpr size_t WS_GW = 10 * MiB + 512 * 1024;
constexpr size_t WS_TOK = 11 * MiB;
constexpr size_t WS_G = 16 * MiB;
constexpr size_t WS_WB = 24 * MiB;
constexpr size_t WS_WO = 26 * MiB;
constexpr size_t WS_WIN = 28 * MiB;
constexpr size_t WS_W1 = 40 * MiB;
constexpr size_t WS_W2 = 168 * MiB;
constexpr size_t WS_V1 = 232 * MiB;
constexpr size_t WS_HM = 360 * MiB;
constexpr size_t WS_HX = 424 * MiB;
constexpr size_t WS_Q = 496 * MiB;
constexpr size_t WS_K = 528 * MiB;
constexpr size_t WS_VT = 536 * MiB;
constexpr size_t WS_KC = 544 * MiB;
constexpr size_t WS_VTC = 545 * MiB;
constexpr size_t WS_UT = 546 * MiB;
constexpr size_t WS_GATE = 642 * MiB;
constexpr size_t WS_ATT = 770 * MiB;
constexpr size_t WS_MM = 834 * MiB;
constexpr size_t WS_ACT = 424 * MiB;
constexpr size_t WS_YB = 696 * MiB;
constexpr size_t WS_END = 1024 * MiB;
static_assert(WS_ACT + (size_t)139264 * 2048 <= WS_YB && WS_YB + (size_t)139264 * 2048 <= WS_END && WS_MM + (size_t)T * 2048 <= WS_END, "d_ws map");
constexpr int CW_TMO = 0, CW_CODE = 1, CW_BAR = 4096, CW_CNT = 16384;

constexpr int RING_BYTES = 131072;
constexpr int LDSCTL_OFF = 143360;
constexpr int MISC_OFF = LDSCTL_OFF + 320;
constexpr int TP_OFF = LDSCTL_OFF + 1024;
constexpr int LDS_BYTES = 147456;

typedef float f32x16 __attribute__((ext_vector_type(16)));
typedef float f32x2 __attribute__((ext_vector_type(2)));
typedef unsigned u32x2 __attribute__((ext_vector_type(2)));

struct Frame {
    LAS unsigned char* lds;
    volatile LAS unsigned* MISC;
    gu32* ctl;
    int tid, lane, wave, vcu, G;
    const float *x, *c, *ctx, *c_ctx, *w_mod, *b_mod, *w_in, *sink, *cw, *cb, *fw1, *fb1, *fw2, *fb2, *fw3, *skip, *w_ba, *w_bh, *w_out, *ln1g, *ln1b, *rw, *rb, *ew1, *eb1, *ew2, *eb2, *ln2g, *ln2b;
    float* out;
    float *modP, *modF, *rope, *gw, *V1;
    int *asg, *tok;
    bf16 *G_, *WB, *WO, *WIN, *W1, *W2, *HM, *HX, *Q, *K, *VT, *KC, *VTC, *UT, *GATE, *ATT, *MM, *ACT, *YB;
};

__device__ __forceinline__ float wave_sum(float v) {
#pragma unroll
    for (int o = 1; o < 64; o <<= 1) v += __shfl_xor(v, o);
    return v;
}
__device__ __forceinline__ float bf2f(unsigned short h) { return __builtin_bit_cast(float, (unsigned)h << 16); }
__device__ __forceinline__ float bflo(unsigned w) { return __builtin_bit_cast(float, w << 16); }
__device__ __forceinline__ float bfhi(unsigned w) { return __builtin_bit_cast(float, w & 0xffff0000u); }
__device__ __forceinline__ float sigmoidf_(float x) { return 1.f / (1.f + __expf(-x)); }

__device__ __forceinline__ void p0_transpose(const float* W, int N, bf16* WT, int Kp, int drow, int k0, int n0, LAS float* scr, int lane) {
    asm volatile("" : "+v"(lane));
#pragma unroll 8
    for (int i = 0; i < 32; ++i) { const int kk = 2 * i + (lane >> 5); scr[kk * 33 + (lane & 31)] = W[(size_t)(k0 + kk) * N + n0 + (lane & 31)]; }
    LDS_WAIT(); asm volatile("" ::: "memory");
    const int c = lane & 7;
#pragma unroll
    for (int j = 0; j < 4; ++j) { const int n = (lane >> 3) + 8 * j; const LAS float* s = scr + (8 * c) * 33 + n;
        v4u o; o.x = pk2(s[0 * 33], s[1 * 33]); o.y = pk2(s[2 * 33], s[3 * 33]); o.z = pk2(s[4 * 33], s[5 * 33]); o.w = pk2(s[6 * 33], s[7 * 33]);
        *(GAS v4u*)(WT + (size_t)(drow + n) * Kp + k0 + 8 * c) = o; }
    LDS_WAIT(); asm volatile("" ::: "memory");
}
__device__ __forceinline__ void p0_mod_item(Frame& F, LAS float* scr, int cb, int kc) {
    int lane = F.lane; asm volatile("" : "+v"(lane));
#pragma unroll
    for (int r = 0; r < 17; ++r) { const float* src = r < 16 ? F.c + r * D : F.c_ctx; const float xv = src[64 * kc + lane]; scr[r * 64 + lane] = xv / (1.f + __expf(-xv)); }
    LDS_WAIT(); asm volatile("" ::: "memory");
    float acc[17];
#pragma unroll
    for (int r = 0; r < 17; ++r) acc[r] = 0.f;
    const float* wp = F.w_mod + (size_t)(64 * kc) * 6144 + 64 * cb + lane;
#pragma unroll 8
    for (int k = 0; k < 64; ++k) { const float w = wp[(size_t)k * 6144];
#pragma unroll
        for (int r = 0; r < 17; ++r) acc[r] += scr[r * 64 + k] * w; }
#pragma unroll
    for (int r = 0; r < 17; ++r) F.modP[((size_t)kc * 17 + r) * 6144 + 64 * cb + lane] = acc[r];
    LDS_WAIT(); asm volatile("" ::: "memory");
}
__device__ __forceinline__ void p0_filt_item(Frame& F, LAS float* scr, int g, int cb) {
    int lane = F.lane; asm volatile("" : "+v"(lane));
    LAS float* zf = scr; LAS float* h1 = scr + 8 * 36; LAS float* h2 = h1 + 8 * 64;
#pragma unroll
    for (int p = 0; p < 8; ++p) { const int j = 8 * g + p; const float om = (6.283185307179586f * (float)j) / 2048.f;
        if (lane < 16) { const float fk = 1e-4f + (float)lane * ((15.f - 1e-4f) / 15.f); zf[p * 36 + 1 + lane] = cosf(fk * om); }
        else if (lane < 32) { const float fk = 1e-4f + (float)(lane - 16) * ((15.f - 1e-4f) / 15.f); zf[p * 36 + 17 + (lane - 16)] = -sinf(fk * om); }
        else if (lane == 32) zf[p * 36] = (float)j / 2047.f; }
    LDS_WAIT(); asm volatile("" ::: "memory");
#pragma unroll
    for (int p = 0; p < 8; ++p) { float a = F.fb1[lane];
        for (int i = 0; i < 33; ++i) a += zf[p * 36 + i] * F.fw1[i * 64 + lane];
        h1[p * 64 + lane] = sinf(a); }
    LDS_WAIT(); asm volatile("" ::: "memory");
#pragma unroll
    for (int p = 0; p < 8; ++p) { float a = F.fb2[lane];
        for (int i = 0; i < 64; ++i) a += h1[p * 64 + i] * F.fw2[i * 64 + lane];
        h2[p * 64 + lane] = sinf(a); }
    LDS_WAIT(); asm volatile("" ::: "memory");
    float o[8][4];
#pragma unroll
    for (int p = 0; p < 8; ++p)
#pragma unroll
        for (int q = 0; q < 4; ++q) o[p][q] = 0.f;
    const float* w3 = F.fw3 + 256 * cb + lane;
#pragma unroll 4
    for (int i = 0; i < 64; ++i) { float w[4];
#pragma unroll
        for (int q = 0; q < 4; ++q) w[q] = w3[(size_t)i * 2048 + 64 * q];
#pragma unroll
        for (int p = 0; p < 8; ++p) { const float hv = h2[p * 64 + i];
#pragma unroll
            for (int q = 0; q < 4; ++q) o[p][q] += hv * w[q]; } }
#pragma unroll
    for (int q = 0; q < 4; ++q) { const int col = 256 * cb + 64 * q + lane, oo = col >> 10, dir = (col >> 9) & 1, ch = col & 511;
        const float delta = 15.350567286626973f - (float)ch * (12.280453829301578f / 511.f);
        bf16* gp = F.G_ + (size_t)(oo * 512 + ch) * 4096;
#pragma unroll
        for (int p = 0; p < 8; ++p) { const int j = 8 * g + p; const float val = o[p][q] * __expf(-((float)j / 2047.f) * delta);
            const int idx = dir ? 2048 + j : 2048 - j; if (!(dir && j == 0)) gp[idx] = (bf16)f2bf(val); }
        if (g == 0 && dir == 0) gp[0] = 0; }
    LDS_WAIT(); asm volatile("" ::: "memory");
}
__device__ __forceinline__ void p0_prologue(Frame& F) {
    LAS float* scr = (LAS float*)(F.lds + F.wave * 16384);
    const int gw = F.vcu * NWAVES + F.wave, NGW = F.G * NWAVES, lane = F.lane;
    constexpr int IT_FILT = 2048, IT_MOD = 1536, IT_ROPE = 1, IT_IN = 16 * 136, IT_B = 8 * 32, IT_O = 16 * 32, IT_W1 = 32 * 16 * 64, IT_W2 = 32 * 16 * 32;
    constexpr int NITEMS = IT_FILT + IT_MOD + IT_ROPE + IT_IN + 2 * IT_B + IT_O + IT_W1 + IT_W2;
    for (int it = gw; it < NITEMS; it += NGW) {
        int r = it;
        if (r < IT_FILT) { p0_filt_item(F, scr, r >> 3, r & 7); continue; } r -= IT_FILT;
        if (r < IT_MOD) { p0_mod_item(F, scr, r % 96, r / 96); continue; } r -= IT_MOD;
        if (r < IT_ROPE) {
#pragma unroll 4
            for (int i = 0; i < 16; ++i) { const int idx = lane * 16 + i, pos = idx >> 4, f = idx & 15; const float inv = exp2f(-(float)f * (13.287712379549449f / 16.f)); const float ang = (float)pos * inv;
                F.rope[idx] = cosf(ang); F.rope[1024 + idx] = sinf(ang); }
            continue; } r -= IT_ROPE;
        const float* W; int N, Kp, drow, k0, n0; bf16* WT;
        if (r < IT_IN) { W = F.w_in; N = INW; WT = F.WIN; Kp = 1024; k0 = 64 * (r / 136); n0 = 32 * (r % 136); drow = n0; }
        else if ((r -= IT_IN) < IT_B) { W = F.w_ba; N = 1024; WT = F.WB; Kp = 512; k0 = 64 * (r / 32); n0 = 32 * (r % 32); drow = n0; }
        else if ((r -= IT_B) < IT_B) { W = F.w_bh; N = 1024; WT = F.WB + 1024 * 512; Kp = 512; k0 = 64 * (r / 32); n0 = 32 * (r % 32); drow = n0; }
        else if ((r -= IT_B) < IT_O) { W = F.w_out; N = 1024; WT = F.WO; Kp = 1024; k0 = 64 * (r / 32); n0 = 32 * (r % 32); drow = n0; }
        else if ((r -= IT_O) < IT_W1) { const int e = r >> 10, q = r & 1023; W = F.ew1 + (size_t)e * 1024 * 2048; N = 2048; WT = F.W1 + (size_t)e * 2048 * 1024; Kp = 1024; k0 = 64 * (q >> 6); n0 = 32 * (q & 63);
            drow = n0 < 1024 ? (n0 >> 7) * 256 + (n0 & 127) : ((n0 - 1024) >> 7) * 256 + 128 + ((n0 - 1024) & 127); }
        else { r -= IT_W1; const int e = r >> 9, q = r & 511; W = F.ew2 + (size_t)e * 1024 * 1024; N = 1024; WT = F.W2 + (size_t)e * 1024 * 1024; Kp = 1024; k0 = 64 * (q >> 5); n0 = 32 * (q & 31); drow = n0; }
        p0_transpose(W, N, WT, Kp, drow, k0, n0, scr, lane);
    }
}

__device__ __forceinline__ float mod_sum(Frame& F, int r, int n) {
    float s = F.b_mod[n];
#pragma unroll
    for (int kc = 0; kc < 16; ++kc) s += F.modP[((size_t)kc * 17 + r) * 6144 + n];
    return s;
}
__device__ __forceinline__ void ln_mod_row(const float* src, bf16* dst, const LAS float* tS, const LAS float* tB, int lane) {
    const GAS f32x4* xr = (const GAS f32x4*)src + lane;
    f32x4 v[4]; float s = 0.f;
#pragma unroll
    for (int j = 0; j < 4; ++j) { v[j] = xr[64 * j]; s += (v[j].x + v[j].y) + (v[j].z + v[j].w); }
    const float mean = wave_sum(s) * (1.f / D); float s2 = 0.f;
#pragma unroll
    for (int j = 0; j < 4; ++j) { v[j] = v[j] - mean; s2 += (v[j].x * v[j].x + v[j].y * v[j].y) + (v[j].z * v[j].z + v[j].w * v[j].w); }
    const float rstd = 1.f / sqrtf(wave_sum(s2) * (1.f / D) + LN_EPS);
#pragma unroll
    for (int j = 0; j < 4; ++j) { const int col = 4 * lane + 256 * j; const f32x4 sc = *(const LAS f32x4*)(tS + col), sh = *(const LAS f32x4*)(tB + col);
        const f32x4 o = v[j] * rstd * sc + sh; u32x2 w; w.x = pk2(o.x, o.y); w.y = pk2(o.z, o.w); *(GAS u32x2*)(dst + col) = w; }
}
__device__ __forceinline__ void p1_rows(Frame& F) {
    LAS float* tA = (LAS float*)F.lds;
    for (int chunk = blockIdx.x; chunk < 256; chunk += F.G) {
        const int b = chunk >> 4;
        for (int i = F.tid; i < 4096; i += NWAVES * 64) { const int which = i >> 10, col = i & 1023, r = which < 2 ? b : 16, n = ((which & 1) ? 0 : 1024) + col;
            const float s = mod_sum(F, r, n); tA[i] = (which & 1) ? s : 1.f + s; }
        __syncthreads();
        for (int rr = 0; rr < 18; ++rr) {
            if (rr < 16) { const int row = chunk * 128 + F.wave * 16 + rr; ln_mod_row(F.x + (size_t)row * D, F.HX + (size_t)row * D, tA, tA + 1024, F.lane); }
            else { const int cr = chunk * 16 + F.wave * 2 + (rr - 16); ln_mod_row(F.ctx + (size_t)cr * D, F.HX + (size_t)(T + cr) * D, tA + 2048, tA + 3072, F.lane); }
        }
        __syncthreads();
        for (int i = chunk * 408 + F.tid; i < (chunk + 1) * 408; i += NWAVES * 64) F.modF[i] = mod_sum(F, i / 6144, i % 6144);
    }
}

using pg8::Unit; using pg8::f32x4; using pg8::cvt_pk_bf16;
struct SchedInProj {
    pg8::StaticOrder so; int G, c;
    __device__ __forceinline__ bool next(int i, Unit& u) const { const long L = (long)i * G + c; if (L < 2176) return so.next(i, u); if (L < 2192) { u.pm = 128 + (int)(L - 2176); u.pn = 2; return true; } return false; }
    __device__ __forceinline__ void a_ready(const Unit&) const {}
};
struct SchedPair {
    pg8::StaticOrder so;
    __device__ __forceinline__ bool next(int i, Unit& u) const { if (!so.next(i >> 1, u)) return false; if (i & 1) { u.pm += 128; u.pn += 4; } return true; }
    __device__ __forceinline__ void a_ready(const Unit&) const {}
};
struct SchedPlain { pg8::StaticOrder so;
    __device__ __forceinline__ bool next(int i, Unit& u) const { return so.next(i, u); }
    __device__ __forceinline__ void a_ready(const Unit&) const {}
};
struct SchedMoe {
    const LAS int* tp; const int* tok; int nNl, G, c;
    __device__ __forceinline__ bool next(int i, Unit& u) const {
        pg8::StaticOrder so; so.init(tp[32], nNl, G, c); if (!so.next(i, u)) return false;
        int e = 0;
        for (int k = 1; k < 32; ++k) e += (u.pm >= tp[k]) ? 1 : 0;
        u.pn += e * nNl; return true; }
    __device__ __forceinline__ int rowoff(const Unit& u, int r) const { const int e = u.pn / nNl; int pos = (u.pm - tp[e]) * 256 + r; pos = pos < tp[33 + e] ? pos : 0; return tok[e * 32768 + pos]; }
    __device__ __forceinline__ void a_ready(const Unit&) const {}
};

struct EpiInProj {
    static constexpr bool PERM = true;
    bf16 *Q, *K, *VT, *KC, *VTC, *UT, *GATE; const float* rope;
    __device__ __forceinline__ void operator()(const f32x4 (&acc)[2][2][4][2], const Unit& u, int wr, int wc, int fr, int fq) const {
        const int pn = u.pn; const bool isctx = u.pm >= 128;
#pragma unroll
        for (int ai = 0; ai < 2; ++ai)
#pragma unroll
            for (int m = 0; m < 4; ++m) {
                const int row = u.pm * 256 + ai * 128 + wr * 64 + m * 16 + fr;
                if (pn >= 9) {
#pragma unroll
                    for (int bj = 0; bj < 2; ++bj) { const int col = (pn - 9) * 256 + bj * 128 + wc * 32 + 8 * fq; const f32x4 v0 = acc[ai][bj][m][0], v1 = acc[ai][bj][m][1]; v4u w;
                        w.x = cvt_pk_bf16(sigmoidf_(v0[0]), sigmoidf_(v0[1])); w.y = cvt_pk_bf16(sigmoidf_(v0[2]), sigmoidf_(v0[3])); w.z = cvt_pk_bf16(sigmoidf_(v1[0]), sigmoidf_(v1[1])); w.w = cvt_pk_bf16(sigmoidf_(v1[2]), sigmoidf_(v1[3]));
                        *(GAS v4u*)(GATE + (size_t)row * 2048 + col) = w; }
                } else if (pn >= 3) {
#pragma unroll
                    for (int bj = 0; bj < 2; ++bj) { const int ch = (pn - 3) * 256 + bj * 128 + wc * 32 + 8 * fq; bf16* up = UT + (size_t)ch * T + row;
#pragma unroll
                        for (int n = 0; n < 2; ++n)
#pragma unroll
                            for (int j = 0; j < 4; ++j) up[(size_t)(4 * n + j) * T] = (bf16)f2bf(acc[ai][bj][m][n][j]); }
                } else {
                    const int t = row & 2047;
                    const int pos = (wc & 1) ? (t & 63) : (t >> 6); const int f0 = 8 * (fq & 1); const bool hihalf = (fq >> 1) != 0;
#pragma unroll
                    for (int bj = 0; bj < 2; ++bj) {
                        if (pn == 2 && bj == 1) {
                            const int kvh = wc >> 1, d0 = (wc & 1) * 32 + 8 * fq;
                            bf16* vp = isctx ? VTC + ((size_t)(((row - T) >> 8) * 2 + kvh) * 64 + d0) * 256 + ((row - T) & 255)
                                             : VT + ((size_t)((row >> 11) * 2 + kvh) * 64 + d0) * 2048 + t;
                            const int pitch = isctx ? 256 : 2048;
#pragma unroll
                            for (int n = 0; n < 2; ++n)
#pragma unroll
                                for (int j = 0; j < 4; ++j) vp[(size_t)(4 * n + j) * pitch] = (bf16)f2bf(acc[ai][bj][m][n][j]);
                        } else {
                            f32x4 r[2];
#pragma unroll
                            for (int n = 0; n < 2; ++n) { const f32x4 own = acc[ai][bj][m][n]; f32x4 oth;
#pragma unroll
                                for (int j = 0; j < 4; ++j) oth[j] = __shfl_xor(own[j], 32);
                                const f32x4 cs = *(const f32x4*)(rope + pos * 16 + f0 + 4 * n), sn = *(const f32x4*)(rope + 1024 + pos * 16 + f0 + 4 * n);
                                r[n] = hihalf ? own * cs + oth * sn : own * cs - oth * sn;
                                if (isctx) r[n] = own; }
                            if (pn < 2) { r[0] = r[0] * C2Q; r[1] = r[1] * C2Q; }
                            v4u w; w.x = cvt_pk_bf16(r[0][0], r[0][1]); w.y = cvt_pk_bf16(r[0][2], r[0][3]); w.z = cvt_pk_bf16(r[1][0], r[1][1]); w.w = cvt_pk_bf16(r[1][2], r[1][3]);
                            bf16* dst = pn < 2 ? Q + (size_t)row * QW + pn * 256 + bj * 128 + wc * 32 + 8 * fq
                                               : (isctx ? KC + (size_t)(row - T) * KVW + wc * 32 + 8 * fq : K + (size_t)row * KVW + wc * 32 + 8 * fq);
                            *(GAS v4u*)dst = w;
                        }
                    }
                }
            }
    }
};
struct EpiMerge {
    static constexpr bool PERM = true;
    const bf16* GATE; bf16* MM;
    __device__ __forceinline__ void operator()(const f32x4 (&acc)[2][2][4][2], const Unit& u, int wr, int wc, int fr, int fq) const {
        const int which = u.pn >> 2, pnl = u.pn & 3, pml = u.pm & 127;
#pragma unroll
        for (int ai = 0; ai < 2; ++ai)
#pragma unroll
            for (int m = 0; m < 4; ++m) { const int row = pml * 256 + ai * 128 + wr * 64 + m * 16 + fr;
#pragma unroll
                for (int bj = 0; bj < 2; ++bj) { const int col = pnl * 256 + bj * 128 + wc * 32 + 8 * fq;
                    const v4u g = *(const GAS v4u*)(GATE + (size_t)row * 2048 + which * 1024 + col);
                    const f32x4 v0 = acc[ai][bj][m][0], v1 = acc[ai][bj][m][1];
                    float o[8] = {bflo(g.x) * v0[0], bfhi(g.x) * v0[1], bflo(g.y) * v0[2], bfhi(g.y) * v0[3], bflo(g.z) * v1[0], bfhi(g.z) * v1[1], bflo(g.w) * v1[2], bfhi(g.w) * v1[3]};
                    bf16* mp = MM + (size_t)row * 1024 + col;
                    if (which) { const v4u p = *(const GAS v4u*)mp; o[0] += bflo(p.x); o[1] += bfhi(p.x); o[2] += bflo(p.y); o[3] += bfhi(p.y); o[4] += bflo(p.z); o[5] += bfhi(p.z); o[6] += bflo(p.w); o[7] += bfhi(p.w); }
                    v4u w; w.x = cvt_pk_bf16(o[0], o[1]); w.y = cvt_pk_bf16(o[2], o[3]); w.z = cvt_pk_bf16(o[4], o[5]); w.w = cvt_pk_bf16(o[6], o[7]);
                    *(GAS v4u*)mp = w; } }
    }
};
struct EpiV1 {
    static constexpr bool PERM = false;
    const float* x; const float* modF; float* V1;
    __device__ __forceinline__ void operator()(const f32x4 (&acc)[2][2][4][2], const Unit& u, int wr, int wc, int fr, int fq) const {
        const int col0 = u.pn * 256 + wc * 32 + 4 * fq; const int b = u.pm >> 3;
        f32x4 g1[2][2];
#pragma unroll
        for (int bj = 0; bj < 2; ++bj)
#pragma unroll
            for (int n = 0; n < 2; ++n) g1[bj][n] = *(const f32x4*)(modF + b * 6144 + 2048 + col0 + bj * 128 + n * 16);
#pragma unroll
        for (int ai = 0; ai < 2; ++ai)
#pragma unroll
            for (int m = 0; m < 4; ++m) { const size_t off = (size_t)(u.pm * 256 + ai * 128 + wr * 64 + m * 16 + fr) * D + col0;
#pragma unroll
                for (int bj = 0; bj < 2; ++bj)
#pragma unroll
                    for (int n = 0; n < 2; ++n) { const f32x4 xv = *(const f32x4*)(x + off + bj * 128 + n * 16); *(f32x4*)(V1 + off + bj * 128 + n * 16) = xv * DN_ALPHA + g1[bj][n] * acc[ai][bj][m][n]; } }
    }
};
struct EpiAct {
    static constexpr bool PERM = true;
    const float* b1; bf16* ACT;
    __device__ __forceinline__ void operator()(const f32x4 (&acc)[2][2][4][2], const Unit& u, int wr, int wc, int fr, int fq) const {
        const int e = u.pn >> 3, pnl = u.pn & 7, colo = pnl * 128 + wc * 32 + 8 * fq;
        f32x4 bg[2], bl[2];
#pragma unroll
        for (int n = 0; n < 2; ++n) { bg[n] = *(const f32x4*)(b1 + e * 2048 + colo + 4 * n); bl[n] = *(const f32x4*)(b1 + e * 2048 + 1024 + colo + 4 * n); }
#pragma unroll
        for (int ai = 0; ai < 2; ++ai)
#pragma unroll
            for (int m = 0; m < 4; ++m) { const int row = u.pm * 256 + ai * 128 + wr * 64 + m * 16 + fr; float o[8];
#pragma unroll
                for (int n = 0; n < 2; ++n)
#pragma unroll
                    for (int j = 0; j < 4; ++j) { float gl = acc[ai][0][m][n][j] + bg[n][j], li = acc[ai][1][m][n][j] + bl[n][j];
                        gl = fminf(gl, 7.f); li = fminf(fmaxf(li, -7.f), 7.f); o[4 * n + j] = gl * sigmoidf_(1.702f * gl) * (li + 1.f); }
                v4u w; w.x = cvt_pk_bf16(o[0], o[1]); w.y = cvt_pk_bf16(o[2], o[3]); w.z = cvt_pk_bf16(o[4], o[5]); w.w = cvt_pk_bf16(o[6], o[7]);
                *(GAS v4u*)(ACT + (size_t)row * 1024 + colo) = w; }
    }
};
struct EpiYb {
    static constexpr bool PERM = true;
    const float* b2; bf16* YB;
    __device__ __forceinline__ void operator()(const f32x4 (&acc)[2][2][4][2], const Unit& u, int wr, int wc, int fr, int fq) const {
        const int e = u.pn >> 2, pnl = u.pn & 3;
#pragma unroll
        for (int bj = 0; bj < 2; ++bj) { const int col = pnl * 256 + bj * 128 + wc * 32 + 8 * fq;
            const f32x4 b0 = *(const f32x4*)(b2 + e * 1024 + col), b1v = *(const f32x4*)(b2 + e * 1024 + col + 4);
#pragma unroll
            for (int ai = 0; ai < 2; ++ai)
#pragma unroll
                for (int m = 0; m < 4; ++m) { const int row = u.pm * 256 + ai * 128 + wr * 64 + m * 16 + fr; const f32x4 v0 = acc[ai][bj][m][0] + b0, v1 = acc[ai][bj][m][1] + b1v;
                    v4u w; w.x = cvt_pk_bf16(v0[0], v0[1]); w.y = cvt_pk_bf16(v0[2], v0[3]); w.z = cvt_pk_bf16(v1[0], v1[1]); w.w = cvt_pk_bf16(v1[2], v1[3]);
                    *(GAS v4u*)(YB + (size_t)row * 1024 + col) = w; } }
    }
};

__device__ __forceinline__ int crow(int r, int hi) { return (r & 3) + 8 * (r >> 2) + 4 * hi; }
template <bool MASK>
__device__ __forceinline__ void attn_step(const LAS unsigned char* Kl, const LAS unsigned char* Vl, const int pitchV, const int kvoff, const bf16x8 (&qf)[2][4],
                                          float (&mrun)[2], float (&lrun)[2], f32x16 (&o)[2][2], const int r32, const int hi, const int dq0) {
    bf16x8 kf[4], vf[2][2];
#pragma unroll
    for (int ks = 0; ks < 4; ++ks) kf[ks] = *(const LAS bf16x8*)(Kl + (kvoff + r32) * 144 + ks * 32 + hi * 16);
#pragma unroll
    for (int dt = 0; dt < 2; ++dt)
#pragma unroll
        for (int s2 = 0; s2 < 2; ++s2) { const LAS unsigned char* p = Vl + (32 * dt + r32) * pitchV + (kvoff + 16 * s2 + 4 * hi) * 2;
            const u32x2 a = *(const LAS u32x2*)p, b = *(const LAS u32x2*)(p + 16); const v4u w = {a.x, a.y, b.x, b.y}; vf[dt][s2] = __builtin_bit_cast(bf16x8, w); }
#pragma unroll
    for (int qt = 0; qt < 2; ++qt) {
        f32x16 s = {0.f, 0.f, 0.f, 0.f, 0.f, 0.f, 0.f, 0.f, 0.f, 0.f, 0.f, 0.f, 0.f, 0.f, 0.f, 0.f};
#pragma unroll
        for (int ks = 0; ks < 4; ++ks) s = __builtin_amdgcn_mfma_f32_32x32x16_bf16(kf[ks], qf[qt][ks], s, 0, 0, 0);
        if (MASK) {
#pragma unroll
            for (int r = 0; r < 16; ++r) { const int dd = dq0 - 32 * qt + crow(r, hi); if (dd > 128 || dd < -128) s[r] = -INFINITY; }
        }
        float mx = s[0];
#pragma unroll
        for (int r = 1; r < 16; ++r) mx = fmaxf(mx, s[r]);
        mx = fmaxf(mx, __shfl_xor(mx, 32));
        const float mn = fmaxf(mrun[qt], mx), f = __builtin_amdgcn_exp2f(mrun[qt] - mn); mrun[qt] = mn;
        float ps = 0.f;
#pragma unroll
        for (int r = 0; r < 16; ++r) { const float p = __builtin_amdgcn_exp2f(s[r] - mn); s[r] = p; ps += p; }
        lrun[qt] = lrun[qt] * f + ps;
#pragma unroll
        for (int dt = 0; dt < 2; ++dt) o[qt][dt] = o[qt][dt] * f;
        bf16x8 pb[2];
#pragma unroll
        for (int s2 = 0; s2 < 2; ++s2) { v4u w; w.x = cvt_pk_bf16(s[8 * s2 + 0], s[8 * s2 + 1]); w.y = cvt_pk_bf16(s[8 * s2 + 2], s[8 * s2 + 3]); w.z = cvt_pk_bf16(s[8 * s2 + 4], s[8 * s2 + 5]); w.w = cvt_pk_bf16(s[8 * s2 + 6], s[8 * s2 + 7]);
            pb[s2] = __builtin_bit_cast(bf16x8, w); }
#pragma unroll
        for (int dt = 0; dt < 2; ++dt)
#pragma unroll
            for (int s2 = 0; s2 < 2; ++s2) o[qt][dt] = __builtin_amdgcn_mfma_f32_32x32x16_bf16(vf[dt][s2], pb[s2], o[qt][dt], 0, 0, 0);
    }
}
__device__ __forceinline__ void attn_unit(Frame& F, int b, int kvh, int qb) {
    LAS unsigned char* lds = F.lds;
    const int tid = F.tid, lane = F.lane, w = F.wave, r32 = lane & 31, hi = lane >> 5;
    const int h = kvh * 4 + (w >> 1), s0 = qb * 128, q0 = s0 + 64 * (w & 1);
    bf16x8 qf[2][4];
#pragma unroll
    for (int qt = 0; qt < 2; ++qt)
#pragma unroll
        for (int ks = 0; ks < 4; ++ks) qf[qt][ks] = *(const GAS bf16x8*)(F.Q + (size_t)(b * SEQ + q0 + 32 * qt + r32) * QW + h * 64 + 16 * ks + 8 * hi);
    float mrun[2] = {-INFINITY, -INFINITY}, lrun[2] = {0.f, 0.f};
    f32x16 o[2][2];
#pragma unroll
    for (int qt = 0; qt < 2; ++qt)
#pragma unroll
        for (int dt = 0; dt < 2; ++dt)
#pragma unroll
            for (int r = 0; r < 16; ++r) o[qt][dt][r] = 0.f;
    {
        LAS unsigned char* Kl = lds; LAS unsigned char* Vl = lds + 36864;
#pragma unroll
        for (int i = 0; i < 4; ++i) { const int idx = tid + 512 * i; { const int row = idx >> 3, ch = idx & 7; *(LAS v4u*)(Kl + row * 144 + ch * 16) = *(const GAS v4u*)(F.KC + (size_t)(b * CTXL + row) * KVW + kvh * 64 + ch * 8); }
            { const int row = idx >> 5, ch = idx & 31; *(LAS v4u*)(Vl + row * 528 + ch * 16) = *(const GAS v4u*)(F.VTC + (size_t)((b * 2 + kvh) * 64 + row) * CTXL + ch * 8); } }
        __syncthreads();
        for (int st = 0; st < 8; ++st) attn_step<false>(Kl, Vl, 528, 32 * st, qf, mrun, lrun, o, r32, hi, 0);
        __syncthreads();
    }
    {
        LAS unsigned char* Kl = lds; LAS unsigned char* Vl = lds + 55296; const int kbase = s0 - 128;
#pragma unroll
        for (int i = 0; i < 6; ++i) { const int idx = tid + 512 * i; { const int row = idx >> 3, ch = idx & 7, kp = kbase + row; if (kp >= 0 && kp < SEQ) *(LAS v4u*)(Kl + row * 144 + ch * 16) = *(const GAS v4u*)(F.K + (size_t)(b * SEQ + kp) * KVW + kvh * 64 + ch * 8); }
            { const int row = idx / 48, ch = idx % 48, kp = kbase + 8 * ch; if (kp >= 0 && kp < SEQ) *(LAS v4u*)(Vl + row * 784 + ch * 16) = *(const GAS v4u*)(F.VT + (size_t)((b * 2 + kvh) * 64 + row) * SEQ + kp); } }
        __syncthreads();
        for (int st = 0; st < 10; ++st) { const int kp0 = q0 - 128 + 32 * st; if (kp0 < 0 || kp0 >= SEQ) continue;
            attn_step<true>(Kl, Vl, 784, kp0 - kbase, qf, mrun, lrun, o, r32, hi, kp0 - q0 - r32); }
        __syncthreads();
    }
    const float sk = F.sink[h] * LOG2E;
#pragma unroll
    for (int qt = 0; qt < 2; ++qt) { float l = lrun[qt] + __shfl_xor(lrun[qt], 32); l += __builtin_amdgcn_exp2f(sk - mrun[qt]); const float inv = 1.f / l;
        bf16* op = F.ATT + (size_t)(b * SEQ + q0 + 32 * qt + r32) * QW + h * 64;
#pragma unroll
        for (int dt = 0; dt < 2; ++dt)
#pragma unroll
            for (int rg = 0; rg < 4; ++rg) { u32x2 wv; wv.x = cvt_pk_bf16(o[qt][dt][4 * rg] * inv, o[qt][dt][4 * rg + 1] * inv); wv.y = cvt_pk_bf16(o[qt][dt][4 * rg + 2] * inv, o[qt][dt][4 * rg + 3] * inv);
                *(GAS u32x2*)(op + 32 * dt + 8 * rg + 4 * hi) = wv; } }
}

constexpr int HZ_PITCH = 4112, HG_OFF = 16 * HZ_PITCH  , HG_PITCH = 8224;
__device__ __forceinline__ void hy_load_filter(LAS unsigned char* GC, const bf16* G, int tid) {
    const GAS v4u* gp = (const GAS v4u*)G;
    const v4u a = gp[tid]; v4u b = {0u, 0u, 0u, 0u}; if (tid < 511) b = gp[tid + 1];
    const unsigned w[8] = {a.x, a.y, a.z, a.w, b.x, b.y, b.z, b.w};
#pragma unroll
    for (int rho = 0; rho < 8; ++rho) { v4u o; unsigned t[4];
#pragma unroll
        for (int dd = 0; dd < 4; ++dd) { const int base = (rho >> 1) + dd; t[dd] = (rho & 1) ? __builtin_amdgcn_alignbit(w[base + 1 > 7 ? 7 : base + 1], w[base], 16) : w[base]; }
        o.x = t[0]; o.y = t[1]; o.z = t[2]; o.w = t[3];
        *(LAS v4u*)(GC + rho * HG_PITCH + tid * 16) = o; }
}
__device__ __forceinline__ f32x4 hy_short4(const bf16* up, int t, float w0, float w1, float w2, float bs) {
    const u32x2 v = *(const GAS u32x2*)(up + t);
    const float u0 = bflo(v.x), u1 = bfhi(v.x), u2 = bflo(v.y), u3 = bfhi(v.y);
    const float um = t > 0 ? bf2f(up[t - 1]) : 0.f, up4 = t + 4 < SEQ ? bf2f(up[t + 4]) : 0.f;
    f32x4 r; r[0] = bs + w0 * um + w1 * u0 + w2 * u1; r[1] = bs + w0 * u0 + w1 * u1 + w2 * u2; r[2] = bs + w0 * u1 + w1 * u2 + w2 * u3; r[3] = bs + w0 * u2 + w1 * u3 + w2 * up4; return r;
}
__device__ __forceinline__ void hy_conv(const LAS unsigned char* Z, const LAS unsigned char* GC, int T0, int fr, int fq, f32x4 (&acc)[16]) {
    const int rho = (8 - (fr & 7)) & 7;
    const LAS unsigned char* gb = GC + rho * HG_PITCH + (2048 - fr + 8 * fq - rho - T0) * 2;
    const LAS unsigned char* zb = Z + fr * HZ_PITCH + fq * 16;
    bf16x8 W[16], Bf, nA0, nA1, nB;
#pragma unroll
    for (int m = 0; m < 16; ++m) { W[m] = *(const LAS bf16x8*)(gb + (-16 * m) * 2); acc[m] = (f32x4){0.f, 0.f, 0.f, 0.f}; }
    Bf = *(const LAS bf16x8*)zb;
    for (int jj = 0; jj < 8; ++jj) {
#pragma unroll
        for (int ji = 0; ji < 8; ++ji) {
            const int j = 8 * jj + ji, jn = j + 1 < 64 ? j + 1 : 63;
            nA0 = *(const LAS bf16x8*)(gb + (32 * jn) * 2); nA1 = *(const LAS bf16x8*)(gb + (32 * jn - 16) * 2); nB = *(const LAS bf16x8*)(zb + 64 * jn);
#pragma unroll
            for (int m = 0; m < 16; ++m) acc[m] = __builtin_amdgcn_mfma_f32_16x16x32_bf16(W[(m - 2 * ji) & 15], Bf, acc[m], 0, 0, 0);
            W[(-2 * (ji + 1)) & 15] = nA0; W[(1 - 2 * (ji + 1)) & 15] = nA1; Bf = nB;
        }
    }
}
__device__ __forceinline__ void hyena_channel(Frame& F, int c) {
    LAS unsigned char* Z = F.lds; LAS unsigned char* GC = F.lds + HG_OFF;
    const int tid = F.tid, lane = F.lane, fr = lane & 15, fq = lane >> 4, T0 = 256 * F.wave;
    { const int cv = 1024 + c; const float w0 = F.cw[cv], w1 = F.cw[1536 + cv], w2 = F.cw[3072 + cv], bs = F.cb[cv];
#pragma unroll 2
      for (int i = 0; i < 8; ++i) { const int chunk = tid + 512 * i, b = chunk >> 8, tc = (chunk & 255) * 8; const bf16* up = F.UT + (size_t)cv * T + b * SEQ;
          const f32x4 a = hy_short4(up, tc, w0, w1, w2, bs), d = hy_short4(up, tc + 4, w0, w1, w2, bs);
          v4u o; o.x = pk2(a[0], a[1]); o.y = pk2(a[2], a[3]); o.z = pk2(d[0], d[1]); o.w = pk2(d[2], d[3]);
          *(LAS v4u*)(Z + b * HZ_PITCH + tc * 2) = o; } }
    hy_load_filter(GC, F.G_ + (size_t)c * 4096, tid);
    __syncthreads();
    f32x4 acc[16];
    hy_conv(Z, GC, T0, fr, fq, acc);
    { const float w0 = F.cw[c], w1 = F.cw[1536 + c], w2 = F.cw[3072 + c], bs = F.cb[c], sk = F.skip[c]; const bf16* up = F.UT + (size_t)c * T + fr * SEQ;
#pragma unroll
      for (int m = 0; m < 16; ++m) { int t = T0 + 16 * m + 4 * fq; asm volatile("" : "+v"(t)); const u32x2 zo = *(const LAS u32x2*)(Z + fr * HZ_PITCH + t * 2); const f32x4 xs = hy_short4(up, t, w0, w1, w2, bs);
          acc[m][0] = xs[0] * (acc[m][0] + sk * bflo(zo.x)); acc[m][1] = xs[1] * (acc[m][1] + sk * bfhi(zo.x)); acc[m][2] = xs[2] * (acc[m][2] + sk * bflo(zo.y)); acc[m][3] = xs[3] * (acc[m][3] + sk * bfhi(zo.y)); } }
    __syncthreads();
#pragma unroll
    for (int m = 0; m < 16; ++m) { const int t = T0 + 16 * m + 4 * fq; u32x2 wv; wv.x = pk2(acc[m][0], acc[m][1]); wv.y = pk2(acc[m][2], acc[m][3]); *(LAS u32x2*)(Z + fr * HZ_PITCH + t * 2) = wv; }
    hy_load_filter(GC, F.G_ + (size_t)(512 + c) * 4096, tid);
    __syncthreads();
    hy_conv(Z, GC, T0, fr, fq, acc);
    { const int cx = 512 + c; const float w0 = F.cw[cx], w1 = F.cw[1536 + cx], w2 = F.cw[3072 + cx], bs = F.cb[cx], sk = F.skip[512 + c]; const bf16* up = F.UT + (size_t)cx * T + fr * SEQ;
      bf16* hp = F.ATT + (size_t)T * QW + (size_t)(fr * SEQ) * HYW + c;
#pragma unroll
      for (int m = 0; m < 16; ++m) { int t = T0 + 16 * m + 4 * fq; asm volatile("" : "+v"(t)); const u32x2 zo = *(const LAS u32x2*)(Z + fr * HZ_PITCH + t * 2); const f32x4 xs = hy_short4(up, t, w0, w1, w2, bs);
          hp[(size_t)(t + 0) * HYW] = (bf16)f2bf(xs[0] * (acc[m][0] + sk * bflo(zo.x))); hp[(size_t)(t + 1) * HYW] = (bf16)f2bf(xs[1] * (acc[m][1] + sk * bfhi(zo.x)));
          hp[(size_t)(t + 2) * HYW] = (bf16)f2bf(xs[2] * (acc[m][2] + sk * bflo(zo.y))); hp[(size_t)(t + 3) * HYW] = (bf16)f2bf(xs[3] * (acc[m][3] + sk * bfhi(zo.y))); } }
    __syncthreads();
}

__device__ __forceinline__ void xmid_row(Frame& F, int row, f32x4 (&xm)[4]) {
    const GAS f32x4* vr = (const GAS f32x4*)(F.V1 + (size_t)row * D) + F.lane;
    float s = 0.f;
#pragma unroll
    for (int j = 0; j < 4; ++j) { xm[j] = vr[64 * j]; s += (xm[j].x + xm[j].y) + (xm[j].z + xm[j].w); }
    const float mean = wave_sum(s) * (1.f / D); float s2 = 0.f;
#pragma unroll
    for (int j = 0; j < 4; ++j) { xm[j] = xm[j] - mean; s2 += (xm[j].x * xm[j].x + xm[j].y * xm[j].y) + (xm[j].z * xm[j].z + xm[j].w * xm[j].w); }
    const float rstd = 1.f / sqrtf(wave_sum(s2) * (1.f / D) + LN_EPS);
#pragma unroll
    for (int j = 0; j < 4; ++j) { const int col = 4 * F.lane + 256 * j; xm[j] = xm[j] * rstd * *(const f32x4*)(F.ln1g + col) + *(const f32x4*)(F.ln1b + col); }
}
__device__ __forceinline__ void p6_route(Frame& F) {
    LAS float* RW = (LAS float*)F.lds;
    LAS int* rec = (LAS int*)(F.lds + 131072);
    LAS float* recg = (LAS float*)(F.lds + 131072 + 2048);
    LAS int* lcnt = (LAS int*)(F.lds + 131072 + 4096);
    LAS int* lbase = lcnt + 32;
    const int tid = F.tid, lane = F.lane, w = F.wave;
    for (int i = tid; i < 32768; i += NWAVES * 64) { const int col = i >> 5, e = i & 31, l = (col & 255) >> 2, j = col >> 8, q = col & 3; RW[(((j * 4 + q) * 8 + (e >> 2)) * 64 + l) * 4 + (e & 3)] = F.rw[i]; }
    if (tid < 32) lcnt[tid] = 0;
    __syncthreads();
    const float rbias = F.rb[lane >> 1];
    for (int chunk = blockIdx.x; chunk < 256; chunk += F.G) {
        const int b = chunk >> 4;
        for (int it = 0; it < 16; ++it) {
            const int rl = w * 16 + it, row = chunk * 128 + rl;
            f32x4 hm[4];
            xmid_row(F, row, hm);
            { float s = 0.f;
#pragma unroll
              for (int j = 0; j < 4; ++j) s += (hm[j].x + hm[j].y) + (hm[j].z + hm[j].w);
              const float mean = wave_sum(s) * (1.f / D); float s2 = 0.f;
#pragma unroll
              for (int j = 0; j < 4; ++j) { hm[j] = hm[j] - mean; s2 += (hm[j].x * hm[j].x + hm[j].y * hm[j].y) + (hm[j].z * hm[j].z + hm[j].w * hm[j].w); }
              const float rstd = 1.f / sqrtf(wave_sum(s2) * (1.f / D) + LN_EPS);
#pragma unroll
              for (int j = 0; j < 4; ++j) { const int col = 4 * lane + 256 * j; const f32x4 sc = *(const f32x4*)(F.modF + b * 6144 + 4096 + col), sh = *(const f32x4*)(F.modF + b * 6144 + 3072 + col);
                  hm[j] = hm[j] * rstd * (sc + 1.f) + sh; u32x2 wv; wv.x = pk2(hm[j].x, hm[j].y); wv.y = pk2(hm[j].z, hm[j].w); *(GAS u32x2*)(F.HM + (size_t)row * D + col) = wv; } }
            float acc[32];
#pragma unroll
            for (int e = 0; e < 32; ++e) acc[e] = 0.f;
#pragma unroll
            for (int jq = 0; jq < 16; ++jq) { const float hv = hm[jq >> 2][jq & 3];
#pragma unroll
                for (int ec = 0; ec < 8; ++ec) { const f32x4 w4 = *(const LAS f32x4*)(RW + ((jq * 8 + ec) * 64 + lane) * 4);
                    acc[4 * ec + 0] += hv * w4[0]; acc[4 * ec + 1] += hv * w4[1]; acc[4 * ec + 2] += hv * w4[2]; acc[4 * ec + 3] += hv * w4[3]; } }
#pragma unroll
            for (int sft = 5; sft >= 1; --sft) { const int half = 1 << (sft - 1), s = 1 << sft; const bool up = (lane & s) != 0;
#pragma unroll
                for (int i = 0; i < 16; ++i) if (i < half) { const float send = up ? acc[i] : acc[i + half], keep = up ? acc[i + half] : acc[i]; acc[i] = keep + __shfl_xor(send, s); } }
            float cur = acc[0] + __shfl_xor(acc[0], 1) + rbias;
            float tv[4]; int te[4];
#pragma unroll
            for (int k = 0; k < 4; ++k) { float mx = cur;
#pragma unroll
                for (int o = 2; o < 64; o <<= 1) mx = fmaxf(mx, __shfl_xor(mx, o));
                const unsigned long long mask = __ballot(cur == mx); const int src = __ffsll((long long)mask) - 1; te[k] = src >> 1; tv[k] = mx; if ((lane >> 1) == te[k]) cur = -INFINITY; }
            const float p1 = __expf(tv[1] - tv[0]), p2 = __expf(tv[2] - tv[0]), p3 = __expf(tv[3] - tv[0]), inv = 1.f / (1.f + p1 + p2 + p3);
            if (lane < 4) { const int es = lane == 0 ? te[0] : lane == 1 ? te[1] : lane == 2 ? te[2] : te[3]; const float gs = (lane == 0 ? 1.f : lane == 1 ? p1 : lane == 2 ? p2 : p3) * inv;
                const int rank = __hip_atomic_fetch_add(lcnt + es, 1, __ATOMIC_RELAXED, __HIP_MEMORY_SCOPE_WORKGROUP);
                rec[rl * 4 + lane] = es | (rank << 5); recg[rl * 4 + lane] = gs; }
        }
        __syncthreads();
        if (tid < 32) { const int cnt = lcnt[tid]; lbase[tid] = cnt ? (int)__hip_atomic_fetch_add(F.ctl + CW_CNT + tid, (unsigned)cnt, RLX_AGENT) : 0; }
        __syncthreads();
        { const int r = rec[tid], e = r & 31, pos = lbase[e] + (r >> 5), row = chunk * 128 + (tid >> 2);
          F.tok[e * 32768 + pos] = row; F.asg[row * 4 + (tid & 3)] = e * 32768 + pos; F.gw[row * 4 + (tid & 3)] = recg[tid]; }
        __syncthreads();
        if (tid < 32) lcnt[tid] = 0;
        __syncthreads();
    }
}
__device__ __forceinline__ void moe_tables(Frame& F) {
    LAS int* tp = (LAS int*)(F.lds + TP_OFF);
    if (F.tid == 0) { int a = 0;
        for (int e = 0; e < 32; ++e) { const int cnt = (int)__hip_atomic_load(F.ctl + CW_CNT + e, RLX_AGENT); tp[e] = a; tp[33 + e] = cnt; a += (cnt + 255) >> 8; }
        tp[32] = a; }
    __syncthreads();
}

__device__ __forceinline__ void p9_final(Frame& F) {
    const LAS int* tp = (const LAS int*)(F.lds + TP_OFF);
    const int lane = F.lane;
    for (int chunk = blockIdx.x; chunk < 256; chunk += F.G) {
        const int b = chunk >> 4;
        for (int it = 0; it < 16; ++it) {
            const int row = chunk * 128 + F.wave * 16 + it;
            f32x4 xm[4];
            xmid_row(F, row, xm);
            f32x4 f[4];
#pragma unroll
            for (int j = 0; j < 4; ++j) f[j] = (f32x4){0.f, 0.f, 0.f, 0.f};
#pragma unroll
            for (int k = 0; k < 4; ++k) { const int a = F.asg[row * 4 + k], e = a >> 15, pos = a & 32767; const float gwt = F.gw[row * 4 + k];
                const bf16* yp = F.YB + (size_t)(256 * tp[e] + pos) * D + 4 * lane;
#pragma unroll
                for (int j = 0; j < 4; ++j) { const u32x2 v = *(const GAS u32x2*)(yp + 256 * j); f[j][0] += gwt * bflo(v.x); f[j][1] += gwt * bfhi(v.x); f[j][2] += gwt * bflo(v.y); f[j][3] += gwt * bfhi(v.y); } }
            float s = 0.f;
#pragma unroll
            for (int j = 0; j < 4; ++j) { const int col = 4 * lane + 256 * j; const f32x4 g2 = *(const f32x4*)(F.modF + b * 6144 + 5120 + col); xm[j] = xm[j] * DN_ALPHA + g2 * f[j]; s += (xm[j].x + xm[j].y) + (xm[j].z + xm[j].w); }
            const float mean = wave_sum(s) * (1.f / D); float s2 = 0.f;
#pragma unroll
            for (int j = 0; j < 4; ++j) { xm[j] = xm[j] - mean; s2 += (xm[j].x * xm[j].x + xm[j].y * xm[j].y) + (xm[j].z * xm[j].z + xm[j].w * xm[j].w); }
            const float rstd = 1.f / sqrtf(wave_sum(s2) * (1.f / D) + LN_EPS);
#pragma unroll
            for (int j = 0; j < 4; ++j) { const int col = 4 * lane + 256 * j; *(GAS f32x4*)(F.out + (size_t)row * D + col) = xm[j] * rstd * *(const f32x4*)(F.ln2g + col) + *(const f32x4*)(F.ln2b + col); }
        }
    }
}

struct Args { const float* in[29]; float* out; unsigned char* ws; int ph_lo, ph_hi; };
__global__ void __launch_bounds__(NWAVES * 64, 2) mk_fwd(Args args) {
    extern __shared__ __attribute__((aligned(16))) unsigned char lds[];
    Frame F;
    F.lds = (LAS unsigned char*)lds;
    F.MISC = (volatile LAS unsigned*)(F.lds + MISC_OFF);
    F.tid = threadIdx.x; F.lane = F.tid & 63; F.wave = __builtin_amdgcn_readfirstlane(F.tid >> 6);
    F.G = gridDim.x; { const int bx = blockIdx.x; F.vcu = (F.G % 8 == 0) ? (bx % 8) * (F.G / 8) + bx / 8 : bx; }
    unsigned char* ws = args.ws;
    F.ctl = (gu32*)(ws + WS_CTL);
    F.x = args.in[0]; F.c = args.in[1]; F.ctx = args.in[2]; F.c_ctx = args.in[3]; F.w_mod = args.in[4]; F.b_mod = args.in[5]; F.w_in = args.in[6]; F.sink = args.in[7];
    F.cw = args.in[8]; F.cb = args.in[9]; F.fw1 = args.in[10]; F.fb1 = args.in[11]; F.fw2 = args.in[12]; F.fb2 = args.in[13]; F.fw3 = args.in[14]; F.skip = args.in[15];
    F.w_ba = args.in[16]; F.w_bh = args.in[17]; F.w_out = args.in[18]; F.ln1g = args.in[19]; F.ln1b = args.in[20]; F.rw = args.in[21]; F.rb = args.in[22];
    F.ew1 = args.in[23]; F.eb1 = args.in[24]; F.ew2 = args.in[25]; F.eb2 = args.in[26]; F.ln2g = args.in[27]; F.ln2b = args.in[28]; F.out = args.out;
    F.modP = (float*)(ws + WS_MODP); F.modF = (float*)(ws + WS_MODF); F.rope = (float*)(ws + WS_ROPE); F.gw = (float*)(ws + WS_GW); F.V1 = (float*)(ws + WS_V1);
    F.asg = (int*)(ws + WS_ASG); F.tok = (int*)(ws + WS_TOK);
    F.G_ = (bf16*)(ws + WS_G); F.WB = (bf16*)(ws + WS_WB); F.WO = (bf16*)(ws + WS_WO); F.WIN = (bf16*)(ws + WS_WIN); F.W1 = (bf16*)(ws + WS_W1); F.W2 = (bf16*)(ws + WS_W2);
    F.HM = (bf16*)(ws + WS_HM); F.HX = (bf16*)(ws + WS_HX); F.Q = (bf16*)(ws + WS_Q); F.K = (bf16*)(ws + WS_K); F.VT = (bf16*)(ws + WS_VT); F.KC = (bf16*)(ws + WS_KC); F.VTC = (bf16*)(ws + WS_VTC);
    F.UT = (bf16*)(ws + WS_UT); F.GATE = (bf16*)(ws + WS_GATE); F.ATT = (bf16*)(ws + WS_ATT); F.MM = (bf16*)(ws + WS_MM); F.ACT = (bf16*)(ws + WS_ACT); F.YB = (bf16*)(ws + WS_YB);
    for (int u = F.tid; u < (LDS_BYTES - LDSCTL_OFF) / 4; u += NWAVES * 64) ((LAS unsigned*)(F.lds + LDSCTL_OFF))[u] = 0u;
    __syncthreads();
    XcdBarrier bar; bar.bar = (unsigned*)(F.ctl + CW_BAR); bar.x = 0; bar.st = nullptr;
    if (N_LAUNCHES == 1) bar = xcd_barrier_post((unsigned*)(F.ctl + CW_BAR), F.MISC + 8);
#define GRID_BAR() do { if (N_LAUNCHES == 1) xcd_barrier(bar); } while (0)
    const int lo = args.ph_lo, hi = args.ph_hi;
#ifndef PHMASK
#define PHMASK 0x3ff
#endif
#define IN(k) (((PHMASK >> (k)) & 1) && lo <= (k) && (k) < hi)
#define BOTH(k) (IN(k) && IN((k) + 1))
    const int bx = (int)blockIdx.x;

    if (IN(0)) { p0_prologue(F); if (BOTH(0)) GRID_BAR(); }
    if (IN(1)) { p1_rows(F); if (BOTH(1)) GRID_BAR(); }
    if (IN(2)) {
        pg8::Gemm g{F.HX, F.WIN, 1024}; SchedInProj S; S.so.init(128, 17, F.G, bx); S.G = F.G; S.c = bx;
        EpiInProj E{F.Q, F.K, F.VT, F.KC, F.VTC, F.UT, F.GATE, F.rope};
        pg8::gemm_phase<EpiInProj, SchedInProj, true, false>(F.lds, g, S, E);
        if (BOTH(2)) GRID_BAR();
    }
    if (IN(3)) {
#ifndef NO_ATTN
        for (int u = bx; u < 512; u += F.G) attn_unit(F, u >> 5, (u >> 4) & 1, u & 15);
#endif
#ifndef NO_HY
        for (int ch = F.vcu; ch < 512; ch += F.G) hyena_channel(F, ch);
#endif
        if (BOTH(3)) GRID_BAR();
    }
    if (IN(4)) {
        pg8::Gemm g{F.ATT, F.WB, 512}; SchedPair S; S.so.init(128, 4, F.G, bx);
        EpiMerge E{F.GATE, F.MM};
        pg8::gemm_phase<EpiMerge, SchedPair, true, false>(F.lds, g, S, E);
        if (BOTH(4)) GRID_BAR();
    }
    if (IN(5)) {
        pg8::Gemm g{F.MM, F.WO, 1024}; SchedPlain S; S.so.init(128, 4, F.G, bx);
        EpiV1 E{F.x, F.modF, F.V1};
        pg8::gemm_phase<EpiV1, SchedPlain, true, false>(F.lds, g, S, E);
        if (BOTH(5)) GRID_BAR();
    }
    if (IN(6)) { p6_route(F); if (BOTH(6)) GRID_BAR(); }
    if (IN(7)) {
        moe_tables(F);
        pg8::Gemm g{F.HM, F.W1, 1024}; SchedMoe S{(const LAS int*)(F.lds + TP_OFF), F.tok, 8, F.G, bx};
        EpiAct E{F.eb1, F.ACT};
        pg8::gemm_phase<EpiAct, SchedMoe, true, true>(F.lds, g, S, E);
        if (BOTH(7)) GRID_BAR();
    }
    if (IN(8)) {
        moe_tables(F);
        pg8::Gemm g{F.ACT, F.W2, 1024}; SchedMoe S{(const LAS int*)(F.lds + TP_OFF), F.tok, 4, F.G, bx};
        EpiYb E{F.eb2, F.YB};
        pg8::gemm_phase<EpiYb, SchedMoe, true, false>(F.lds, g, S, E);
        if (BOTH(8)) GRID_BAR();
    }
    if (IN(9)) { moe_tables(F); p9_final(F); }
#undef IN
#undef BOTH
#undef GRID_BAR
}

extern "C" void kernel_launch(void* const* d_in, const int* in_sizes, int n_in, void* d_out, int out_size, void* d_ws, size_t ws_size, hipStream_t stream) {
    static int grid = 0;
    if (grid == 0) {
        if (n_in != 29 || in_sizes[0] != T * D || out_size != T * D || ws_size < WS_END) { fprintf(stderr, "kernel_launch: unexpected shapes (n_in %d, in0 %d, out %d, ws %zu); nothing launched\n", n_in, n_in > 0 ? in_sizes[0] : -1, out_size, ws_size); grid = -1; return; }
        int dev = 0, cus = 0, per_cu = 0;
        if (hipGetDevice(&dev) != hipSuccess || hipDeviceGetAttribute(&cus, hipDeviceAttributeMultiprocessorCount, dev) != hipSuccess) { grid = -1; return; }
        if (hipFuncSetAttribute((const void*)mk_fwd, hipFuncAttributeMaxDynamicSharedMemorySize, LDS_BYTES) != hipSuccess) { fprintf(stderr, "kernel_launch: hipFuncSetAttribute failed\n"); grid = -1; return; }
        if (hipOccupancyMaxActiveBlocksPerMultiprocessor(&per_cu, (const void*)mk_fwd, NWAVES * 64, LDS_BYTES) != hipSuccess || per_cu < 1) { fprintf(stderr, "kernel_launch: occupancy query reports %d workgroups per CU\n", per_cu); }
        (void)hipGetLastError();
        grid = cus < 256 ? cus : 256;
    }
    if (grid < 0) return;
    if (hipMemsetAsync((char*)d_ws + WS_CTL, 0, CTL_ZERO_BYTES, stream) != hipSuccess) return;
    Args a{};
    for (int i = 0; i < 29; ++i) a.in[i] = (const float*)d_in[i];
    a.out = (float*)d_out; a.ws = (unsigned char*)d_ws;
    if (N_LAUNCHES == 1) { a.ph_lo = 0; a.ph_hi = NPH; hipLaunchKernelGGL(mk_fwd, dim3(grid), dim3(NWAVES * 64), LDS_BYTES, stream, a); }
    else for (int p = 0; p < NPH; ++p) { a.ph_lo = p; a.ph_hi = p + 1; hipLaunchKernelGGL(mk_fwd, dim3(grid), dim3(NWAVES * 64), LDS_BYTES, stream, a); }
}
```

```cpp
#include <hip/hip_runtime.h>
#define MK_N_LAUNCHES 1
#include <cstdio>
#include <cstdint>
#include <cmath>
namespace pg8 {
#define PG8_LAS __attribute__((address_space(3)))
typedef unsigned short bf16_t;
typedef short bf16x8 __attribute__((ext_vector_type(8)));
typedef float f32x4 __attribute__((ext_vector_type(4)));
typedef unsigned u32x4 __attribute__((ext_vector_type(4)));
constexpr int BM = 256, BK = 64, HALF = 128, HTB = HALF * BK * 2  , STAGE_BYTES = 8 * HTB, NXCD = 8, WGM = 8;

__host__ __device__ __forceinline__ int lds_byte(int r, int c) { const int st = (r >> 4) * 2 + (c >> 5), rr = r & 15, cc = c & 31, ob = rr * 64 + cc * 2; return st * 1024 + (ob ^ (((ob >> 9) & 1) << 5)); }
__host__ __device__ __forceinline__ void stage_rc(int b, int& R, int& C) { const int st = b / 1024, sb = b % 1024, swz = sb ^ (((sb >> 9) & 1) << 5); R = (st >> 1) * 16 + swz / 64; C = (st & 1) * 32 + (swz % 64) / 2; }
__host__ __device__ __forceinline__ int perm32(int rho) { const int n = rho >> 4, i = rho & 15; return 8 * (i >> 2) + 4 * n + (i & 3); }

struct Unit { int pm, pn; };
struct Gemm { const bf16_t* A; const bf16_t* Bt; int K; int wave; };

struct StaticOrder {
    int nM, nN, nwg, G, c, wgm = WGM;
    __host__ __device__ void init(int nM_, int nN_, int G_, int c_) { nM = nM_; nN = nN_; nwg = nM * nN; G = G_; c = c_; }
    __host__ __device__ bool next(int i, Unit& u) const {
        const long L = (long)i * G + c; if (L >= nwg) return false;
        int wgid = (int)L; { const int q = nwg / NXCD, r = nwg % NXCD, xcd = wgid % NXCD, off = wgid / NXCD; wgid = (xcd < r ? xcd * (q + 1) : r * (q + 1) + (xcd - r) * q) + off; }
        const int nig = wgm * nN, gid = wgid / nig, fm = gid * wgm, gsz = (nM - fm) < wgm ? (nM - fm) : wgm;
        u.pm = fm + ((wgid % nig) % gsz); u.pn = (wgid % nig) / gsz; return true;
    }
};

typedef float f32x2_cv __attribute__((ext_vector_type(2))); typedef __bf16 bf16x2_cv __attribute__((ext_vector_type(2)));
__device__ __forceinline__ unsigned cvt_pk_bf16(float lo, float hi) { const f32x2_cv v = {lo, hi}; const bf16x2_cv b = __builtin_convertvector(v, bf16x2_cv); return __builtin_bit_cast(unsigned, b); }

__device__ __forceinline__ int lane_id_v() { int l; asm volatile("v_mbcnt_lo_u32_b32 %0, -1, 0\n\tv_mbcnt_hi_u32_b32 %0, -1, %0" : "=v"(l)); return l; }
typedef int i32x4_t __attribute__((ext_vector_type(4)));
typedef int i32x8_t __attribute__((ext_vector_type(8)));
__device__ __forceinline__ i32x8_t cat8(bf16x8 lo, bf16x8 hi) { const i32x4_t a = __builtin_bit_cast(i32x4_t, lo), b = __builtin_bit_cast(i32x4_t, hi); return __builtin_shufflevector(a, b, 0, 1, 2, 3, 4, 5, 6, 7); }
#ifndef PROBE_SPIN
#define PROBE_SPIN -1
#endif
#define PG8_PT_B(k) do { if (PROBE_SPIN == (k) && FP8 && !GATHER && tid == 0) pt_t0 = __builtin_amdgcn_s_memrealtime(); } while (0)
#define PG8_PT_E(k) do { if (PROBE_SPIN == (k) && FP8 && !GATHER && tid == 0) *(volatile PG8_LAS unsigned long long*)(lds + 153600) += __builtin_amdgcn_s_memrealtime() - pt_t0; } while (0)
template <class Epi, class Sched, bool ALIGN_EPI, bool GATHER, bool FP8 = false>
__device__ __forceinline__ void gemm_phase(PG8_LAS unsigned char* lds, const Gemm g, const Sched& S, const Epi& E) {
    const int wid = g.wave, lane = lane_id_v(), tid = wid * 64 + lane, wr = wid >> 2, wc = wid & 3, fr = lane & 15, fq = lane >> 4;
    const int K = g.K, nt = K / BK;
    unsigned voffA[2], voffB[2]; int gR[2]; unsigned gC[2];
#pragma unroll
    for (int i = 0; i < 2; ++i) { int R, C; stage_rc(tid * 16 + i * 8192, R, C); const int Rb = Epi::PERM ? ((R & ~31) + perm32(R & 31)) : R;
        voffA[i] = (unsigned)(R * K + C) * 2u; voffB[i] = (unsigned)(Rb * K + C) * 2u; gR[i] = R; gC[i] = (unsigned)C * 2u; }
    const size_t kstep = (size_t)(BK * 2);
    const size_t hstep = (size_t)HALF * K * 2;
    const size_t tstep = 2 * hstep;
    const size_t r64 = (size_t)64 * K * 2;
    const unsigned ldsw = (unsigned)wid * 1024u;
    const int aoff = lds_byte(wr * 64 + fr, fq * 8), boff = lds_byte(wc * 32 + fr, fq * 8);
#define PG8_SA(b, h) (((b) * 2 + (h)) * HTB)
#define PG8_SB(b, h) ((4 + (b) * 2 + (h)) * HTB)
#define PG8_STAGE(bufoff, gbase, voff) do { _Pragma("unroll") for (int _i = 0; _i < 2; ++_i) { unsigned v_ = (voff)[0]; if constexpr (FP8 && GATHER) asm volatile("" : "+v"(v_)); \
        __builtin_amdgcn_global_load_lds((const unsigned*)((const char*)(gbase) + (size_t)_i * r64 + v_), (PG8_LAS unsigned*)(lds + (bufoff) + ldsw + _i * 8192), 16, 0, 0); } } while (0)
#define PG8_STAGE_G(bufoff, gbase, pk) do { _Pragma("unroll") for (int _i = 0; _i < 2; ++_i) { unsigned p_ = (pk); asm volatile("" : "+v"(p_));   \
        __builtin_amdgcn_global_load_lds((const unsigned*)((const char*)(gbase) + (((p_ >> (16 * _i)) & 0xffffu) * (unsigned)(K * 2) + gC[0])), (PG8_LAS unsigned*)(lds + (bufoff) + ldsw + _i * 8192), 16, 0, 0); } } while (0)
#define PG8_STAGE_A(b, h, kp, VS) do { if constexpr (GATHER) { PG8_STAGE_G(PG8_SA(b, h), (kp), VS[h]); } else { PG8_STAGE(PG8_SA(b, h), (kp) + (size_t)(h) * hstep, voffA); } } while (0)
#define PG8_LDA(dst, b, h) do { _Pragma("unroll") for (int m = 0; m < 4; ++m) { if constexpr (FP8) { dst##8[m] = __builtin_shufflevector(*(const PG8_LAS i32x4_t*)(lds + PG8_SA(b, h) + aoff + m * 2048), *(const PG8_LAS i32x4_t*)(lds + PG8_SA(b, h) + aoff + m * 2048 + 1024), 0, 1, 2, 3, 4, 5, 6, 7); } \
        else { _Pragma("unroll") for (int k = 0; k < 2; ++k) dst[m][k] = *(const PG8_LAS bf16x8*)(lds + PG8_SA(b, h) + aoff + m * 2048 + k * 1024); } } } while (0)
#define PG8_LDB(dst, b, h) do { _Pragma("unroll") for (int n = 0; n < 2; ++n) { if constexpr (FP8) { dst##8[n] = __builtin_shufflevector(*(const PG8_LAS i32x4_t*)(lds + PG8_SB(b, h) + boff + n * 2048), *(const PG8_LAS i32x4_t*)(lds + PG8_SB(b, h) + boff + n * 2048 + 1024), 0, 1, 2, 3, 4, 5, 6, 7); } \
        else { _Pragma("unroll") for (int k = 0; k < 2; ++k) dst[n][k] = *(const PG8_LAS bf16x8*)(lds + PG8_SB(b, h) + boff + n * 2048 + k * 1024); } } } while (0)
#define PG8_MMA(ai, bj, At, Bt) do { __builtin_amdgcn_s_setprio(1); _Pragma("unroll") for (int m = 0; m < 4; ++m) _Pragma("unroll") for (int n = 0; n < 2; ++n) { \
        if constexpr (FP8) { acc[ai][bj][m][n] = __builtin_amdgcn_mfma_scale_f32_16x16x128_f8f6f4(Bt##8[n], At##8[m], acc[ai][bj][m][n], 0, 0, 0, 0, 0, 0); } \
        else { _Pragma("unroll") for (int k = 0; k < 2; ++k) acc[ai][bj][m][n] = __builtin_amdgcn_mfma_f32_16x16x32_bf16(Bt[n][k], At[m][k], acc[ai][bj][m][n], 0, 0, 0); } } __builtin_amdgcn_s_setprio(0); } while (0)
#define PG8_WAIT_V(n) asm volatile("s_waitcnt vmcnt(" #n ")" ::: "memory")
#define PG8_WAIT_L(n) asm volatile("s_waitcnt lgkmcnt(" #n ")" ::: "memory")
#define PG8_BAR __builtin_amdgcn_s_barrier()
#define PG8_SCHED __builtin_amdgcn_sched_barrier(0)
    unsigned long long pt_t0 = 0;
    Unit cur, nxt; int ui = 0;
    if (!S.next(0, cur)) return;
    f32x4 acc[2][2][4][2];
#pragma unroll
    for (int a = 0; a < 2; ++a)
#pragma unroll
        for (int b = 0; b < 2; ++b)
#pragma unroll
            for (int m = 0; m < 4; ++m)
#pragma unroll
                for (int n = 0; n < 2; ++n) acc[a][b][m][n] = (f32x4){0.f, 0.f, 0.f, 0.f};
    bf16x8 At[4][2], B0[2][2], B1[2][2]; i32x8_t At8[4], B08[2], B18[2];
    unsigned vAc[2];
    const char* cA = GATHER ? (const char*)g.A : (const char*)g.A + (size_t)cur.pm * tstep; const char* cB = (const char*)g.Bt + (size_t)cur.pn * tstep;
    if constexpr (GATHER) {
#pragma unroll
        for (int h = 0; h < 2; ++h) vAc[h] = (unsigned)S.rowoff(cur, h * HALF + gR[0]) | ((unsigned)S.rowoff(cur, h * HALF + gR[0] + 64) << 16);
    }
    PG8_STAGE(PG8_SB(0, 0), cB, voffB); PG8_STAGE(PG8_SB(0, 1), cB + hstep, voffB); PG8_STAGE_A(0, 0, cA, vAc); PG8_STAGE_A(0, 1, cA, vAc);
    if (wr == 1) PG8_BAR;
    PG8_WAIT_V(2); PG8_BAR;
    PG8_STAGE(PG8_SB(1, 0), cB + kstep, voffB); PG8_STAGE_A(1, 0, cA + kstep, vAc); PG8_STAGE(PG8_SB(1, 1), cB + hstep + kstep, voffB);
    PG8_WAIT_V(6); PG8_BAR;
    for (;;) {
        const bool has_next = S.next(ui + 1, nxt);
        const char* nA = GATHER ? cA : (has_next ? (const char*)g.A + (size_t)nxt.pm * tstep : cA); const char* nB = has_next ? (const char*)g.Bt + (size_t)nxt.pn * tstep : cB;
        int gr0 = 0, gr1 = 0, gr2 = 0, gr3 = 0;
        if constexpr (GATHER) {
            const int t_ = wid * 64 + lane_id_v(); int R_, C_; stage_rc(t_ * 16, R_, C_);
            if (has_next) { gr0 = S.rowoff(nxt, R_); gr1 = S.rowoff(nxt, R_ + 64); gr2 = S.rowoff(nxt, HALF + R_); gr3 = S.rowoff(nxt, HALF + R_ + 64); }
        }
#pragma unroll 1
        for (int t = 0; t < nt; t += 2) {
            const bool last = (t == nt - 2);
            const char* a1 = cA + (size_t)(t + 1) * kstep;
            const char* a2 = last ? nA : cA + (size_t)(t + 2) * kstep; const char* b2 = last ? nB : cB + (size_t)(t + 2) * kstep;
            const char* a3 = a2 + kstep; const char* b3 = b2 + kstep;
            PG8_LDB(B0, 0, 0); PG8_LDB(B1, 0, 1); PG8_SCHED; PG8_LDA(At, 0, 0); PG8_STAGE_A(1, 1, a1, vAc);
            if constexpr (GATHER) { if (last && has_next) { vAc[0] = (unsigned)gr0 | ((unsigned)gr1 << 16); vAc[1] = (unsigned)gr2 | ((unsigned)gr3 << 16); } }
            PG8_WAIT_V(8); PG8_WAIT_L(0); PG8_BAR; PG8_MMA(0, 0, At, B0); PG8_MMA(0, 1, At, B1); PG8_BAR; PG8_SCHED;
            PG8_LDA(At, 0, 1); PG8_STAGE(PG8_SB(0, 0), b2, voffB); PG8_STAGE(PG8_SB(0, 1), b2 + hstep, voffB); PG8_STAGE_A(0, 0, a2, vAc);
            PG8_WAIT_V(8); PG8_WAIT_L(0); PG8_BAR; PG8_MMA(1, 0, At, B0); PG8_MMA(1, 1, At, B1); PG8_BAR; PG8_SCHED;
            PG8_LDB(B0, 1, 0); PG8_LDB(B1, 1, 1); PG8_SCHED; PG8_LDA(At, 1, 0); PG8_STAGE_A(0, 1, a2, vAc);
            PG8_WAIT_V(8); PG8_WAIT_L(0); PG8_BAR; PG8_MMA(0, 0, At, B0); PG8_MMA(0, 1, At, B1); PG8_BAR; PG8_SCHED;
            PG8_LDA(At, 1, 1); PG8_STAGE(PG8_SB(1, 0), b3, voffB); PG8_STAGE(PG8_SB(1, 1), b3 + hstep, voffB); PG8_STAGE_A(1, 0, a3, vAc);
            PG8_WAIT_V(8); PG8_WAIT_L(0); PG8_BAR; PG8_MMA(1, 0, At, B0); PG8_MMA(1, 1, At, B1); PG8_BAR; PG8_SCHED;
        }
        PG8_PT_B(18);
        if constexpr (ALIGN_EPI) { if (wr == 0) PG8_BAR; }
        PG8_PT_B(19); { const int l_ = lane_id_v(); E(acc, cur, wr, wc, l_ & 15, l_ >> 4); } PG8_PT_E(19);
        if (!has_next) break;
#pragma unroll
        for (int a = 0; a < 2; ++a)
#pragma unroll
            for (int b = 0; b < 2; ++b)
#pragma unroll
                for (int m = 0; m < 4; ++m)
#pragma unroll
                    for (int n = 0; n < 2; ++n) acc[a][b][m][n] = (f32x4){0.f, 0.f, 0.f, 0.f};
        cur = nxt; cA = nA; cB = nB; ++ui;
        if constexpr (ALIGN_EPI) { if (wr == 1) PG8_BAR; }
        PG8_PT_E(18);
    }
    PG8_WAIT_V(0);
    if constexpr (!ALIGN_EPI) { if (wr == 0) PG8_BAR; }
    PG8_BAR;
#undef PG8_SA
#undef PG8_SB
#undef PG8_STAGE
#undef PG8_STAGE_A
#undef PG8_STAGE_G
#undef PG8_LDA
#undef PG8_LDB
#undef PG8_MMA
#undef PG8_WAIT_V
#undef PG8_WAIT_L
#undef PG8_BAR
#undef PG8_SCHED
}
}
#define GAS __attribute__((address_space(1)))
#define LAS __attribute__((address_space(3)))
typedef unsigned short bf16;
typedef unsigned v4u __attribute__((ext_vector_type(4)));
typedef float f32x4 __attribute__((ext_vector_type(4)));
typedef short bf16x8 __attribute__((ext_vector_type(8)));
typedef GAS unsigned gu32;
typedef GAS unsigned long long gu64;
#define RLX_AGENT __ATOMIC_RELAXED, __HIP_MEMORY_SCOPE_AGENT
#define LDS_WAIT() asm volatile("s_waitcnt lgkmcnt(0)" ::: "memory")
#define VM_WAIT() asm volatile("s_waitcnt vmcnt(0)" ::: "memory")
__device__ __forceinline__ unsigned long long rt() { return __builtin_amdgcn_s_memrealtime(); }
__device__ __forceinline__ unsigned f2bf(float f) { unsigned u = __builtin_bit_cast(unsigned, f); return (u + 0x7fffu + ((u >> 16) & 1u)) >> 16; }
__device__ __forceinline__ unsigned pk2(float lo, float hi) { return f2bf(lo) | (f2bf(hi) << 16); }

#define XB_TMO      128
#define XB_XCNT(j)  (256  + 64 * (j))
#define XB_XSUB(j)  (1280 + 64 * (j))
#define XB_XGEN(j)  (2304 + 64 * (j))
#define XB_TOP      3328
#define XB_TOPGEN   3392
#define XCD_BAR_WORDS 3456
#define XB_SPIN_CAP (1u << 18)

__device__ __forceinline__ unsigned xb_ld(unsigned* p)              { return __hip_atomic_load(p, __ATOMIC_RELAXED, __HIP_MEMORY_SCOPE_AGENT); }
__device__ __forceinline__ unsigned xb_add(unsigned* p, unsigned v) { return __hip_atomic_fetch_add(p, v, __ATOMIC_RELAXED, __HIP_MEMORY_SCOPE_AGENT); }
__device__ __forceinline__ unsigned xb_xcc_id() { return (unsigned)__builtin_amdgcn_s_getreg((3 << 11) | 20) & 0xFu; }
#define XB_SPIN(cond, bar) do { unsigned _sp = 0; while (cond) { __builtin_amdgcn_s_sleep(1); \
    if ((++_sp & 255u) == 0u) { if (xb_ld(&(bar)[XB_TMO])) break; if (_sp > XB_SPIN_CAP) { atomicAdd(&(bar)[XB_TMO], 1u); break; } } } } while (0)

struct XcdBarrier {
    unsigned* bar; unsigned x;
    volatile LAS unsigned* st;
};

__device__ __forceinline__ XcdBarrier xcd_barrier_post(unsigned* bar, volatile LAS unsigned* st) {
    XcdBarrier b; b.bar = bar; b.x = xb_xcc_id(); b.st = st;
    if (threadIdx.x == 0) (void)xb_add(&bar[XB_XCNT(b.x)], 1u);
    return b;
}
__device__ __forceinline__ void xcd_barrier_complete(unsigned* bar, unsigned x, unsigned& nloc, unsigned& nx) {
    const unsigned G = gridDim.x * gridDim.y * gridDim.z;
    unsigned sum, cnt, mine, sp = 0u;
    for (;;) {
        sum = 0u; cnt = 0u; mine = 0u;
#pragma unroll
        for (unsigned j = 0; j < 16; ++j) { const unsigned c = xb_ld(&bar[XB_XCNT(j)]); sum += c; cnt += (c > 0u) ? 1u : 0u; mine = (j == x) ? c : mine; }
        if (sum == G) break;
        __builtin_amdgcn_s_sleep(1);
        if ((++sp & 255u) == 0u) { if (xb_ld(&bar[XB_TMO])) break; if (sp > XB_SPIN_CAP) { atomicAdd(&bar[XB_TMO], 1u); break; } }
    }
    nloc = mine > 0u ? mine : 1u; nx = cnt > 0u ? cnt : 1u;
}

__device__ __forceinline__ void xcd_barrier(const XcdBarrier& b) {
    asm volatile("s_waitcnt vmcnt(0)" ::: "memory");
    __syncthreads();
    if (threadIdx.x == 0) {
        unsigned* bar = b.bar;
        __builtin_amdgcn_s_waitcnt(0);
        unsigned nloc = b.st[0], nx = b.st[1];
        if (nloc == 0u) { xcd_barrier_complete(bar, b.x, nloc, nx); b.st[0] = nloc; b.st[1] = nx; }
        const unsigned old = xb_add(&bar[XB_XSUB(b.x)], 1u);
        const unsigned gen = old / nloc;
        if (old + 1u == (gen + 1u) * nloc) {
            __builtin_amdgcn_fence(__ATOMIC_RELEASE, "agent");
            asm volatile("s_waitcnt vmcnt(0)" ::: "memory");
            const unsigned og = xb_add(&bar[XB_TOP], 1u);
            const unsigned tg = og / nx;
            if (og + 1u == (tg + 1u) * nx) xb_add(&bar[XB_TOPGEN], 1u);
            else XB_SPIN(xb_ld(&bar[XB_TOPGEN]) == tg, bar);
            __builtin_amdgcn_fence(__ATOMIC_ACQUIRE, "agent");
            xb_add(&bar[XB_XGEN(b.x)], 1u);
            asm volatile("s_waitcnt vmcnt(0)" ::: "memory");
        } else {
            XB_SPIN(xb_ld(&bar[XB_XGEN(b.x)]) == gen, bar);
            __builtin_amdgcn_fence(__ATOMIC_ACQUIRE, "agent");
            asm volatile("s_waitcnt vmcnt(0)" ::: "memory");
        }
    }
    __syncthreads();
}

constexpr int NWAVES = 8;
constexpr int D = 1024, NB = 16, SEQ = 2048, T = NB * SEQ, CTXL = 256, TC = NB * CTXL;
constexpr int QW = 512, KVW = 128, HYW = 512, INW = 4352, NE = 32, DFF = 1024;
constexpr float LN_EPS = 1e-5f;
constexpr float DN_ALPHA = 1.189207115002721f;
constexpr float LOG2E = 1.4426950408889634f;
constexpr float C2Q = 0.125f * LOG2E;
constexpr int NPH = 10;
#ifndef MK_N_LAUNCHES
#define MK_N_LAUNCHES 1
#endif
constexpr int N_LAUNCHES = MK_N_LAUNCHES;

constexpr size_t MiB = 1u << 20;
constexpr size_t WS_CTL = 0, CTL_ZERO_BYTES = 1 * MiB;
constexpr size_t WS_MODP = 1 * MiB;
constexpr size_t WS_MODF = 8 * MiB;
constexpr size_t WS_ROPE = 9 * MiB;
constexpr size_t WS_ASG = 10 * MiB;
constexpr size_t WS_GW = 10 * MiB + 512 * 1024;
constexpr size_t WS_TOK = 11 * MiB;
constexpr size_t WS_G = 16 * MiB;
constexpr size_t WS_WB = 24 * MiB;
constexpr size_t WS_WO = 26 * MiB;
constexpr size_t WS_WIN = 28 * MiB;
constexpr size_t WS_W1 = 40 * MiB;
constexpr size_t WS_W2 = 168 * MiB;
constexpr size_t WS_V1 = 232 * MiB;
constexpr size_t WS_HM = 360 * MiB;
constexpr size_t WS_HX = 424 * MiB;
constexpr size_t WS_Q = 496 * MiB;
constexpr size_t WS_K = 528 * MiB;
constexpr size_t WS_VT = 536 * MiB;
constexpr size_t WS_KC = 544 * MiB;
constexpr size_t WS_VTC = 545 * MiB;
constexpr size_t WS_UT = 546 * MiB;
constexpr size_t WS_GATE = 642 * MiB;
constexpr size_t WS_ATT = 770 * MiB;
constexpr size_t WS_HYT = 898 * MiB;
constexpr size_t WS_MM = 834 * MiB;
constexpr size_t WS_ACT = 424 * MiB;
constexpr size_t WS_YB = 696 * MiB;
constexpr size_t WS_END = 1024 * MiB;
static_assert(WS_ACT + (size_t)139264 * 2048 <= WS_YB && WS_YB + (size_t)139264 * 2048 <= WS_END && WS_MM + (size_t)T * 2048 <= WS_END, "d_ws map");
constexpr int CW_TMO = 0, CW_CODE = 1, CW_BAR = 4096, CW_CNT = 16384, CW_MOD = 16384 + 64;

constexpr int RING_BYTES = 131072;
constexpr int LDSCTL_OFF = 151552;
constexpr int MISC_OFF = LDSCTL_OFF + 320;
constexpr int TP_OFF = LDSCTL_OFF + 1024;
constexpr int LDS_BYTES = 155648;

typedef float f32x16 __attribute__((ext_vector_type(16)));
typedef float f32x2 __attribute__((ext_vector_type(2)));
typedef unsigned u32x2 __attribute__((ext_vector_type(2)));

struct Frame {
    unsigned long long pt0, ptacc;
    LAS unsigned char* lds;
    volatile LAS unsigned* MISC;
    gu32* ctl;
    int tid, lane, wave, vcu, G;
    const GAS float *x, *c, *ctx, *c_ctx, *w_mod, *b_mod, *w_in, *sink, *cw, *cb, *fw1, *fb1, *fw2, *fb2, *fw3, *skip, *w_ba, *w_bh, *w_out, *ln1g, *ln1b, *rw, *rb, *ew1, *eb1, *ew2, *eb2, *ln2g, *ln2b;
    GAS float* out;
    GAS float *modP, *modF, *rope, *gw; GAS bf16* V1;
    GAS int *asg, *tok;
    GAS bf16 *G_, *WB, *WO, *WIN, *W1, *W2, *HM, *HX, *Q, *K, *VT, *KC, *VTC, *UT, *GATE, *ATT, *MM, *ACT, *YB, *HYT;
};

template <int CTRL> __device__ __forceinline__ float dpp_f(float v) { return __builtin_bit_cast(float, __builtin_amdgcn_update_dpp(0, __builtin_bit_cast(int, v), CTRL, 0xF, 0xF, true)); }
__device__ __forceinline__ float wave_sum(float v) {
    v += dpp_f<0xB1>(v); v += dpp_f<0x4E>(v); v += dpp_f<0x141>(v); v += dpp_f<0x140>(v);
    { const unsigned u = __builtin_bit_cast(unsigned, v); auto r = __builtin_amdgcn_permlane16_swap(u, u, false, false); v = __builtin_bit_cast(float, (unsigned)r[0]) + __builtin_bit_cast(float, (unsigned)r[1]); }
    { const unsigned u = __builtin_bit_cast(unsigned, v); auto r = __builtin_amdgcn_permlane32_swap(u, u, false, false); v = __builtin_bit_cast(float, (unsigned)r[0]) + __builtin_bit_cast(float, (unsigned)r[1]); }
    return v;
}
__device__ __forceinline__ float wave_max(float v) {
    v = fmaxf(v, dpp_f<0xB1>(v)); v = fmaxf(v, dpp_f<0x4E>(v)); v = fmaxf(v, dpp_f<0x141>(v)); v = fmaxf(v, dpp_f<0x140>(v));
    { const unsigned u = __builtin_bit_cast(unsigned, v); auto r = __builtin_amdgcn_permlane16_swap(u, u, false, false); v = fmaxf(__builtin_bit_cast(float, (unsigned)r[0]), __builtin_bit_cast(float, (unsigned)r[1])); }
    { const unsigned u = __builtin_bit_cast(unsigned, v); auto r = __builtin_amdgcn_permlane32_swap(u, u, false, false); v = fmaxf(__builtin_bit_cast(float, (unsigned)r[0]), __builtin_bit_cast(float, (unsigned)r[1])); }
    return v;
}
__device__ __forceinline__ float bf2f(unsigned short h) { return __builtin_bit_cast(float, (unsigned)h << 16); }
__device__ __forceinline__ float bflo(unsigned w) { return __builtin_bit_cast(float, w << 16); }
__device__ __forceinline__ float bfhi(unsigned w) { return __builtin_bit_cast(float, w & 0xffff0000u); }
__device__ __forceinline__ float sigmoidf_(float x) { return __builtin_amdgcn_rcpf(1.f + __builtin_amdgcn_exp2f(-LOG2E * x)); }
__device__ __forceinline__ unsigned pk4_fp8(float a, float b, float c, float d) { int w = 0; w = __builtin_amdgcn_cvt_pk_fp8_f32(a, b, w, false); w = __builtin_amdgcn_cvt_pk_fp8_f32(c, d, w, true); return (unsigned)w; }

__device__ __forceinline__ void p0_mod_block(Frame& F, int cb) {
    const int lane = F.lane, w = F.wave;
    LAS float* scr = (LAS float*)(F.lds + w * 16384);
    LAS float* part = (LAS float*)(F.lds + 8704);
    float xs[17][2];
#pragma unroll
    for (int r = 0; r < 17; ++r) { const GAS float* src = r < 16 ? F.c + r * D : F.c_ctx; xs[r][0] = src[128 * w + lane]; xs[r][1] = src[128 * w + 64 + lane]; }
#pragma unroll
    for (int r = 0; r < 17; ++r) { scr[r * 128 + lane] = xs[r][0] / (1.f + __expf(-xs[r][0])); scr[r * 128 + 64 + lane] = xs[r][1] / (1.f + __expf(-xs[r][1])); }
    LDS_WAIT(); asm volatile("" ::: "memory");
    float acc[17];
#pragma unroll
    for (int r = 0; r < 17; ++r) acc[r] = 0.f;
    const GAS float* wp = F.w_mod + (size_t)(128 * w) * 6144 + 64 * cb + lane;
#pragma unroll 1
    for (int k0 = 0; k0 < 128; k0 += 64) { float wv[64];
#pragma unroll
        for (int k = 0; k < 64; ++k) wv[k] = wp[(size_t)(k0 + k) * 6144];
#pragma unroll
        for (int k = 0; k < 64; ++k) {
#pragma unroll
            for (int r = 0; r < 17; ++r) acc[r] += scr[r * 128 + k0 + k] * wv[k]; } }
#pragma unroll
    for (int r = 0; r < 17; ++r) part[w * 4096 + r * 64 + lane] = acc[r];
    __syncthreads();
    for (int i = F.tid; i < 17 * 64; i += NWAVES * 64) { const int r = i >> 6, c = i & 63; float sum = F.b_mod[64 * cb + c];
#pragma unroll
        for (int ww = 0; ww < 8; ++ww) sum += part[ww * 4096 + r * 64 + c];
        F.modF[r * 6144 + 64 * cb + c] = sum; }
    asm volatile("s_waitcnt vmcnt(0)" ::: "memory"); __syncthreads();
    if (F.tid == 0) { __builtin_amdgcn_fence(__ATOMIC_RELEASE, "agent"); asm volatile("s_waitcnt vmcnt(0)" ::: "memory"); __hip_atomic_fetch_add(F.ctl + CW_MOD, 1u, RLX_AGENT); }
    __syncthreads();
}
__device__ __forceinline__ void p0_filt_item(Frame& F, LAS float* scr, int g, int cb) {
    int lane = F.lane; asm volatile("" : "+v"(lane));
    LAS float* zf = scr; LAS float* h1 = scr + 8 * 36; LAS float* h2 = h1 + 8 * 64;
#pragma unroll
    for (int p = 0; p < 8; ++p) { const int j = 8 * g + p; const float om = (6.283185307179586f * (float)j) / 2048.f;
        if (lane < 16) { const float fk = 1e-4f + (float)lane * ((15.f - 1e-4f) / 15.f); zf[p * 36 + 1 + lane] = cosf(fk * om); }
        else if (lane < 32) { const float fk = 1e-4f + (float)(lane - 16) * ((15.f - 1e-4f) / 15.f); zf[p * 36 + 17 + (lane - 16)] = -sinf(fk * om); }
        else if (lane == 32) zf[p * 36] = (float)j / 2047.f; }
    LDS_WAIT(); asm volatile("" ::: "memory");
    {
        float w1c[33], w2c[64];
#pragma unroll
        for (int i = 0; i < 33; ++i) w1c[i] = F.fw1[i * 64 + lane];
#pragma unroll
        for (int i = 0; i < 64; ++i) w2c[i] = F.fw2[i * 64 + lane];
        const float bb1 = F.fb1[lane], bb2 = F.fb2[lane];
#pragma unroll
        for (int p = 0; p < 8; ++p) { float a = bb1;
#pragma unroll
            for (int i = 0; i < 33; ++i) a += zf[p * 36 + i] * w1c[i];
            h1[p * 64 + lane] = sinf(a); }
        LDS_WAIT(); asm volatile("" ::: "memory");
#pragma unroll
        for (int p = 0; p < 8; ++p) { float a = bb2;
#pragma unroll
            for (int i = 0; i < 64; ++i) a += h1[p * 64 + i] * w2c[i];
            h2[p * 64 + lane] = sinf(a); }
        LDS_WAIT(); asm volatile("" ::: "memory");
    }
    float o[8][4];
#pragma unroll
    for (int p = 0; p < 8; ++p)
#pragma unroll
        for (int q = 0; q < 4; ++q) o[p][q] = 0.f;
    const GAS float* w3 = F.fw3 + 256 * cb + lane;
#pragma unroll 1
    for (int i0 = 0; i0 < 64; i0 += 16) { float w[16][4];
#pragma unroll
        for (int i = 0; i < 16; ++i)
#pragma unroll
            for (int q = 0; q < 4; ++q) w[i][q] = w3[(size_t)(i0 + i) * 2048 + 64 * q];
#pragma unroll
        for (int i = 0; i < 16; ++i)
#pragma unroll
            for (int p = 0; p < 8; ++p) { const float hv = h2[p * 64 + i0 + i];
#pragma unroll
                for (int q = 0; q < 4; ++q) o[p][q] += hv * w[i][q]; } }
#pragma unroll
    for (int q = 0; q < 4; ++q) { const int col = 256 * cb + 64 * q + lane, oo = col >> 10, dir = (col >> 9) & 1, ch = col & 511;
        const float delta = 15.350567286626973f - (float)ch * (12.280453829301578f / 511.f);
        GAS bf16* gp = F.G_ + (size_t)(oo * 512 + ch) * 4096;
#pragma unroll
        for (int p = 0; p < 8; ++p) { const int j = 8 * g + p; const float val = o[p][q] * __expf(-((float)j / 2047.f) * delta);
            const int idx = dir ? 2048 + j : 2048 - j; if (!(dir && j == 0)) gp[idx] = (bf16)f2bf(val); }
        if (g == 0 && dir == 0) gp[0] = 0; }
    LDS_WAIT(); asm volatile("" ::: "memory");
}
constexpr int IT_IN = 16 * 136, IT_B = 8 * 32, IT_O = 16 * 32, IT_W1 = 32 * 16 * 64, IT_W2 = 32 * 16 * 32, NTR = IT_IN + 2 * IT_B + IT_O + IT_W1 + IT_W2;
struct TrItem { const GAS float* W; GAS bf16* WT; int N, Kp, drow, k0, n0, f8; };
__device__ __forceinline__ TrItem tr_decode(Frame& F, int r) {
    TrItem t; t.f8 = 0;
    if (r < IT_IN) { t.W = F.w_in; t.N = INW; t.WT = F.WIN; t.Kp = 1024; t.k0 = 64 * (r / 136); t.n0 = 32 * (r % 136); t.drow = t.n0; }
    else if ((r -= IT_IN) < IT_B) { t.W = F.w_ba; t.N = 1024; t.WT = F.WB; t.Kp = 512; t.k0 = 64 * (r / 32); t.n0 = 32 * (r % 32); t.drow = t.n0; }
    else if ((r -= IT_B) < IT_B) { t.W = F.w_bh; t.N = 1024; t.WT = F.WB + 1024 * 512; t.Kp = 512; t.k0 = 64 * (r / 32); t.n0 = 32 * (r % 32); t.drow = t.n0; }
    else if ((r -= IT_B) < IT_O) { t.W = F.w_out; t.N = 1024; t.WT = F.WO; t.Kp = 1024; t.k0 = 64 * (r / 32); t.n0 = 32 * (r % 32); t.drow = t.n0; }
    else if ((r -= IT_O) < IT_W1) { const int e = r >> 10, q = r & 1023; t.W = F.ew1 + (size_t)e * 1024 * 2048; t.N = 2048; t.WT = (GAS bf16*)((GAS unsigned char*)F.W1 + (size_t)e * 2048 * 1024); t.Kp = 1024; t.f8 = 1; t.k0 = 64 * (q >> 6); t.n0 = 32 * (q & 63);
        t.drow = t.n0 < 1024 ? (t.n0 >> 7) * 256 + (t.n0 & 127) : ((t.n0 - 1024) >> 7) * 256 + 128 + ((t.n0 - 1024) & 127); }
    else { r -= IT_W1; const int e = r >> 9, q = r & 511; t.W = F.ew2 + (size_t)e * 1024 * 1024; t.N = 1024; t.WT = (GAS bf16*)((GAS unsigned char*)F.W2 + (size_t)e * 1024 * 1024); t.Kp = 1024; t.f8 = 1; t.k0 = 64 * (q >> 5); t.n0 = 32 * (q & 31); t.drow = t.n0; }
    return t;
}
__device__ __forceinline__ void tr_load(const TrItem& t, int lane, f32x4 (&buf)[8]) {
    const GAS float* wp = t.W + (size_t)(t.k0 + (lane >> 3)) * t.N + t.n0 + 4 * (lane & 7);
#pragma unroll
    for (int i = 0; i < 8; ++i) buf[i] = __builtin_nontemporal_load((const GAS f32x4*)(wp + (size_t)(8 * i) * t.N));
}
__device__ __forceinline__ void tr_store(const TrItem& t, const f32x4 (&buf)[8], LAS float* scr, int lane) {
    const int kk = lane >> 3, c4 = lane & 7;
#pragma unroll
    for (int i = 0; i < 8; ++i) { LAS float* d = scr + (8 * i + kk) * 33 + 4 * c4; d[0] = buf[i][0]; d[1] = buf[i][1]; d[2] = buf[i][2]; d[3] = buf[i][3]; }
    LDS_WAIT(); asm volatile("" ::: "memory");
    const int c = lane & 7;
#pragma unroll
    for (int j = 0; j < 4; ++j) { const int n = (lane >> 3) + 8 * j; const LAS float* sp = scr + (8 * c) * 33 + n;
        if (t.f8) { u32x2 o; o.x = pk4_fp8(sp[0 * 33] * 256.f, sp[1 * 33] * 256.f, sp[2 * 33] * 256.f, sp[3 * 33] * 256.f); o.y = pk4_fp8(sp[4 * 33] * 256.f, sp[5 * 33] * 256.f, sp[6 * 33] * 256.f, sp[7 * 33] * 256.f);
            *(GAS u32x2*)((GAS unsigned char*)t.WT + (size_t)(t.drow + n) * t.Kp + t.k0 + 8 * c) = o; }
        else { v4u o; o.x = pk2(sp[0 * 33], sp[1 * 33]); o.y = pk2(sp[2 * 33], sp[3 * 33]); o.z = pk2(sp[4 * 33], sp[5 * 33]); o.w = pk2(sp[6 * 33], sp[7 * 33]);
            *(GAS v4u*)(t.WT + (size_t)(t.drow + n) * t.Kp + t.k0 + 8 * c) = o; } }
    LDS_WAIT(); asm volatile("" ::: "memory");
}
__device__ __forceinline__ void p1_rows(Frame& F);
__device__ __forceinline__ void p0_prologue(Frame& F) {
    LAS float* scr = (LAS float*)(F.lds + F.wave * 16384);
    const int gw = F.vcu * NWAVES + F.wave, NGW = F.G * NWAVES, lane = F.lane;
    constexpr int IT_FILT = 2048, IT_ROPE = 1, NSPEC = IT_FILT + IT_ROPE;
    if ((int)blockIdx.x < 96) p0_mod_block(F, (int)blockIdx.x);
    const bool spec_first = (F.wave & 1) != 0;
#define P0_SPECIAL() do { for (int it = gw; it < NSPEC; it += NGW) { int r = it; \
        if (r < IT_FILT) { p0_filt_item(F, scr, r >> 3, r & 7); continue; } \
        _Pragma("unroll 4") for (int i = 0; i < 16; ++i) { const int idx = lane * 16 + i, pos = idx >> 4, f = idx & 15; const float inv = exp2f(-(float)f * (13.287712379549449f / 16.f)); const float ang = (float)pos * inv; \
            F.rope[idx] = cosf(ang); F.rope[1024 + idx] = sinf(ang); } } } while (0)
    if (spec_first) P0_SPECIAL();
    if (gw < NTR) {
        int it = gw;
        TrItem c0 = tr_decode(F, it); f32x4 b0[8]; tr_load(c0, lane, b0);
        int i1 = it + NGW; bool h1 = i1 < NTR; TrItem c1 = tr_decode(F, h1 ? i1 : it); f32x4 b1[8]; tr_load(c1, lane, b1);
        for (;;) {
            const int i2 = i1 + NGW; const bool h2 = h1 && i2 < NTR;
            TrItem c2 = tr_decode(F, h2 ? i2 : it); f32x4 b2[8]; tr_load(c2, lane, b2);
            tr_store(c0, b0, scr, lane);
            if (!h1) break;
            c0 = c1; c1 = c2; it = i1; i1 = i2; h1 = h2;
#pragma unroll
            for (int i = 0; i < 8; ++i) { b0[i] = b1[i]; b1[i] = b2[i]; }
        }
    }
    if (!spec_first) P0_SPECIAL();
#undef P0_SPECIAL
    __syncthreads();
    if (F.wave == 0) { unsigned sp = 0;
        while ((unsigned)__builtin_amdgcn_readfirstlane(__hip_atomic_load(F.ctl + CW_MOD, RLX_AGENT)) < 96u) { __builtin_amdgcn_s_sleep(2); if (++sp > (1u << 22)) { if (F.lane == 0) __hip_atomic_store(F.ctl + CW_TMO, 1u, RLX_AGENT); break; } }
        __builtin_amdgcn_fence(__ATOMIC_ACQUIRE, "agent"); asm volatile("s_waitcnt vmcnt(0)" ::: "memory"); }
    __syncthreads();
    p1_rows(F);
}

template <int NR>
__device__ __forceinline__ void ln_mod_rows(const GAS float* const (&src)[NR], GAS bf16* const (&dst)[NR], const LAS float* const (&tS)[NR], const LAS float* const (&tB)[NR], int lane) {
    f32x4 v[NR][4]; float s[NR], s2[NR];
#pragma unroll
    for (int r = 0; r < NR; ++r) { const GAS f32x4* xr = (const GAS f32x4*)src[r] + lane;
#pragma unroll
        for (int j = 0; j < 4; ++j) v[r][j] = __builtin_nontemporal_load(xr + 64 * j); }
#pragma unroll
    for (int r = 0; r < NR; ++r) { s[r] = 0.f;
#pragma unroll
        for (int j = 0; j < 4; ++j) s[r] += (v[r][j].x + v[r][j].y) + (v[r][j].z + v[r][j].w); }
#pragma unroll
    for (int r = 0; r < NR; ++r) s[r] = wave_sum(s[r]) * (1.f / D);
#pragma unroll
    for (int r = 0; r < NR; ++r) { s2[r] = 0.f;
#pragma unroll
        for (int j = 0; j < 4; ++j) { v[r][j] = v[r][j] - s[r]; s2[r] += (v[r][j].x * v[r][j].x + v[r][j].y * v[r][j].y) + (v[r][j].z * v[r][j].z + v[r][j].w * v[r][j].w); } }
#pragma unroll
    for (int r = 0; r < NR; ++r) s2[r] = 1.f / sqrtf(wave_sum(s2[r]) * (1.f / D) + LN_EPS);
#pragma unroll
    for (int r = 0; r < NR; ++r)
#pragma unroll
        for (int j = 0; j < 4; ++j) { const int col = 4 * lane + 256 * j; const f32x4 sc = *(const LAS f32x4*)(tS[r] + col), sh = *(const LAS f32x4*)(tB[r] + col);
            const f32x4 o = v[r][j] * s2[r] * sc + sh; u32x2 w; w.x = pk2(o.x, o.y); w.y = pk2(o.z, o.w); *(GAS u32x2*)(dst[r] + col) = w; }
}
__device__ __forceinline__ void p1_rows(Frame& F) {
    LAS float* tA = (LAS float*)F.lds;
    for (int chunk = blockIdx.x; chunk < 256; chunk += F.G) {
        const int b = chunk >> 4;
        for (int i = F.tid; i < 4096; i += NWAVES * 64) { const int which = i >> 10, col = i & 1023, r = which < 2 ? b : 16, n = ((which & 1) ? 0 : 1024) + col;
            const float s = F.modF[r * 6144 + n]; tA[i] = (which & 1) ? s : 1.f + s; }
        __syncthreads();
#pragma unroll 1
        for (int g = 0; g < 6; ++g) {
            const GAS float* src[3]; GAS bf16* dst[3]; const LAS float* tS[3]; const LAS float* tB[3];
#pragma unroll
            for (int r = 0; r < 3; ++r) { const int rr = 3 * g + r;
                if (rr < 16) { const int row = chunk * 128 + F.wave * 16 + rr; src[r] = F.x + (size_t)row * D; dst[r] = F.HX + (size_t)row * D; tS[r] = tA; tB[r] = tA + 1024; }
                else { const int cr = chunk * 16 + F.wave * 2 + (rr - 16); src[r] = F.ctx + (size_t)cr * D; dst[r] = F.HX + (size_t)(T + cr) * D; tS[r] = tA + 2048; tB[r] = tA + 3072; } }
            ln_mod_rows<3>(src, dst, tS, tB, F.lane);
        }
        __syncthreads();
    }
}

using pg8::Unit; using pg8::f32x4; using pg8::cvt_pk_bf16;
struct SchedInProj {
    pg8::StaticOrder so; int G, c;
    __device__ __forceinline__ bool next(int i, Unit& u) const { const long L = (long)i * G + c; if (L < 2176) return so.next(i, u); if (L < 2192) { u.pm = 128 + (int)(L - 2176); u.pn = 2; return true; } return false; }
    __device__ __forceinline__ void a_ready(const Unit&) const {}
};
struct SchedPair {
    pg8::StaticOrder so;
    __device__ __forceinline__ bool next(int i, Unit& u) const { if (!so.next(i >> 1, u)) return false; if (i & 1) { u.pm += 128; u.pn += 4; } return true; }
    __device__ __forceinline__ void a_ready(const Unit&) const {}
};
struct SchedPlain { pg8::StaticOrder so;
    __device__ __forceinline__ bool next(int i, Unit& u) const { return so.next(i, u); }
    __device__ __forceinline__ void a_ready(const Unit&) const {}
};
struct SchedMoe {
    const LAS int* tp; const GAS int* tok; int nNl, G, c;
    __device__ __forceinline__ bool next(int i, Unit& u) const {
        pg8::StaticOrder so; so.init(__builtin_amdgcn_readfirstlane(tp[32]), nNl, G, c); if (!so.next(i, u)) return false;
        int e = 0;
        for (int k = 1; k < 32; ++k) e += (u.pm >= tp[k]) ? 1 : 0;
        u.pm = __builtin_amdgcn_readfirstlane(u.pm); u.pn = __builtin_amdgcn_readfirstlane(u.pn + e * nNl); return true; }
    __device__ __forceinline__ int rowoff(const Unit& u, int r) const { const int e = u.pn / nNl; int pos = (u.pm - tp[e]) * 256 + r; pos = pos < tp[33 + e] ? pos : 0; return tok[e * 32768 + pos]; }
    __device__ __forceinline__ void a_ready(const Unit&) const {}
};

struct EpiInProj {
    static constexpr bool PERM = true; static constexpr float S8 = 1.f;
    GAS bf16 *Q, *K, *VT, *KC, *VTC, *UT, *GATE; const GAS float* rope;
    __device__ __forceinline__ void operator()(const f32x4 (&acc)[2][2][4][2], const Unit& u, int wr, int wc, int fr, int fq) const {
        const int pn = u.pn; const bool isctx = u.pm >= 128;
#pragma unroll
        for (int ai = 0; ai < 2; ++ai)
#pragma unroll
            for (int m = 0; m < 4; ++m) {
                const int row = u.pm * 256 + ai * 128 + wr * 64 + m * 16 + fr;
                if (pn >= 9) {
#pragma unroll
                    for (int bj = 0; bj < 2; ++bj) { const int col = (pn - 9) * 256 + bj * 128 + wc * 32 + 8 * fq; const f32x4 v0 = acc[ai][bj][m][0] * S8, v1 = acc[ai][bj][m][1] * S8; v4u w;
                        w.x = cvt_pk_bf16(sigmoidf_(v0[0]), sigmoidf_(v0[1])); w.y = cvt_pk_bf16(sigmoidf_(v0[2]), sigmoidf_(v0[3])); w.z = cvt_pk_bf16(sigmoidf_(v1[0]), sigmoidf_(v1[1])); w.w = cvt_pk_bf16(sigmoidf_(v1[2]), sigmoidf_(v1[3]));
                        *(GAS v4u*)(GATE + (size_t)row * 2048 + col) = w; }
                } else if (pn >= 3) {
#pragma unroll
                    for (int bj = 0; bj < 2; ++bj) { const int ch = (pn - 3) * 256 + bj * 128 + wc * 32 + 8 * fq; GAS bf16* up = UT + (size_t)ch * T + row;
#pragma unroll
                        for (int n = 0; n < 2; ++n)
#pragma unroll
                            for (int j = 0; j < 4; ++j) up[(size_t)(4 * n + j) * T] = (bf16)f2bf(acc[ai][bj][m][n][j] * S8); }
                } else {
                    const int t = row & 2047;
                    const int pos = (wc & 1) ? (t & 63) : (t >> 6); const int f0 = 8 * (fq & 1); const bool hihalf = (fq >> 1) != 0;
#pragma unroll
                    for (int bj = 0; bj < 2; ++bj) {
                        if (pn == 2 && bj == 1) {
                            const int kvh = wc >> 1, d0 = (wc & 1) * 32 + 8 * fq;
                            GAS bf16* vp = isctx ? VTC + ((size_t)(((row - T) >> 8) * 2 + kvh) * 64 + d0) * 256 + ((row - T) & 255)
                                             : VT + ((size_t)((row >> 11) * 2 + kvh) * 64 + d0) * 2048 + t;
                            const int pitch = isctx ? 256 : 2048;
#pragma unroll
                            for (int n = 0; n < 2; ++n)
#pragma unroll
                                for (int j = 0; j < 4; ++j) vp[(size_t)(4 * n + j) * pitch] = (bf16)f2bf(acc[ai][bj][m][n][j] * S8);
                        } else {
                            f32x4 r[2];
#pragma unroll
                            for (int n = 0; n < 2; ++n) { const f32x4 own = acc[ai][bj][m][n] * S8; f32x4 oth;
#pragma unroll
                                for (int j = 0; j < 4; ++j) oth[j] = __shfl_xor(own[j], 32);
                                const f32x4 cs = *(const GAS f32x4*)(rope + pos * 16 + f0 + 4 * n), sn = *(const GAS f32x4*)(rope + 1024 + pos * 16 + f0 + 4 * n);
                                r[n] = hihalf ? own * cs + oth * sn : own * cs - oth * sn;
                                if (isctx) r[n] = own; }
                            if (pn < 2) { r[0] = r[0] * C2Q; r[1] = r[1] * C2Q; }
                            v4u w; w.x = cvt_pk_bf16(r[0][0], r[0][1]); w.y = cvt_pk_bf16(r[0][2], r[0][3]); w.z = cvt_pk_bf16(r[1][0], r[1][1]); w.w = cvt_pk_bf16(r[1][2], r[1][3]);
                            GAS bf16* dst = pn < 2 ? Q + (size_t)row * QW + pn * 256 + bj * 128 + wc * 32 + 8 * fq
                                               : (isctx ? KC + (size_t)(row - T) * KVW + wc * 32 + 8 * fq : K + (size_t)row * KVW + wc * 32 + 8 * fq);
                            *(GAS v4u*)dst = w;
                        }
                    }
                }
            }
    }
};
struct EpiMerge {
    static constexpr bool PERM = true;
    const GAS bf16* GATE; GAS bf16* MM;
    __device__ __forceinline__ void operator()(const f32x4 (&acc)[2][2][4][2], const Unit& u, int wr, int wc, int fr, int fq) const {
        const int which = u.pn >> 2, pnl = u.pn & 3, pml = u.pm & 127;
#pragma unroll
        for (int ai = 0; ai < 2; ++ai) {
            v4u g[4][2], p[4][2];
#pragma unroll
            for (int m = 0; m < 4; ++m)
#pragma unroll
                for (int bj = 0; bj < 2; ++bj) { const int row = pml * 256 + ai * 128 + wr * 64 + m * 16 + fr, col = pnl * 256 + bj * 128 + wc * 32 + 8 * fq;
                    g[m][bj] = *(const GAS v4u*)(GATE + (size_t)row * 2048 + which * 1024 + col); p[m][bj] = (v4u){0u, 0u, 0u, 0u}; }
            if (which) {
#pragma unroll
                for (int m = 0; m < 4; ++m)
#pragma unroll
                    for (int bj = 0; bj < 2; ++bj) { const int row = pml * 256 + ai * 128 + wr * 64 + m * 16 + fr, col = pnl * 256 + bj * 128 + wc * 32 + 8 * fq; p[m][bj] = *(const GAS v4u*)(MM + (size_t)row * 1024 + col); } }
#pragma unroll
            for (int m = 0; m < 4; ++m)
#pragma unroll
                for (int bj = 0; bj < 2; ++bj) { const int row = pml * 256 + ai * 128 + wr * 64 + m * 16 + fr, col = pnl * 256 + bj * 128 + wc * 32 + 8 * fq;
                    const v4u gg = g[m][bj], pp = p[m][bj]; const f32x4 v0 = acc[ai][bj][m][0], v1 = acc[ai][bj][m][1];
                    const float o0 = bflo(gg.x) * v0[0] + bflo(pp.x), o1 = bfhi(gg.x) * v0[1] + bfhi(pp.x), o2 = bflo(gg.y) * v0[2] + bflo(pp.y), o3 = bfhi(gg.y) * v0[3] + bfhi(pp.y);
                    const float o4 = bflo(gg.z) * v1[0] + bflo(pp.z), o5 = bfhi(gg.z) * v1[1] + bfhi(pp.z), o6 = bflo(gg.w) * v1[2] + bflo(pp.w), o7 = bfhi(gg.w) * v1[3] + bfhi(pp.w);
                    v4u w; w.x = cvt_pk_bf16(o0, o1); w.y = cvt_pk_bf16(o2, o3); w.z = cvt_pk_bf16(o4, o5); w.w = cvt_pk_bf16(o6, o7);
                    *(GAS v4u*)(MM + (size_t)row * 1024 + col) = w; }
        }
    }
};
struct EpiV1 {
    static constexpr bool PERM = false;
    const GAS float* x; const GAS float* modF; GAS bf16* V1;
    __device__ __forceinline__ void operator()(const f32x4 (&acc)[2][2][4][2], const Unit& u, int wr, int wc, int fr, int fq) const {
        const int col0 = u.pn * 256 + wc * 32 + 4 * fq; const int b = u.pm >> 3;
        f32x4 g1[2][2];
#pragma unroll
        for (int bj = 0; bj < 2; ++bj)
#pragma unroll
            for (int n = 0; n < 2; ++n) g1[bj][n] = *(const GAS f32x4*)(modF + b * 6144 + 2048 + col0 + bj * 128 + n * 16);
#pragma unroll
        for (int ai = 0; ai < 2; ++ai) {
            f32x4 xv[4][2][2];
#pragma unroll
            for (int m = 0; m < 4; ++m) { const size_t off = (size_t)(u.pm * 256 + ai * 128 + wr * 64 + m * 16 + fr) * D + col0;
#pragma unroll
                for (int bj = 0; bj < 2; ++bj)
#pragma unroll
                    for (int n = 0; n < 2; ++n) xv[m][bj][n] = *(const GAS f32x4*)(x + off + bj * 128 + n * 16); }
#pragma unroll
            for (int m = 0; m < 4; ++m) { const size_t off = (size_t)(u.pm * 256 + ai * 128 + wr * 64 + m * 16 + fr) * D + col0;
#pragma unroll
                for (int bj = 0; bj < 2; ++bj)
#pragma unroll
                    for (int n = 0; n < 2; ++n) { const f32x4 r = xv[m][bj][n] * DN_ALPHA + g1[bj][n] * acc[ai][bj][m][n]; u32x2 w; w.x = cvt_pk_bf16(r[0], r[1]); w.y = cvt_pk_bf16(r[2], r[3]); *(GAS u32x2*)(V1 + off + bj * 128 + n * 16) = w; } }
        }
    }
};
struct EpiAct {
    static constexpr bool PERM = true;
    const GAS float* b1; GAS bf16* ACT;
    __device__ __forceinline__ void operator()(const f32x4 (&acc)[2][2][4][2], const Unit& u, int wr, int wc, int fr, int fq) const {
        const int e = u.pn >> 3, pnl = u.pn & 7, colo = pnl * 128 + wc * 32 + 8 * fq;
        f32x4 bg[2], bl[2];
#pragma unroll
        for (int n = 0; n < 2; ++n) { bg[n] = *(const GAS f32x4*)(b1 + e * 2048 + colo + 4 * n); bl[n] = *(const GAS f32x4*)(b1 + e * 2048 + 1024 + colo + 4 * n); }
#pragma unroll
        for (int ai = 0; ai < 2; ++ai)
#pragma unroll
            for (int m = 0; m < 4; ++m) { const int row = u.pm * 256 + ai * 128 + wr * 64 + m * 16 + fr; float o[8];
#pragma unroll
                for (int n = 0; n < 2; ++n)
#pragma unroll
                    for (int j = 0; j < 4; ++j) { float gl = acc[ai][0][m][n][j] * (1.f / 256.f) + bg[n][j], li = acc[ai][1][m][n][j] * (1.f / 256.f) + bl[n][j];
                        gl = fminf(gl, 7.f); li = fminf(fmaxf(li, -7.f), 7.f); o[4 * n + j] = gl * sigmoidf_(1.702f * gl) * (li + 1.f); }
                u32x2 w; w.x = pk4_fp8(o[0], o[1], o[2], o[3]); w.y = pk4_fp8(o[4], o[5], o[6], o[7]);
                *(GAS u32x2*)((GAS unsigned char*)ACT + (size_t)row * 1024 + colo) = w; }
    }
};
struct EpiYb {
    static constexpr bool PERM = true;
    const GAS float* b2; GAS bf16* YB;
    __device__ __forceinline__ void operator()(const f32x4 (&acc)[2][2][4][2], const Unit& u, int wr, int wc, int fr, int fq) const {
        const int e = u.pn >> 2, pnl = u.pn & 3;
#pragma unroll
        for (int bj = 0; bj < 2; ++bj) { const int col = pnl * 256 + bj * 128 + wc * 32 + 8 * fq;
            const f32x4 b0 = *(const GAS f32x4*)(b2 + e * 1024 + col), b1v = *(const GAS f32x4*)(b2 + e * 1024 + col + 4);
#pragma unroll
            for (int ai = 0; ai < 2; ++ai)
#pragma unroll
                for (int m = 0; m < 4; ++m) { const int row = u.pm * 256 + ai * 128 + wr * 64 + m * 16 + fr; const f32x4 v0 = acc[ai][bj][m][0] * (1.f / 256.f) + b0, v1 = acc[ai][bj][m][1] * (1.f / 256.f) + b1v;
                    u32x2 w; w.x = pk4_fp8(v0[0], v0[1], v0[2], v0[3]); w.y = pk4_fp8(v1[0], v1[1], v1[2], v1[3]);
                    *(GAS u32x2*)((GAS unsigned char*)YB + (size_t)row * 1024 + col) = w; } }
    }
};

#define HPT_B(k) do { if (PROBE_SPIN == (k)) F.pt0 = rt(); } while (0)
#define HPT_E(k) do { if (PROBE_SPIN == (k)) F.ptacc += rt() - F.pt0; } while (0)
__device__ __forceinline__ int crow(int r, int hi) { return (r & 3) + 8 * (r >> 2) + 4 * hi; }
__device__ __forceinline__ void attn_step(const bool MASK, const LAS unsigned char* Kl, const LAS unsigned char* Vl, const int pitchV, const int kvoff, const bf16x8 (&qf)[2][4],
                                          float (&mrun)[2], float (&lrun)[2], f32x16 (&o)[2][2], const int r32, const int hi, const int dq0) {
    bf16x8 kf[4], vf[2][2];
#pragma unroll
    for (int ks = 0; ks < 4; ++ks) kf[ks] = *(const LAS bf16x8*)(Kl + (kvoff + r32) * 144 + ks * 32 + hi * 16);
#pragma unroll
    for (int dt = 0; dt < 2; ++dt)
#pragma unroll
        for (int s2 = 0; s2 < 2; ++s2) vf[dt][s2] = *(const LAS bf16x8*)(Vl + (32 * dt + r32) * pitchV + (kvoff + 16 * s2) * 2 + hi * 16);
#pragma unroll
    for (int qt = 0; qt < 2; ++qt) {
        f32x16 s = {0.f, 0.f, 0.f, 0.f, 0.f, 0.f, 0.f, 0.f, 0.f, 0.f, 0.f, 0.f, 0.f, 0.f, 0.f, 0.f};
#pragma unroll
        for (int ks = 0; ks < 4; ++ks) s = __builtin_amdgcn_mfma_f32_32x32x16_bf16(kf[ks], qf[qt][ks], s, 0, 0, 0);
        if (MASK) {
#pragma unroll
            for (int r = 0; r < 16; ++r) { const int dd = dq0 - 32 * qt + crow(r, hi); if (dd > 128 || dd < -128) s[r] = -INFINITY; }
        }
        float mx = fmaxf(fmaxf(s[0], s[1]), s[2]);
#pragma unroll
        for (int r = 3; r < 15; r += 2) mx = fmaxf(fmaxf(mx, s[r]), s[r + 1]);
        mx = fmaxf(mx, s[15]);
        { const unsigned u = __builtin_bit_cast(unsigned, mx); auto rr = __builtin_amdgcn_permlane32_swap(u, u, false, false); mx = fmaxf(__builtin_bit_cast(float, (unsigned)rr[0]), __builtin_bit_cast(float, (unsigned)rr[1])); }
        if (__any(mx > mrun[qt])) {
            const float mn = fmaxf(mrun[qt], mx), f = __builtin_amdgcn_exp2f(mrun[qt] - mn); mrun[qt] = mn; lrun[qt] *= f;
#pragma unroll
            for (int dt = 0; dt < 2; ++dt) o[qt][dt] = o[qt][dt] * f;
        }
        const float mn = mrun[qt];
        float ps = 0.f;
#pragma unroll
        for (int r = 0; r < 16; ++r) { const float p = __builtin_amdgcn_exp2f(s[r] - mn); s[r] = p; ps += p; }
        lrun[qt] += ps;
        bf16x8 pb[2];
#pragma unroll
        for (int s2 = 0; s2 < 2; ++s2) { v4u w; w.x = cvt_pk_bf16(s[8 * s2 + 0], s[8 * s2 + 1]); w.y = cvt_pk_bf16(s[8 * s2 + 2], s[8 * s2 + 3]); w.z = cvt_pk_bf16(s[8 * s2 + 4], s[8 * s2 + 5]); w.w = cvt_pk_bf16(s[8 * s2 + 6], s[8 * s2 + 7]);
            pb[s2] = __builtin_bit_cast(bf16x8, w); }
#pragma unroll
        for (int dt = 0; dt < 2; ++dt)
#pragma unroll
            for (int s2 = 0; s2 < 2; ++s2) o[qt][dt] = __builtin_amdgcn_mfma_f32_32x32x16_bf16(vf[dt][s2], pb[s2], o[qt][dt], 0, 0, 0);
    }
}
__device__ __forceinline__ void attn_unit(Frame& F, int b, int kvh, int qb) {
    LAS unsigned char* lds = F.lds;
    const int tid = F.tid, lane = F.lane, w = F.wave, r32 = lane & 31, hi = lane >> 5;
    const int h = kvh * 4 + (w >> 1), s0 = qb * 128, q0 = s0 + 64 * (w & 1);
    bf16x8 qf[2][4];
#pragma unroll
    for (int qt = 0; qt < 2; ++qt)
#pragma unroll
        for (int ks = 0; ks < 4; ++ks) qf[qt][ks] = *(const GAS bf16x8*)(F.Q + (size_t)(b * SEQ + q0 + 32 * qt + r32) * QW + h * 64 + 16 * ks + 8 * hi);
    float mrun[2] = {-INFINITY, -INFINITY}, lrun[2] = {0.f, 0.f};
    f32x16 o[2][2];
#pragma unroll
    for (int qt = 0; qt < 2; ++qt)
#pragma unroll
        for (int dt = 0; dt < 2; ++dt)
#pragma unroll
            for (int r = 0; r < 16; ++r) o[qt][dt][r] = 0.f;
    {
        HPT_B(30);
        LAS unsigned char* Kl = lds; LAS unsigned char* Vl = lds + 36864;
        v4u rk[4], rv[4];
#pragma unroll
        for (int i = 0; i < 4; ++i) { const int idx = tid + 512 * i; rk[i] = *(const GAS v4u*)(F.KC + (size_t)(b * CTXL + (idx >> 3)) * KVW + kvh * 64 + (idx & 7) * 8);
            rv[i] = *(const GAS v4u*)(F.VTC + (size_t)((b * 2 + kvh) * 64 + (idx >> 5)) * CTXL + (idx & 31) * 8); }
#pragma unroll
        for (int i = 0; i < 4; ++i) { const int idx = tid + 512 * i; *(LAS v4u*)(Kl + (idx >> 3) * 144 + (idx & 7) * 16) = rk[i]; { const int ch = idx & 31; LAS unsigned char* vd = Vl + (idx >> 5) * 528 + (ch >> 1) * 32 + (ch & 1) * 8; *(LAS u32x2*)vd = (u32x2){rv[i].x, rv[i].y}; *(LAS u32x2*)(vd + 16) = (u32x2){rv[i].z, rv[i].w}; } }
        __syncthreads(); HPT_E(30); HPT_B(31);
        for (int st = 0; st < 8; ++st) attn_step(false, Kl, Vl, 528, 32 * st, qf, mrun, lrun, o, r32, hi, 0);
        __syncthreads(); HPT_E(31);
    }
    {
        LAS unsigned char* Kl = lds; LAS unsigned char* Vl = lds + 55296; const int kbase = s0 - 128;
        HPT_B(32);
        v4u rk[6], rv[6];
#pragma unroll
        for (int i = 0; i < 6; ++i) { const int idx = tid + 512 * i; { const int row = idx >> 3, ch = idx & 7; int kp = kbase + row; kp = kp < 0 ? 0 : (kp >= SEQ ? SEQ - 1 : kp); rk[i] = *(const GAS v4u*)(F.K + (size_t)(b * SEQ + kp) * KVW + kvh * 64 + ch * 8); }
            { const int row = idx / 48, ch = idx % 48; int kp = kbase + 8 * ch; kp = kp < 0 ? 0 : (kp >= SEQ ? SEQ - 8 : kp); rv[i] = *(const GAS v4u*)(F.VT + (size_t)((b * 2 + kvh) * 64 + row) * SEQ + kp); } }
#pragma unroll
        for (int i = 0; i < 6; ++i) { const int idx = tid + 512 * i; *(LAS v4u*)(Kl + (idx >> 3) * 144 + (idx & 7) * 16) = rk[i]; { const int ch = idx % 48; LAS unsigned char* vd = Vl + (idx / 48) * 784 + (ch >> 1) * 32 + (ch & 1) * 8; *(LAS u32x2*)vd = (u32x2){rv[i].x, rv[i].y}; *(LAS u32x2*)(vd + 16) = (u32x2){rv[i].z, rv[i].w}; } }
        __syncthreads(); HPT_E(32); HPT_B(33);
        for (int st = 0; st < 10; ++st) { const int kp0 = q0 - 128 + 32 * st; if (kp0 < 0 || kp0 >= SEQ) continue;
            attn_step(st < 2 || st >= 8, Kl, Vl, 784, kp0 - kbase, qf, mrun, lrun, o, r32, hi, kp0 - q0 - r32); }
        __syncthreads();
    }
    HPT_E(33);
    const float sk = F.sink[h] * LOG2E;
#pragma unroll
    for (int qt = 0; qt < 2; ++qt) { float l = lrun[qt] + __shfl_xor(lrun[qt], 32); l += __builtin_amdgcn_exp2f(sk - mrun[qt]); const float inv = 1.f / l;
        GAS bf16* op = F.ATT + (size_t)(b * SEQ + q0 + 32 * qt + r32) * QW + h * 64;
#pragma unroll
        for (int dt = 0; dt < 2; ++dt)
#pragma unroll
            for (int rg = 0; rg < 4; ++rg) { u32x2 wv; wv.x = cvt_pk_bf16(o[qt][dt][4 * rg] * inv, o[qt][dt][4 * rg + 1] * inv); wv.y = cvt_pk_bf16(o[qt][dt][4 * rg + 2] * inv, o[qt][dt][4 * rg + 3] * inv);
                *(GAS u32x2*)(op + 32 * dt + 8 * rg + 4 * hi) = wv; } }
}

constexpr int HZ_PITCH = 4112, HG_OFF = 16 * HZ_PITCH  , HG_PITCH = 8224;
__device__ __forceinline__ void hy_load_filter(LAS unsigned char* GC, const GAS bf16* G, int tid) {
    const GAS v4u* gp = (const GAS v4u*)G;
    const v4u a = gp[tid]; v4u b = {0u, 0u, 0u, 0u}; if (tid < 511) b = gp[tid + 1];
    const unsigned w[8] = {a.x, a.y, a.z, a.w, b.x, b.y, b.z, b.w};
#pragma unroll
    for (int rho = 0; rho < 8; ++rho) { v4u o; unsigned t[4];
#pragma unroll
        for (int dd = 0; dd < 4; ++dd) { const int base = (rho >> 1) + dd; t[dd] = (rho & 1) ? __builtin_amdgcn_alignbit(w[base + 1 > 7 ? 7 : base + 1], w[base], 16) : w[base]; }
        o.x = t[0]; o.y = t[1]; o.z = t[2]; o.w = t[3];
        *(LAS v4u*)(GC + rho * HG_PITCH + tid * 16) = o; }
}
__device__ __forceinline__ f32x4 hy_short4(const GAS bf16* up, int t, float w0, float w1, float w2, float bs) {
    const u32x2 v = *(const GAS u32x2*)(up + t);
    const float u0 = bflo(v.x), u1 = bfhi(v.x), u2 = bflo(v.y), u3 = bfhi(v.y);
    const float um = t > 0 ? bf2f(up[t - 1]) : 0.f, up4 = t + 4 < SEQ ? bf2f(up[t + 4]) : 0.f;
    f32x4 r; r[0] = bs + w0 * um + w1 * u0 + w2 * u1; r[1] = bs + w0 * u0 + w1 * u1 + w2 * u2; r[2] = bs + w0 * u1 + w1 * u2 + w2 * u3; r[3] = bs + w0 * u2 + w1 * u3 + w2 * up4; return r;
}
__device__ __forceinline__ void hy_conv(const LAS unsigned char* Z, const LAS unsigned char* GC, int T0, int fr, int fq, f32x4 (&acc)[16]) {
    const int rho = (8 - (fr & 7)) & 7;
    const LAS unsigned char* gb = GC + rho * HG_PITCH + (2048 - fr + 8 * fq - rho - T0) * 2;
    const LAS unsigned char* zb = Z + fr * HZ_PITCH + fq * 16;
    bf16x8 W[16], Bf, nA0, nA1, nB;
#pragma unroll
    for (int m = 0; m < 16; ++m) { W[m] = *(const LAS bf16x8*)(gb + (-16 * m) * 2); acc[m] = (f32x4){0.f, 0.f, 0.f, 0.f}; }
    Bf = *(const LAS bf16x8*)zb;
    for (int jj = 0; jj < 8; ++jj) {
#pragma unroll
        for (int ji = 0; ji < 8; ++ji) {
            const int j = 8 * jj + ji, jn = j + 1 < 64 ? j + 1 : 63;
            nA0 = *(const LAS bf16x8*)(gb + (32 * jn) * 2); nA1 = *(const LAS bf16x8*)(gb + (32 * jn - 16) * 2); nB = *(const LAS bf16x8*)(zb + 64 * jn);
            __builtin_amdgcn_sched_barrier(0);
#pragma unroll
            for (int m = 0; m < 16; ++m) acc[m] = __builtin_amdgcn_mfma_f32_16x16x32_bf16(W[(m - 2 * ji) & 15], Bf, acc[m], 0, 0, 0);
            W[(-2 * (ji + 1)) & 15] = nA0; W[(1 - 2 * (ji + 1)) & 15] = nA1; Bf = nB;
        }
    }
}
__device__ __forceinline__ void hyena_channel(Frame& F, int c) {
    LAS unsigned char* Z = F.lds; LAS unsigned char* GC = F.lds + HG_OFF;
    const int tid = F.tid, lane = F.lane, fr = lane & 15, fq = lane >> 4, T0 = 256 * F.wave;
    HPT_B(13);
    { const int cv = 1024 + c; const float w0 = F.cw[cv], w1 = F.cw[1536 + cv], w2 = F.cw[3072 + cv], bs = F.cb[cv];
#pragma unroll 1
      for (int i0 = 0; i0 < 8; i0 += 4) {
      v4u raw[4]; unsigned short hm1[4], hp8[4];
#pragma unroll
      for (int i = 0; i < 4; ++i) { const int chunk = tid + 512 * (i0 + i), b = chunk >> 8, tc = (chunk & 255) * 8; const GAS bf16* up = F.UT + (size_t)cv * T + b * SEQ;
          raw[i] = *(const GAS v4u*)(up + tc); hm1[i] = tc > 0 ? up[tc - 1] : (unsigned short)0; hp8[i] = tc + 8 < SEQ ? up[tc + 8] : (unsigned short)0; }
#pragma unroll
      for (int i = 0; i < 4; ++i) { const int chunk = tid + 512 * (i0 + i), b = chunk >> 8, tc = (chunk & 255) * 8;
          float u[10]; u[0] = bf2f(hm1[i]); u[1] = bflo(raw[i].x); u[2] = bfhi(raw[i].x); u[3] = bflo(raw[i].y); u[4] = bfhi(raw[i].y); u[5] = bflo(raw[i].z); u[6] = bfhi(raw[i].z); u[7] = bflo(raw[i].w); u[8] = bfhi(raw[i].w); u[9] = bf2f(hp8[i]);
          float r[8];
#pragma unroll
          for (int k = 0; k < 8; ++k) r[k] = bs + w0 * u[k] + w1 * u[k + 1] + w2 * u[k + 2];
          v4u o; o.x = pk2(r[0], r[1]); o.y = pk2(r[2], r[3]); o.z = pk2(r[4], r[5]); o.w = pk2(r[6], r[7]);
          *(LAS v4u*)(Z + b * HZ_PITCH + tc * 2) = o; } } }
    hy_load_filter(GC, F.G_ + (size_t)c * 4096, tid);
    __syncthreads(); HPT_E(13);
    f32x4 acc[16];
    HPT_B(11); hy_conv(Z, GC, T0, fr, fq, acc); HPT_E(11);
    HPT_B(14);
    { const float w0 = F.cw[c], w1 = F.cw[1536 + c], w2 = F.cw[3072 + c], bs = F.cb[c], sk = F.skip[c]; const GAS bf16* up = F.UT + (size_t)c * T + fr * SEQ;
#pragma unroll
      for (int m = 0; m < 16; ++m) { int t = T0 + 16 * m + 4 * fq; asm volatile("" : "+v"(t)); const u32x2 zo = *(const LAS u32x2*)(Z + fr * HZ_PITCH + t * 2); const f32x4 xs = hy_short4(up, t, w0, w1, w2, bs);
          acc[m][0] = xs[0] * (acc[m][0] + sk * bflo(zo.x)); acc[m][1] = xs[1] * (acc[m][1] + sk * bfhi(zo.x)); acc[m][2] = xs[2] * (acc[m][2] + sk * bflo(zo.y)); acc[m][3] = xs[3] * (acc[m][3] + sk * bfhi(zo.y)); } }
    HPT_E(14); HPT_B(15);
    __syncthreads();
#pragma unroll
    for (int m = 0; m < 16; ++m) { const int t = T0 + 16 * m + 4 * fq; u32x2 wv; wv.x = pk2(acc[m][0], acc[m][1]); wv.y = pk2(acc[m][2], acc[m][3]); *(LAS u32x2*)(Z + fr * HZ_PITCH + t * 2) = wv; }
    hy_load_filter(GC, F.G_ + (size_t)(512 + c) * 4096, tid);
    __syncthreads(); HPT_E(15);
    HPT_B(11); hy_conv(Z, GC, T0, fr, fq, acc); HPT_E(11);
    HPT_B(12);
    { const int cx = 512 + c; const float w0 = F.cw[cx], w1 = F.cw[1536 + cx], w2 = F.cw[3072 + cx], bs = F.cb[cx], sk = F.skip[512 + c]; const GAS bf16* up = F.UT + (size_t)cx * T + fr * SEQ;
      GAS bf16* hp = F.HYT + (size_t)c * T + fr * SEQ;
#pragma unroll
      for (int m = 0; m < 16; ++m) { int t = T0 + 16 * m + 4 * fq; asm volatile("" : "+v"(t)); const u32x2 zo = *(const LAS u32x2*)(Z + fr * HZ_PITCH + t * 2); const f32x4 xs = hy_short4(up, t, w0, w1, w2, bs);
          u32x2 wv; wv.x = pk2(xs[0] * (acc[m][0] + sk * bflo(zo.x)), xs[1] * (acc[m][1] + sk * bfhi(zo.x))); wv.y = pk2(xs[2] * (acc[m][2] + sk * bflo(zo.y)), xs[3] * (acc[m][3] + sk * bfhi(zo.y)));
          *(GAS u32x2*)(hp + t) = wv; } }
    __syncthreads();
    HPT_E(12);
}

__device__ __forceinline__ void hyt_transpose(Frame& F) {
    LAS unsigned short* scr = (LAS unsigned short*)(F.lds + F.wave * 16384);
    const int gw = F.vcu * NWAVES + F.wave, NGW = F.G * NWAVES, lane = F.lane, tcx = lane & 7, r8 = lane >> 3;
    GAS bf16* HY = F.ATT + (size_t)T * QW;
    for (int it = gw; it < 4096; it += NGW) {
        const int cb = it & 7, tb = it >> 3;
        v4u raw[8];
#pragma unroll
        for (int i = 0; i < 8; ++i) raw[i] = *(const GAS v4u*)(F.HYT + (size_t)(64 * cb + r8 + 8 * i) * T + 64 * tb + 8 * tcx);
#pragma unroll
        for (int i = 0; i < 8; ++i) { const int ch = r8 + 8 * i; LAS unsigned short* d = scr + (8 * tcx) * 66 + ch;
            d[0 * 66] = (unsigned short)raw[i].x; d[1 * 66] = (unsigned short)(raw[i].x >> 16); d[2 * 66] = (unsigned short)raw[i].y; d[3 * 66] = (unsigned short)(raw[i].y >> 16);
            d[4 * 66] = (unsigned short)raw[i].z; d[5 * 66] = (unsigned short)(raw[i].z >> 16); d[6 * 66] = (unsigned short)raw[i].w; d[7 * 66] = (unsigned short)(raw[i].w >> 16); }
        LDS_WAIT(); asm volatile("" ::: "memory");
#pragma unroll
        for (int i = 0; i < 8; ++i) { const int t = r8 + 8 * i; const LAS unsigned* sp = (const LAS unsigned*)(scr + t * 66 + 8 * tcx);
            v4u o; o.x = sp[0]; o.y = sp[1]; o.z = sp[2]; o.w = sp[3];
            *(GAS v4u*)(HY + (size_t)(64 * tb + t) * HYW + 64 * cb + 8 * tcx) = o; }
        LDS_WAIT(); asm volatile("" ::: "memory");
    }
}

__device__ __forceinline__ void load_row16(const GAS bf16* base, int row, int lane, f32x4 (&v)[4]) {
    const GAS u32x2* vr = (const GAS u32x2*)(base + (size_t)row * D) + lane;
    u32x2 t[4];
#pragma unroll
    for (int j = 0; j < 4; ++j) t[j] = vr[64 * j];
#pragma unroll
    for (int j = 0; j < 4; ++j) v[j] = (f32x4){bflo(t[j].x), bfhi(t[j].x), bflo(t[j].y), bfhi(t[j].y)};
}
__device__ __forceinline__ void ln_inplace(f32x4 (&v)[4]) {
    float s = 0.f;
#pragma unroll
    for (int j = 0; j < 4; ++j) s += (v[j].x + v[j].y) + (v[j].z + v[j].w);
    const float mean = wave_sum(s) * (1.f / D); float s2 = 0.f;
#pragma unroll
    for (int j = 0; j < 4; ++j) { v[j] = v[j] - mean; s2 += (v[j].x * v[j].x + v[j].y * v[j].y) + (v[j].z * v[j].z + v[j].w * v[j].w); }
    const float rstd = 1.f / sqrtf(wave_sum(s2) * (1.f / D) + LN_EPS);
#pragma unroll
    for (int j = 0; j < 4; ++j) v[j] = v[j] * rstd;
}
typedef _Float16 f16x8 __attribute__((ext_vector_type(8)));
typedef _Float16 f16x4 __attribute__((ext_vector_type(4)));
__device__ __forceinline__ void ln_inplace4(f32x4 (&v)[4][4]) {
    float s[4], q[4];
#pragma unroll
    for (int r = 0; r < 4; ++r) { s[r] = 0.f;
#pragma unroll
        for (int j = 0; j < 4; ++j) s[r] += (v[r][j].x + v[r][j].y) + (v[r][j].z + v[r][j].w); }
#pragma unroll
    for (int r = 0; r < 4; ++r) s[r] = wave_sum(s[r]) * (1.f / D);
#pragma unroll
    for (int r = 0; r < 4; ++r) { q[r] = 0.f;
#pragma unroll
        for (int j = 0; j < 4; ++j) { v[r][j] = v[r][j] - s[r]; q[r] += (v[r][j].x * v[r][j].x + v[r][j].y * v[r][j].y) + (v[r][j].z * v[r][j].z + v[r][j].w * v[r][j].w); } }
#pragma unroll
    for (int r = 0; r < 4; ++r) q[r] = 1.f / sqrtf(wave_sum(q[r]) * (1.f / D) + LN_EPS);
#pragma unroll
    for (int r = 0; r < 4; ++r)
#pragma unroll
        for (int j = 0; j < 4; ++j) v[r][j] = v[r][j] * q[r];
}
__device__ __forceinline__ void p6_route(Frame& F) {
    constexpr int RP = 2064;
    LAS unsigned char* W16 = F.lds;
    LAS unsigned char* HT = F.lds + 32 * RP;
    LAS float* LG = (LAS float*)(F.lds + 64 * RP);
    LAS int* rec = (LAS int*)(F.lds + 64 * RP + 8192);
    LAS float* recg = (LAS float*)(F.lds + 64 * RP + 8192 + 2048);
    LAS int* lcnt = (LAS int*)(F.lds + 64 * RP + 8192 + 4096);
    LAS int* lbase = lcnt + 32;
    const int tid = F.tid, lane = F.lane, w = F.wave, fr = lane & 15, fq = lane >> 4;
    for (int i = tid; i < 32768; i += NWAVES * 64) { const int k = i >> 5, e = i & 31; *(LAS _Float16*)(W16 + e * RP + k * 2) = (_Float16)F.rw[i]; }
    if (tid < 32) lcnt[tid] = 0;
    __syncthreads();
    const float rbias = F.rb[lane & 31];
    const int mt = w & 1, nt = (w >> 1) & 1, kh = w >> 2;
    for (int chunk = blockIdx.x; chunk < 256; chunk += F.G) {
        const int b = chunk >> 4;
#pragma unroll 1
        for (int grp = 0; grp < 4; ++grp) {
            const int rg0 = chunk * 128 + grp * 32;
            {
                f32x4 v[4][4];
#pragma unroll
                for (int rr = 0; rr < 4; ++rr) load_row16(F.V1, rg0 + 4 * w + rr, lane, v[rr]);
                int lo = 4 * lane; asm volatile("" : "+v"(lo));
                ln_inplace4(v);
#pragma unroll
                for (int rr = 0; rr < 4; ++rr)
#pragma unroll
                    for (int j = 0; j < 4; ++j) v[rr][j] = v[rr][j] * *(const GAS f32x4*)(F.ln1g + lo + 256 * j) + *(const GAS f32x4*)(F.ln1b + lo + 256 * j);
                ln_inplace4(v);
#pragma unroll
                for (int rr = 0; rr < 4; ++rr) { const int rl = 4 * w + rr;
#pragma unroll
                    for (int j = 0; j < 4; ++j) { v[rr][j] = v[rr][j] * (*(const GAS f32x4*)(F.modF + b * 6144 + 4096 + lo + 256 * j) + 1.f) + *(const GAS f32x4*)(F.modF + b * 6144 + 3072 + lo + 256 * j);
                        *(GAS unsigned*)((GAS unsigned char*)F.HM + (size_t)(rg0 + rl) * D + 4 * lane + 256 * j) = pk4_fp8(v[rr][j].x, v[rr][j].y, v[rr][j].z, v[rr][j].w);
                        const f16x4 hv = {(_Float16)v[rr][j].x, (_Float16)v[rr][j].y, (_Float16)v[rr][j].z, (_Float16)v[rr][j].w};
                        *(LAS f16x4*)(HT + rl * RP + (4 * lane + 256 * j) * 2) = hv; } }
            }
            __syncthreads();
            {
                f32x4 acc = {0.f, 0.f, 0.f, 0.f};
                const LAS unsigned char* wp = W16 + (16 * nt + fr) * RP + (512 * kh + 8 * fq) * 2; const LAS unsigned char* hp = HT + (16 * mt + fr) * RP + (512 * kh + 8 * fq) * 2;
#pragma unroll 4
                for (int s2 = 0; s2 < 16; ++s2) acc = __builtin_amdgcn_mfma_f32_16x16x32_f16(*(const LAS f16x8*)(wp + 64 * s2), *(const LAS f16x8*)(hp + 64 * s2), acc, 0, 0, 0);
#pragma unroll
                for (int k = 0; k < 4; ++k) LG[(kh * 32 + 16 * mt + fr) * 32 + 16 * nt + 4 * fq + k] = acc[k];
            }
            __syncthreads();
#pragma unroll 1
            for (int i = 0; i < 4; ++i) { const int rl = 4 * w + i;
                float cur = LG[rl * 32 + (lane & 31)] + LG[(32 + rl) * 32 + (lane & 31)] + rbias;
                float tv[4]; int te[4];
#pragma unroll
                for (int k = 0; k < 4; ++k) { const float mx = wave_max(cur);
                    const unsigned long long mask = __ballot(cur == mx); const int src = __ffsll((long long)mask) - 1; te[k] = src & 31; tv[k] = mx; if ((lane & 31) == te[k]) cur = -INFINITY; }
                const float p1 = __expf(tv[1] - tv[0]), p2 = __expf(tv[2] - tv[0]), p3 = __expf(tv[3] - tv[0]), inv = 1.f / (1.f + p1 + p2 + p3);
                if (lane < 4) { const int es = lane == 0 ? te[0] : lane == 1 ? te[1] : lane == 2 ? te[2] : te[3]; const float gs = (lane == 0 ? 1.f : lane == 1 ? p1 : lane == 2 ? p2 : p3) * inv;
                    const int rc = grp * 32 + rl;
                    const int rank = __hip_atomic_fetch_add(lcnt + es, 1, __ATOMIC_RELAXED, __HIP_MEMORY_SCOPE_WORKGROUP);
                    rec[rc * 4 + lane] = es | (rank << 5); recg[rc * 4 + lane] = gs; }
            }
            __syncthreads();
        }
        if (tid < 32) { gu32* cp = F.ctl; asm volatile("" : "+s"(cp)); const int cnt = lcnt[tid]; lbase[tid] = cnt ? (int)__hip_atomic_fetch_add(cp + CW_CNT + tid, (unsigned)cnt, RLX_AGENT) : 0; }
        __syncthreads();
        { const int r = rec[tid], e = r & 31, pos = lbase[e] + (r >> 5), row = chunk * 128 + (tid >> 2);
          F.tok[e * 32768 + pos] = row; F.asg[row * 4 + (tid & 3)] = e * 32768 + pos; F.gw[row * 4 + (tid & 3)] = recg[tid]; }
        __syncthreads();
        if (tid < 32) lcnt[tid] = 0;
        __syncthreads();
    }
}
__device__ __forceinline__ void moe_tables(Frame& F) {
    LAS int* tp = (LAS int*)(F.lds + TP_OFF);
    if (F.tid < 32) { gu32* cp = F.ctl; asm volatile("" : "+s"(cp)); const int cnt = (int)__hip_atomic_load(cp + CW_CNT + F.tid, RLX_AGENT);
        tp[33 + F.tid] = cnt; tp[65 + F.tid] = (cnt + 255) >> 8; }
    __syncthreads();
    if (F.tid < 33) { int a = 0;
        for (int e = 0; e < 32; ++e) a += (e < F.tid) ? tp[65 + e] : 0;
        tp[F.tid] = a; }
    __syncthreads();
}

typedef int i32x4 __attribute__((ext_vector_type(4)));
__device__ __forceinline__ void p9_final(Frame& F) {
    const LAS int* tp = (const LAS int*)(F.lds + TP_OFF);
    const int lane = F.lane;
    f32x4 g1v[4], b1v[4], g2v[4], b2v[4];
#pragma unroll
    for (int j = 0; j < 4; ++j) { const int col = 4 * lane + 256 * j; g1v[j] = *(const GAS f32x4*)(F.ln1g + col); b1v[j] = *(const GAS f32x4*)(F.ln1b + col); g2v[j] = *(const GAS f32x4*)(F.ln2g + col); b2v[j] = *(const GAS f32x4*)(F.ln2b + col); }
    for (int chunk = blockIdx.x; chunk < 256; chunk += F.G) {
        const int b = chunk >> 4, row0 = chunk * 128 + F.wave * 16;
        f32x4 gm[4];
#pragma unroll
        for (int j = 0; j < 4; ++j) gm[j] = *(const GAS f32x4*)(F.modF + b * 6144 + 5120 + 4 * lane + 256 * j);
        f32x4 v[4]; i32x4 a = *(const GAS i32x4*)(F.asg + row0 * 4); f32x4 g = *(const GAS f32x4*)(F.gw + row0 * 4);
        load_row16(F.V1, row0, lane, v);
        for (int it = 0; it < 16; ++it) {
            const int row = row0 + it, rn = it < 15 ? row + 1 : row;
            unsigned y[4][4];
#pragma unroll
            for (int k = 0; k < 4; ++k) { const int e = a[k] >> 15, pos = a[k] & 32767; const GAS unsigned char* yp = (const GAS unsigned char*)F.YB + (size_t)(256 * tp[e] + pos) * D + 4 * lane;
#pragma unroll
                for (int j = 0; j < 4; ++j) y[k][j] = __builtin_nontemporal_load((const GAS unsigned*)(yp + 256 * j)); }
            f32x4 nv[4]; load_row16(F.V1, rn, lane, nv);
            const i32x4 na = *(const GAS i32x4*)(F.asg + rn * 4); const f32x4 ng = *(const GAS f32x4*)(F.gw + rn * 4);
            ln_inplace(v);
#pragma unroll
            for (int j = 0; j < 4; ++j) { f32x4 f = {0.f, 0.f, 0.f, 0.f};
#pragma unroll
                for (int k = 0; k < 4; ++k) { const f32x2 lo = __builtin_amdgcn_cvt_pk_f32_fp8((int)y[k][j], false), hi = __builtin_amdgcn_cvt_pk_f32_fp8((int)y[k][j], true); f[0] += g[k] * lo[0]; f[1] += g[k] * lo[1]; f[2] += g[k] * hi[0]; f[3] += g[k] * hi[1]; }
                v[j] = (v[j] * g1v[j] + b1v[j]) * DN_ALPHA + gm[j] * f; }
            ln_inplace(v);
#pragma unroll
            for (int j = 0; j < 4; ++j) __builtin_nontemporal_store(v[j] * g2v[j] + b2v[j], (GAS f32x4*)(F.out + (size_t)row * D + 4 * lane + 256 * j));
#pragma unroll
            for (int j = 0; j < 4; ++j) v[j] = nv[j];
            a = na; g = ng;
        }
    }
}

struct Args { const float* in[29]; float* out; unsigned char* ws; int ph_lo, ph_hi; };
__global__ void __launch_bounds__(NWAVES * 64, 2) mk_fwd(Args args) {
    extern __shared__ __attribute__((aligned(16))) unsigned char lds[];
    Frame F;
    F.lds = (LAS unsigned char*)lds;
    F.MISC = (volatile LAS unsigned*)(F.lds + MISC_OFF);
    F.tid = threadIdx.x; F.lane = F.tid & 63; F.wave = __builtin_amdgcn_readfirstlane(F.tid >> 6);
    F.G = gridDim.x; { const int bx = blockIdx.x; F.vcu = (F.G % 8 == 0) ? (bx % 8) * (F.G / 8) + bx / 8 : bx; }
    unsigned char* ws = args.ws;
    F.ctl = (gu32*)(ws + WS_CTL);
    F.x = (const GAS float*)args.in[0]; F.c = (const GAS float*)args.in[1]; F.ctx = (const GAS float*)args.in[2]; F.c_ctx = (const GAS float*)args.in[3]; F.w_mod = (const GAS float*)args.in[4]; F.b_mod = (const GAS float*)args.in[5]; F.w_in = (const GAS float*)args.in[6]; F.sink = (const GAS float*)args.in[7];
    F.cw = (const GAS float*)args.in[8]; F.cb = (const GAS float*)args.in[9]; F.fw1 = (const GAS float*)args.in[10]; F.fb1 = (const GAS float*)args.in[11]; F.fw2 = (const GAS float*)args.in[12]; F.fb2 = (const GAS float*)args.in[13]; F.fw3 = (const GAS float*)args.in[14]; F.skip = (const GAS float*)args.in[15];
    F.w_ba = (const GAS float*)args.in[16]; F.w_bh = (const GAS float*)args.in[17]; F.w_out = (const GAS float*)args.in[18]; F.ln1g = (const GAS float*)args.in[19]; F.ln1b = (const GAS float*)args.in[20]; F.rw = (const GAS float*)args.in[21]; F.rb = (const GAS float*)args.in[22];
    F.ew1 = (const GAS float*)args.in[23]; F.eb1 = (const GAS float*)args.in[24]; F.ew2 = (const GAS float*)args.in[25]; F.eb2 = (const GAS float*)args.in[26]; F.ln2g = (const GAS float*)args.in[27]; F.ln2b = (const GAS float*)args.in[28]; F.out = (GAS float*)args.out;
    F.modP = (GAS float*)(ws + WS_MODP); F.modF = (GAS float*)(ws + WS_MODF); F.rope = (GAS float*)(ws + WS_ROPE); F.gw = (GAS float*)(ws + WS_GW); F.V1 = (GAS bf16*)(ws + WS_V1);
    F.asg = (GAS int*)(ws + WS_ASG); F.tok = (GAS int*)(ws + WS_TOK);
    F.G_ = (GAS bf16*)(ws + WS_G); F.WB = (GAS bf16*)(ws + WS_WB); F.WO = (GAS bf16*)(ws + WS_WO); F.WIN = (GAS bf16*)(ws + WS_WIN); F.W1 = (GAS bf16*)(ws + WS_W1); F.W2 = (GAS bf16*)(ws + WS_W2);
    F.HM = (GAS bf16*)(ws + WS_HM); F.HX = (GAS bf16*)(ws + WS_HX); F.Q = (GAS bf16*)(ws + WS_Q); F.K = (GAS bf16*)(ws + WS_K); F.VT = (GAS bf16*)(ws + WS_VT); F.KC = (GAS bf16*)(ws + WS_KC); F.VTC = (GAS bf16*)(ws + WS_VTC);
    F.UT = (GAS bf16*)(ws + WS_UT); F.GATE = (GAS bf16*)(ws + WS_GATE); F.ATT = (GAS bf16*)(ws + WS_ATT); F.MM = (GAS bf16*)(ws + WS_MM); F.ACT = (GAS bf16*)(ws + WS_ACT); F.YB = (GAS bf16*)(ws + WS_YB); F.HYT = (GAS bf16*)(ws + WS_HYT);
    for (int u = F.tid; u < (LDS_BYTES - LDSCTL_OFF) / 4; u += NWAVES * 64) ((LAS unsigned*)(F.lds + LDSCTL_OFF))[u] = 0u;
    __syncthreads();
    XcdBarrier bar; bar.bar = (unsigned*)(F.ctl + CW_BAR); bar.x = 0; bar.st = nullptr;
    if (N_LAUNCHES == 1) bar = xcd_barrier_post((unsigned*)(F.ctl + CW_BAR), F.MISC + 8);
#define GRID_BAR() do { if (N_LAUNCHES == 1) { if (PROBE_SPIN == 20 || PROBE_SPIN == 21 + nbar_) pt0_ = rt(); xcd_barrier(bar); if (PROBE_SPIN == 20 || PROBE_SPIN == 21 + nbar_) ptacc_ += rt() - pt0_; ++nbar_; } } while (0)
    const int lo = args.ph_lo, hi = args.ph_hi;
#ifndef PHMASK
#define PHMASK 0x3ff
#endif
#define IN(k) (((PHMASK >> (k)) & 1) && lo <= (k) && (k) < hi)
#define BOTH(k) (IN(k) && IN((k) + 1))
#define FRESH() do { F.lane = pg8::lane_id_v(); F.tid = F.wave * 64 + F.lane; } while (0)
    const int bx = (int)blockIdx.x;
    unsigned long long pt0_ = 0, ptacc_ = 0; F.pt0 = 0; F.ptacc = 0; int nbar_ = 0;
#define PT_BEGIN(k) do { if (PROBE_SPIN == (k)) pt0_ = rt(); } while (0)
#define PT_END(k) do { if (PROBE_SPIN == (k)) ptacc_ += rt() - pt0_; } while (0)

    if (IN(0)) { FRESH(); PT_BEGIN(0); p0_prologue(F); if (IN(2)) GRID_BAR(); PT_END(0); }
    if (IN(2)) { FRESH();
        pg8::Gemm g{(const bf16*)F.HX, (const bf16*)F.WIN, 1024, F.wave}; SchedInProj S; S.so.init(128, 17, F.G, bx); S.G = F.G; S.c = bx;
        EpiInProj E{F.Q, F.K, F.VT, F.KC, F.VTC, F.UT, F.GATE, F.rope};
        PT_BEGIN(2); pg8::gemm_phase<EpiInProj, SchedInProj, true, false>(F.lds, g, S, E);
        if (BOTH(2)) GRID_BAR(); PT_END(2);
    }
    if (IN(3)) { FRESH();
        PT_BEGIN(3); for (int u = bx; u < 512; u += F.G) attn_unit(F, u >> 5, (u >> 4) & 1, u & 15); PT_END(3);
        FRESH(); PT_BEGIN(10); for (int ch = F.vcu; ch < 512; ch += F.G) hyena_channel(F, ch);
        if (BOTH(3)) GRID_BAR(); PT_END(10);
    }
    if (IN(4)) { FRESH();
        PT_BEGIN(4); hyt_transpose(F); GRID_BAR(); PT_END(4);
        pg8::Gemm g{(const bf16*)F.ATT, (const bf16*)F.WB, 512, F.wave}; SchedPair S; S.so.init(128, 4, F.G, bx);
        EpiMerge E{F.GATE, F.MM};
        PT_BEGIN(17); pg8::gemm_phase<EpiMerge, SchedPair, true, false>(F.lds, g, S, E);
        if (BOTH(4)) GRID_BAR(); PT_END(17);
    }
    if (IN(5)) { FRESH();
        pg8::Gemm g{(const bf16*)F.MM, (const bf16*)F.WO, 1024, F.wave}; SchedPlain S; S.so.init(128, 4, F.G, bx);
        EpiV1 E{F.x, F.modF, F.V1};
        PT_BEGIN(5); pg8::gemm_phase<EpiV1, SchedPlain, true, false>(F.lds, g, S, E);
        if (BOTH(5)) GRID_BAR(); PT_END(5);
    }
    if (IN(6)) { FRESH(); PT_BEGIN(6); p6_route(F); if (BOTH(6)) GRID_BAR(); PT_END(6); }
    if (IN(7)) { FRESH();
        moe_tables(F);
        pg8::Gemm g{(const bf16*)F.HM, (const bf16*)F.W1, 512, F.wave}; SchedMoe S{(const LAS int*)(F.lds + TP_OFF), F.tok, 8, F.G, bx};
        EpiAct E{F.eb1, F.ACT};
        PT_BEGIN(7); pg8::gemm_phase<EpiAct, SchedMoe, true, true, true>(F.lds, g, S, E);
        if (BOTH(7)) GRID_BAR(); PT_END(7);
    }
    if (IN(8)) { FRESH();
        moe_tables(F);
        pg8::Gemm g{(const bf16*)F.ACT, (const bf16*)F.W2, 512, F.wave}; SchedMoe S{(const LAS int*)(F.lds + TP_OFF), F.tok, 4, F.G, bx};
        EpiYb E{F.eb2, F.YB};
        PT_BEGIN(8); pg8::gemm_phase<EpiYb, SchedMoe, true, false, true>(F.lds, g, S, E);
        if (BOTH(8)) GRID_BAR(); PT_END(8);
    }
    if (IN(9)) { FRESH(); PT_BEGIN(9); moe_tables(F); p9_final(F); PT_END(9); }
    if (PROBE_SPIN >= 0 && bx == 0) { const unsigned long long t0_ = rt(); const unsigned long long gacc_ = (PROBE_SPIN == 18 || PROBE_SPIN == 19) ? *(volatile LAS unsigned long long*)(F.lds + 153600) : 0ull; while (rt() - t0_ < ptacc_ + F.ptacc + gacc_) __builtin_amdgcn_s_sleep(8); }
#undef IN
#undef BOTH
#undef GRID_BAR
}

extern "C" void kernel_launch(void* const* d_in, const int* in_sizes, int n_in, void* d_out, int out_size, void* d_ws, size_t ws_size, hipStream_t stream) {
    static int grid = 0;
    if (grid == 0) {
        if (n_in != 29 || in_sizes[0] != T * D || out_size != T * D || ws_size < WS_END) { fprintf(stderr, "kernel_launch: unexpected shapes (n_in %d, in0 %d, out %d, ws %zu); nothing launched\n", n_in, n_in > 0 ? in_sizes[0] : -1, out_size, ws_size); grid = -1; return; }
        int dev = 0, cus = 0, per_cu = 0;
        if (hipGetDevice(&dev) != hipSuccess || hipDeviceGetAttribute(&cus, hipDeviceAttributeMultiprocessorCount, dev) != hipSuccess) { grid = -1; return; }
        if (hipFuncSetAttribute((const void*)mk_fwd, hipFuncAttributeMaxDynamicSharedMemorySize, LDS_BYTES) != hipSuccess) { fprintf(stderr, "kernel_launch: hipFuncSetAttribute failed\n"); grid = -1; return; }
        if (hipOccupancyMaxActiveBlocksPerMultiprocessor(&per_cu, (const void*)mk_fwd, NWAVES * 64, LDS_BYTES) != hipSuccess || per_cu < 1) { fprintf(stderr, "kernel_launch: occupancy query reports %d workgroups per CU\n", per_cu); }
        (void)hipGetLastError();
        grid = cus < 256 ? cus : 256;
    }
    if (grid < 0) return;
    if (hipMemsetAsync((char*)d_ws + WS_CTL, 0, CTL_ZERO_BYTES, stream) != hipSuccess) return;
    Args a{};
    for (int i = 0; i < 29; ++i) a.in[i] = (const float*)d_in[i];
    a.out = (float*)d_out; a.ws = (unsigned char*)d_ws;
    if (N_LAUNCHES == 1) { a.ph_lo = 0; a.ph_hi = NPH; hipLaunchKernelGGL(mk_fwd, dim3(grid), dim3(NWAVES * 64), LDS_BYTES, stream, a); }
    else for (int p = 0; p < NPH; ++p) { a.ph_lo = p; a.ph_hi = p + 1; hipLaunchKernelGGL(mk_fwd, dim3(grid), dim3(NWAVES * 64), LDS_BYTES, stream, a); }
}
```

```cpp
#include <hip/hip_runtime.h>
#include <cstdio>
#include <cstdint>
#include <cmath>
namespace pg8 {
#define PG8_LAS __attribute__((address_space(3)))
typedef unsigned short bf16_t;
typedef short bf16x8 __attribute__((ext_vector_type(8)));
typedef float f32x4 __attribute__((ext_vector_type(4)));
typedef unsigned u32x4 __attribute__((ext_vector_type(4)));
constexpr int BM = 256, BK = 64, HALF = 128, HTB = HALF * BK * 2  , STAGE_BYTES = 8 * HTB, NXCD = 8, WGM = 8;

__host__ __device__ __forceinline__ int lds_byte(int r, int c) { const int st = (r >> 4) * 2 + (c >> 5), rr = r & 15, cc = c & 31, ob = rr * 64 + cc * 2; return st * 1024 + (ob ^ (((ob >> 9) & 1) << 5)); }
__host__ __device__ __forceinline__ void stage_rc(int b, int& R, int& C) { const int st = b / 1024, sb = b % 1024, swz = sb ^ (((sb >> 9) & 1) << 5); R = (st >> 1) * 16 + swz / 64; C = (st & 1) * 32 + (swz % 64) / 2; }
__host__ __device__ __forceinline__ int perm32(int rho) { const int n = rho >> 4, i = rho & 15; return 8 * (i >> 2) + 4 * n + (i & 3); }

struct Unit { int pm, pn; };
struct Gemm { const bf16_t* A; const bf16_t* Bt; int K; int wave; };

struct StaticOrder {
    int nM, nN, nwg, G, c, wgm = WGM;
    __host__ __device__ void init(int nM_, int nN_, int G_, int c_) { nM = nM_; nN = nN_; nwg = nM * nN; G = G_; c = c_; }
    __host__ __device__ bool next(int i, Unit& u) const {
        const long L = (long)i * G + c; if (L >= nwg) return false;
        int wgid = (int)L; { const int q = nwg / NXCD, r = nwg % NXCD, xcd = wgid % NXCD, off = wgid / NXCD; wgid = (xcd < r ? xcd * (q + 1) : r * (q + 1) + (xcd - r) * q) + off; }
        const int nig = wgm * nN, gid = wgid / nig, fm = gid * wgm, gsz = (nM - fm) < wgm ? (nM - fm) : wgm;
        u.pm = fm + ((wgid % nig) % gsz); u.pn = (wgid % nig) / gsz; return true;
    }
};

typedef float f32x2_cv __attribute__((ext_vector_type(2))); typedef __bf16 bf16x2_cv __attribute__((ext_vector_type(2)));
__device__ __forceinline__ unsigned cvt_pk_bf16(float lo, float hi) { const f32x2_cv v = {lo, hi}; const bf16x2_cv b = __builtin_convertvector(v, bf16x2_cv); return __builtin_bit_cast(unsigned, b); }

__device__ __forceinline__ int lane_id_v() { int l; asm volatile("v_mbcnt_lo_u32_b32 %0, -1, 0\n\tv_mbcnt_hi_u32_b32 %0, -1, %0" : "=v"(l)); return l; }
typedef int i32x4_t __attribute__((ext_vector_type(4)));
typedef int i32x8_t __attribute__((ext_vector_type(8)));
__device__ __forceinline__ i32x8_t cat8(bf16x8 lo, bf16x8 hi) { const i32x4_t a = __builtin_bit_cast(i32x4_t, lo), b = __builtin_bit_cast(i32x4_t, hi); return __builtin_shufflevector(a, b, 0, 1, 2, 3, 4, 5, 6, 7); }
#ifndef PROBE_SPIN
#define PROBE_SPIN -1
#endif
#define PG8_PT_B(k) do { if (PROBE_SPIN == (k) && FP8 && !GATHER && tid == 0) pt_t0 = __builtin_amdgcn_s_memrealtime(); } while (0)
#define PG8_PT_E(k) do { if (PROBE_SPIN == (k) && FP8 && !GATHER && tid == 0) *(volatile PG8_LAS unsigned long long*)(lds + 153600) += __builtin_amdgcn_s_memrealtime() - pt_t0; } while (0)
template <class Epi, class Sched, bool ALIGN_EPI, bool GATHER, bool FP8 = false>
__device__ __forceinline__ void gemm_phase(PG8_LAS unsigned char* lds, const Gemm g, const Sched& S, const Epi& E) {
    const int wid = g.wave, lane = lane_id_v(), tid = wid * 64 + lane, wr = wid >> 2, wc = wid & 3, fr = lane & 15, fq = lane >> 4;
    const int K = g.K, nt = K / BK;
    unsigned voffA[2], voffB[2]; int gR[2]; unsigned gC[2];
#pragma unroll
    for (int i = 0; i < 2; ++i) { int R, C; stage_rc(tid * 16 + i * 8192, R, C); const int Rb = Epi::PERM ? ((R & ~31) + perm32(R & 31)) : R;
        voffA[i] = (unsigned)(R * K + C) * 2u; voffB[i] = (unsigned)(Rb * K + C) * 2u; gR[i] = R; gC[i] = (unsigned)C * 2u; }
    const size_t kstep = (size_t)(BK * 2);
    const size_t hstep = (size_t)HALF * K * 2;
    const size_t tstep = 2 * hstep;
    const size_t r64 = (size_t)64 * K * 2;
    const unsigned ldsw = (unsigned)wid * 1024u;
    const int aoff = lds_byte(wr * 64 + fr, fq * 8), boff = lds_byte(wc * 32 + fr, fq * 8);
#define PG8_SA(b, h) (((b) * 2 + (h)) * HTB)
#define PG8_SB(b, h) ((4 + (b) * 2 + (h)) * HTB)
#define PG8_STAGE(bufoff, gbase, voff) do { _Pragma("unroll") for (int _i = 0; _i < 2; ++_i) { unsigned v_ = (voff)[0]; if constexpr (FP8 && GATHER) asm volatile("" : "+v"(v_)); \
        __builtin_amdgcn_global_load_lds((const unsigned*)((const char*)(gbase) + (size_t)_i * r64 + v_), (PG8_LAS unsigned*)(lds + (bufoff) + ldsw + _i * 8192), 16, 0, 0); } } while (0)
#define PG8_STAGE_G(bufoff, gbase, pk) do { _Pragma("unroll") for (int _i = 0; _i < 2; ++_i) { unsigned p_ = (pk); asm volatile("" : "+v"(p_));   \
        __builtin_amdgcn_global_load_lds((const unsigned*)((const char*)(gbase) + (((p_ >> (16 * _i)) & 0xffffu) * (unsigned)(K * 2) + gC[0])), (PG8_LAS unsigned*)(lds + (bufoff) + ldsw + _i * 8192), 16, 0, 0); } } while (0)
#define PG8_STAGE_A(b, h, kp, VS) do { if constexpr (GATHER) { PG8_STAGE_G(PG8_SA(b, h), (kp), VS[h]); } else { PG8_STAGE(PG8_SA(b, h), (kp) + (size_t)(h) * hstep, voffA); } } while (0)
#define PG8_LDA(dst, b, h) do { _Pragma("unroll") for (int m = 0; m < 4; ++m) { if constexpr (FP8) { dst##8[m] = __builtin_shufflevector(*(const PG8_LAS i32x4_t*)(lds + PG8_SA(b, h) + aoff + m * 2048), *(const PG8_LAS i32x4_t*)(lds + PG8_SA(b, h) + aoff + m * 2048 + 1024), 0, 1, 2, 3, 4, 5, 6, 7); } \
        else { _Pragma("unroll") for (int k = 0; k < 2; ++k) dst[m][k] = *(const PG8_LAS bf16x8*)(lds + PG8_SA(b, h) + aoff + m * 2048 + k * 1024); } } } while (0)
#define PG8_LDB(dst, b, h) do { _Pragma("unroll") for (int n = 0; n < 2; ++n) { if constexpr (FP8) { dst##8[n] = __builtin_shufflevector(*(const PG8_LAS i32x4_t*)(lds + PG8_SB(b, h) + boff + n * 2048), *(const PG8_LAS i32x4_t*)(lds + PG8_SB(b, h) + boff + n * 2048 + 1024), 0, 1, 2, 3, 4, 5, 6, 7); } \
        else { _Pragma("unroll") for (int k = 0; k < 2; ++k) dst[n][k] = *(const PG8_LAS bf16x8*)(lds + PG8_SB(b, h) + boff + n * 2048 + k * 1024); } } } while (0)
#define PG8_MMA(ai, bj, At, Bt) do { __builtin_amdgcn_s_setprio(1); _Pragma("unroll") for (int m = 0; m < 4; ++m) _Pragma("unroll") for (int n = 0; n < 2; ++n) { \
        if constexpr (FP8) { acc[ai][bj][m][n] = __builtin_amdgcn_mfma_scale_f32_16x16x128_f8f6f4(Bt##8[n], At##8[m], acc[ai][bj][m][n], 0, 0, 0, 0, 0, 0); } \
        else { _Pragma("unroll") for (int k = 0; k < 2; ++k) acc[ai][bj][m][n] = __builtin_amdgcn_mfma_f32_16x16x32_bf16(Bt[n][k], At[m][k], acc[ai][bj][m][n], 0, 0, 0); } } __builtin_amdgcn_s_setprio(0); } while (0)
#define PG8_WAIT_V(n) asm volatile("s_waitcnt vmcnt(" #n ")" ::: "memory")
#define PG8_WAIT_L(n) asm volatile("s_waitcnt lgkmcnt(" #n ")" ::: "memory")
#define PG8_BAR __builtin_amdgcn_s_barrier()
#define PG8_SCHED __builtin_amdgcn_sched_barrier(0)
    unsigned long long pt_t0 = 0;
    Unit cur, nxt; int ui = 0;
    if (!S.next(0, cur)) return;
    f32x4 acc[2][2][4][2];
#pragma unroll
    for (int a = 0; a < 2; ++a)
#pragma unroll
        for (int b = 0; b < 2; ++b)
#pragma unroll
            for (int m = 0; m < 4; ++m)
#pragma unroll
                for (int n = 0; n < 2; ++n) acc[a][b][m][n] = (f32x4){0.f, 0.f, 0.f, 0.f};
    bf16x8 At[4][2], B0[2][2], B1[2][2]; i32x8_t At8[4], B08[2], B18[2];
    unsigned vAc[2];
    const char* cA = GATHER ? (const char*)g.A : (const char*)g.A + (size_t)cur.pm * tstep; const char* cB = (const char*)g.Bt + (size_t)cur.pn * tstep;
    if constexpr (GATHER) {
#pragma unroll
        for (int h = 0; h < 2; ++h) vAc[h] = (unsigned)S.rowoff(cur, h * HALF + gR[0]) | ((unsigned)S.rowoff(cur, h * HALF + gR[0] + 64) << 16);
    }
    PG8_STAGE(PG8_SB(0, 0), cB, voffB); PG8_STAGE(PG8_SB(0, 1), cB + hstep, voffB); PG8_STAGE_A(0, 0, cA, vAc); PG8_STAGE_A(0, 1, cA, vAc);
    if (wr == 1) PG8_BAR;
    PG8_WAIT_V(2); PG8_BAR;
    PG8_STAGE(PG8_SB(1, 0), cB + kstep, voffB); PG8_STAGE_A(1, 0, cA + kstep, vAc); PG8_STAGE(PG8_SB(1, 1), cB + hstep + kstep, voffB);
    PG8_WAIT_V(6); PG8_BAR;
    for (;;) {
        const bool has_next = S.next(ui + 1, nxt);
        const char* nA = GATHER ? cA : (has_next ? (const char*)g.A + (size_t)nxt.pm * tstep : cA); const char* nB = has_next ? (const char*)g.Bt + (size_t)nxt.pn * tstep : cB;
        int gr0 = 0, gr1 = 0, gr2 = 0, gr3 = 0;
        if constexpr (GATHER) {
            const int t_ = wid * 64 + lane_id_v(); int R_, C_; stage_rc(t_ * 16, R_, C_);
            if (has_next) { gr0 = S.rowoff(nxt, R_); gr1 = S.rowoff(nxt, R_ + 64); gr2 = S.rowoff(nxt, HALF + R_); gr3 = S.rowoff(nxt, HALF + R_ + 64); }
        }
#pragma unroll 1
        for (int t = 0; t < nt; t += 2) {
            const bool last = (t == nt - 2);
            const char* a1 = cA + (size_t)(t + 1) * kstep;
            const char* a2 = last ? nA : cA + (size_t)(t + 2) * kstep; const char* b2 = last ? nB : cB + (size_t)(t + 2) * kstep;
            const char* a3 = a2 + kstep; const char* b3 = b2 + kstep;
            PG8_LDB(B0, 0, 0); PG8_LDB(B1, 0, 1); PG8_SCHED; PG8_LDA(At, 0, 0); PG8_STAGE_A(1, 1, a1, vAc);
            if constexpr (GATHER) { if (last && has_next) { vAc[0] = (unsigned)gr0 | ((unsigned)gr1 << 16); vAc[1] = (unsigned)gr2 | ((unsigned)gr3 << 16); } }
            PG8_WAIT_V(8); PG8_WAIT_L(0); PG8_BAR; PG8_MMA(0, 0, At, B0); PG8_MMA(0, 1, At, B1); PG8_BAR; PG8_SCHED;
            PG8_LDA(At, 0, 1); PG8_STAGE(PG8_SB(0, 0), b2, voffB); PG8_STAGE(PG8_SB(0, 1), b2 + hstep, voffB); PG8_STAGE_A(0, 0, a2, vAc);
            PG8_WAIT_V(8); PG8_WAIT_L(0); PG8_BAR; PG8_MMA(1, 0, At, B0); PG8_MMA(1, 1, At, B1); PG8_BAR; PG8_SCHED;
            PG8_LDB(B0, 1, 0); PG8_LDB(B1, 1, 1); PG8_SCHED; PG8_LDA(At, 1, 0); PG8_STAGE_A(0, 1, a2, vAc);
            PG8_WAIT_V(8); PG8_WAIT_L(0); PG8_BAR; PG8_MMA(0, 0, At, B0); PG8_MMA(0, 1, At, B1); PG8_BAR; PG8_SCHED;
            PG8_LDA(At, 1, 1); PG8_STAGE(PG8_SB(1, 0), b3, voffB); PG8_STAGE(PG8_SB(1, 1), b3 + hstep, voffB); PG8_STAGE_A(1, 0, a3, vAc);
            PG8_WAIT_V(8); PG8_WAIT_L(0); PG8_BAR; PG8_MMA(1, 0, At, B0); PG8_MMA(1, 1, At, B1); PG8_BAR; PG8_SCHED;
        }
        PG8_PT_B(18);
        if constexpr (ALIGN_EPI) { if (wr == 0) PG8_BAR; }
        PG8_PT_B(19); { const int l_ = lane_id_v(); E(acc, cur, wr, wc, l_ & 15, l_ >> 4); } PG8_PT_E(19);
        if (!has_next) break;
#pragma unroll
        for (int a = 0; a < 2; ++a)
#pragma unroll
            for (int b = 0; b < 2; ++b)
#pragma unroll
                for (int m = 0; m < 4; ++m)
#pragma unroll
                    for (int n = 0; n < 2; ++n) acc[a][b][m][n] = (f32x4){0.f, 0.f, 0.f, 0.f};
        cur = nxt; cA = nA; cB = nB; ++ui;
        if constexpr (ALIGN_EPI) { if (wr == 1) PG8_BAR; }
        PG8_PT_E(18);
    }
    PG8_WAIT_V(0);
    if constexpr (!ALIGN_EPI) { if (wr == 0) PG8_BAR; }
    PG8_BAR;
#undef PG8_SA
#undef PG8_SB
#undef PG8_STAGE
#undef PG8_STAGE_A
#undef PG8_STAGE_G
#undef PG8_LDA
#undef PG8_LDB
#undef PG8_MMA
#undef PG8_WAIT_V
#undef PG8_WAIT_L
#undef PG8_BAR
#undef PG8_SCHED
}
}
#define GAS __attribute__((address_space(1)))
#define LAS __attribute__((address_space(3)))
typedef unsigned short bf16;
typedef unsigned v4u __attribute__((ext_vector_type(4)));
typedef float f32x4 __attribute__((ext_vector_type(4)));
typedef short bf16x8 __attribute__((ext_vector_type(8)));
typedef GAS unsigned gu32;
typedef GAS unsigned long long gu64;
#define RLX_AGENT __ATOMIC_RELAXED, __HIP_MEMORY_SCOPE_AGENT
#define LDS_WAIT() asm volatile("s_waitcnt lgkmcnt(0)" ::: "memory")
#define VM_WAIT() asm volatile("s_waitcnt vmcnt(0)" ::: "memory")
__device__ __forceinline__ unsigned long long rt() { return __builtin_amdgcn_s_memrealtime(); }
__device__ __forceinline__ unsigned f2bf(float f) { unsigned u = __builtin_bit_cast(unsigned, f); return (u + 0x7fffu + ((u >> 16) & 1u)) >> 16; }
__device__ __forceinline__ unsigned pk2(float lo, float hi) { return f2bf(lo) | (f2bf(hi) << 16); }

#define XB_TMO      128
#define XB_XCNT(j)  (256  + 64 * (j))
#define XB_XSUB(j)  (1280 + 64 * (j))
#define XB_XGEN(j)  (2304 + 64 * (j))
#define XB_TOP      3328
#define XB_TOPGEN   3392
#define XCD_BAR_WORDS 3456
#define XB_SPIN_CAP (1u << 18)

__device__ __forceinline__ unsigned xb_ld(unsigned* p)              { return __hip_atomic_load(p, __ATOMIC_RELAXED, __HIP_MEMORY_SCOPE_AGENT); }
__device__ __forceinline__ unsigned xb_add(unsigned* p, unsigned v) { return __hip_atomic_fetch_add(p, v, __ATOMIC_RELAXED, __HIP_MEMORY_SCOPE_AGENT); }
__device__ __forceinline__ unsigned xb_xcc_id() { return (unsigned)__builtin_amdgcn_s_getreg((3 << 11) | 20) & 0xFu; }
#define XB_SPIN(cond, bar) do { unsigned _sp = 0; while (cond) { __builtin_amdgcn_s_sleep(1); \
    if ((++_sp & 255u) == 0u) { if (xb_ld(&(bar)[XB_TMO])) break; if (_sp > XB_SPIN_CAP) { atomicAdd(&(bar)[XB_TMO], 1u); break; } } } } while (0)

struct XcdBarrier {
    unsigned* bar; unsigned x;
    volatile LAS unsigned* st;
};

__device__ __forceinline__ XcdBarrier xcd_barrier_post(unsigned* bar, volatile LAS unsigned* st) {
    XcdBarrier b; b.bar = bar; b.x = xb_xcc_id(); b.st = st;
    if (threadIdx.x == 0) (void)xb_add(&bar[XB_XCNT(b.x)], 1u);
    return b;
}
__device__ __forceinline__ void xcd_barrier_complete(unsigned* bar, unsigned x, unsigned& nloc, unsigned& nx) {
    const unsigned G = gridDim.x * gridDim.y * gridDim.z;
    unsigned sum, cnt, mine, sp = 0u;
    for (;;) {
        sum = 0u; cnt = 0u; mine = 0u;
#pragma unroll
        for (unsigned j = 0; j < 16; ++j) { const unsigned c = xb_ld(&bar[XB_XCNT(j)]); sum += c; cnt += (c > 0u) ? 1u : 0u; mine = (j == x) ? c : mine; }
        if (sum == G) break;
        __builtin_amdgcn_s_sleep(1);
        if ((++sp & 255u) == 0u) { if (xb_ld(&bar[XB_TMO])) break; if (sp > XB_SPIN_CAP) { atomicAdd(&bar[XB_TMO], 1u); break; } }
    }
    nloc = mine > 0u ? mine : 1u; nx = cnt > 0u ? cnt : 1u;
}

__device__ __forceinline__ void xcd_barrier(const XcdBarrier& b) {
    asm volatile("s_waitcnt vmcnt(0)" ::: "memory");
    __syncthreads();
    if (threadIdx.x == 0) {
        unsigned* bar = b.bar;
        __builtin_amdgcn_s_waitcnt(0);
        unsigned nloc = b.st[0], nx = b.st[1];
        if (nloc == 0u) { xcd_barrier_complete(bar, b.x, nloc, nx); b.st[0] = nloc; b.st[1] = nx; }
        const unsigned old = xb_add(&bar[XB_XSUB(b.x)], 1u);
        const unsigned gen = old / nloc;
        if (old + 1u == (gen + 1u) * nloc) {
            __builtin_amdgcn_fence(__ATOMIC_RELEASE, "agent");
            asm volatile("s_waitcnt vmcnt(0)" ::: "memory");
            const unsigned og = xb_add(&bar[XB_TOP], 1u);
            const unsigned tg = og / nx;
            if (og + 1u == (tg + 1u) * nx) xb_add(&bar[XB_TOPGEN], 1u);
            else XB_SPIN(xb_ld(&bar[XB_TOPGEN]) == tg, bar);
            __builtin_amdgcn_fence(__ATOMIC_ACQUIRE, "agent");
            xb_add(&bar[XB_XGEN(b.x)], 1u);
            asm volatile("s_waitcnt vmcnt(0)" ::: "memory");
        } else {
            XB_SPIN(xb_ld(&bar[XB_XGEN(b.x)]) == gen, bar);
            __builtin_amdgcn_fence(__ATOMIC_ACQUIRE, "agent");
            asm volatile("s_waitcnt vmcnt(0)" ::: "memory");
        }
    }
    __syncthreads();
}

constexpr int NWAVES = 8;
constexpr int D = 1024, NB = 16, SEQ = 2048, T = NB * SEQ, CTXL = 256, TC = NB * CTXL;
constexpr int QW = 512, KVW = 128, HYW = 512, INW = 4352, NE = 32, DFF = 1024;
constexpr float LN_EPS = 1e-5f;
constexpr float DN_ALPHA = 1.189207115002721f;
constexpr float LOG2E = 1.4426950408889634f;
constexpr float C2Q = 0.125f * LOG2E;
constexpr int NPH = 10;
#ifndef MK_N_LAUNCHES
#define MK_N_LAUNCHES 1
#endif
constexpr int N_LAUNCHES = MK_N_LAUNCHES;

constexpr size_t MiB = 1u << 20;
constexpr size_t WS_CTL = 0, CTL_ZERO_BYTES = 128 * 1024;
constexpr size_t WS_MODP = 1 * MiB;
constexpr size_t WS_MODF = 8 * MiB;
constexpr size_t WS_ROPE = 9 * MiB;
constexpr size_t WS_ASG = 10 * MiB;
constexpr size_t WS_GW = 10 * MiB + 512 * 1024;
constexpr size_t WS_TOK = 11 * MiB;
constexpr size_t WS_G = 16 * MiB;
constexpr size_t WS_WB = 24 * MiB;
constexpr size_t WS_WO = 26 * MiB;
constexpr size_t WS_WIN = 28 * MiB;
constexpr size_t WS_W1 = 40 * MiB;
constexpr size_t WS_W2 = 168 * MiB;
constexpr size_t WS_V1 = 232 * MiB;
constexpr size_t WS_HM = 360 * MiB;
constexpr size_t WS_HX = 424 * MiB;
constexpr size_t WS_Q = 496 * MiB;
constexpr size_t WS_K = 528 * MiB;
constexpr size_t WS_VT = 536 * MiB;
constexpr size_t WS_KC = 544 * MiB;
constexpr size_t WS_VTC = 545 * MiB;
constexpr size_t WS_UT = 546 * MiB;
constexpr size_t WS_GATE = 642 * MiB;
constexpr size_t WS_ATT = 770 * MiB;
constexpr size_t WS_HYT = 898 * MiB;
constexpr size_t WS_MM = 834 * MiB;
constexpr size_t WS_ACT = 424 * MiB;
constexpr size_t WS_YB = 696 * MiB;
constexpr size_t WS_END = 1024 * MiB;
static_assert(WS_ACT + (size_t)139264 * 2048 <= WS_YB && WS_YB + (size_t)139264 * 2048 <= WS_END && WS_MM + (size_t)T * 2048 <= WS_END, "d_ws map");
constexpr int CW_TMO = 0, CW_CODE = 1, CW_BAR = 4096, CW_CNT = 16384, CW_MOD = 16384 + 64;
static_assert((CW_MOD + 1) * 4 <= (int)CTL_ZERO_BYTES && (CW_BAR + 3456) <= CW_CNT, "control words inside the per-call memset");

constexpr int RING_BYTES = 131072;
constexpr int LDSCTL_OFF = 151552;
constexpr int MISC_OFF = LDSCTL_OFF + 320;
constexpr int TP_OFF = LDSCTL_OFF + 1024;
constexpr int LDS_BYTES = 155648;

typedef float f32x16 __attribute__((ext_vector_type(16)));
typedef float f32x2 __attribute__((ext_vector_type(2)));
typedef unsigned u32x2 __attribute__((ext_vector_type(2)));

struct Frame {
    unsigned long long pt0, ptacc;
    LAS unsigned char* lds;
    volatile LAS unsigned* MISC;
    gu32* ctl;
    int tid, lane, wave, vcu, G;
    const GAS float *x, *c, *ctx, *c_ctx, *w_mod, *b_mod, *w_in, *sink, *cw, *cb, *fw1, *fb1, *fw2, *fb2, *fw3, *skip, *w_ba, *w_bh, *w_out, *ln1g, *ln1b, *rw, *rb, *ew1, *eb1, *ew2, *eb2, *ln2g, *ln2b;
    GAS float* out;
    GAS float *modP, *modF, *rope, *gw; GAS bf16* V1;
    GAS int *asg, *tok;
    GAS bf16 *G_, *WB, *WO, *WIN, *W1, *W2, *HM, *HX, *Q, *K, *VT, *KC, *VTC, *UT, *GATE, *ATT, *MM, *ACT, *YB, *HYT;
};

template <int CTRL> __device__ __forceinline__ float dpp_f(float v) { return __builtin_bit_cast(float, __builtin_amdgcn_update_dpp(0, __builtin_bit_cast(int, v), CTRL, 0xF, 0xF, true)); }
__device__ __forceinline__ float wave_sum(float v) {
    v += dpp_f<0xB1>(v); v += dpp_f<0x4E>(v); v += dpp_f<0x141>(v); v += dpp_f<0x140>(v);
    { const unsigned u = __builtin_bit_cast(unsigned, v); auto r = __builtin_amdgcn_permlane16_swap(u, u, false, false); v = __builtin_bit_cast(float, (unsigned)r[0]) + __builtin_bit_cast(float, (unsigned)r[1]); }
    { const unsigned u = __builtin_bit_cast(unsigned, v); auto r = __builtin_amdgcn_permlane32_swap(u, u, false, false); v = __builtin_bit_cast(float, (unsigned)r[0]) + __builtin_bit_cast(float, (unsigned)r[1]); }
    return v;
}
__device__ __forceinline__ float wave_max(float v) {
    v = fmaxf(v, dpp_f<0xB1>(v)); v = fmaxf(v, dpp_f<0x4E>(v)); v = fmaxf(v, dpp_f<0x141>(v)); v = fmaxf(v, dpp_f<0x140>(v));
    { const unsigned u = __builtin_bit_cast(unsigned, v); auto r = __builtin_amdgcn_permlane16_swap(u, u, false, false); v = fmaxf(__builtin_bit_cast(float, (unsigned)r[0]), __builtin_bit_cast(float, (unsigned)r[1])); }
    { const unsigned u = __builtin_bit_cast(unsigned, v); auto r = __builtin_amdgcn_permlane32_swap(u, u, false, false); v = fmaxf(__builtin_bit_cast(float, (unsigned)r[0]), __builtin_bit_cast(float, (unsigned)r[1])); }
    return v;
}
__device__ __forceinline__ float bf2f(unsigned short h) { return __builtin_bit_cast(float, (unsigned)h << 16); }
__device__ __forceinline__ float bflo(unsigned w) { return __builtin_bit_cast(float, w << 16); }
__device__ __forceinline__ float bfhi(unsigned w) { return __builtin_bit_cast(float, w & 0xffff0000u); }
__device__ __forceinline__ float sigmoidf_(float x) { return __builtin_amdgcn_rcpf(1.f + __builtin_amdgcn_exp2f(-LOG2E * x)); }
__device__ __forceinline__ unsigned pk4_fp8(float a, float b, float c, float d) { int w = 0; w = __builtin_amdgcn_cvt_pk_fp8_f32(a, b, w, false); w = __builtin_amdgcn_cvt_pk_fp8_f32(c, d, w, true); return (unsigned)w; }

__device__ __forceinline__ void p0_mod_block(Frame& F, int cb) {
    const int lane = F.lane, w = F.wave;
    LAS float* scr = (LAS float*)(F.lds + w * 16384);
    LAS float* part = (LAS float*)(F.lds + 8704);
    float xs[17][2];
#pragma unroll
    for (int r = 0; r < 17; ++r) { const GAS float* src = r < 16 ? F.c + r * D : F.c_ctx; xs[r][0] = src[128 * w + lane]; xs[r][1] = src[128 * w + 64 + lane]; }
#pragma unroll
    for (int r = 0; r < 17; ++r) { scr[r * 128 + lane] = xs[r][0] / (1.f + __expf(-xs[r][0])); scr[r * 128 + 64 + lane] = xs[r][1] / (1.f + __expf(-xs[r][1])); }
    LDS_WAIT(); asm volatile("" ::: "memory");
    float acc[17];
#pragma unroll
    for (int r = 0; r < 17; ++r) acc[r] = 0.f;
    const GAS float* wp = F.w_mod + (size_t)(128 * w) * 6144 + 64 * cb + lane;
#pragma unroll 1
    for (int k0 = 0; k0 < 128; k0 += 64) { float wv[64];
#pragma unroll
        for (int k = 0; k < 64; ++k) wv[k] = wp[(size_t)(k0 + k) * 6144];
#pragma unroll
        for (int k = 0; k < 64; ++k) {
#pragma unroll
            for (int r = 0; r < 17; ++r) acc[r] += scr[r * 128 + k0 + k] * wv[k]; } }
#pragma unroll
    for (int r = 0; r < 17; ++r) part[w * 4096 + r * 64 + lane] = acc[r];
    __syncthreads();
    for (int i = F.tid; i < 17 * 64; i += NWAVES * 64) { const int r = i >> 6, c = i & 63; float sum = F.b_mod[64 * cb + c];
#pragma unroll
        for (int ww = 0; ww < 8; ++ww) sum += part[ww * 4096 + r * 64 + c];
        F.modF[r * 6144 + 64 * cb + c] = sum; }
    asm volatile("s_waitcnt vmcnt(0)" ::: "memory"); __syncthreads();
    if (F.tid == 0) { __builtin_amdgcn_fence(__ATOMIC_RELEASE, "agent"); asm volatile("s_waitcnt vmcnt(0)" ::: "memory"); __hip_atomic_fetch_add(F.ctl + CW_MOD, 1u, RLX_AGENT); }
    __syncthreads();
}
__device__ __forceinline__ void p0_filt_item(Frame& F, LAS float* scr, int g, int cb) {
    int lane = F.lane; asm volatile("" : "+v"(lane));
    LAS float* zf = scr; LAS float* h1 = scr + 8 * 36; LAS float* h2 = h1 + 8 * 64;
#pragma unroll
    for (int p = 0; p < 8; ++p) { const int j = 8 * g + p; const float om = (6.283185307179586f * (float)j) / 2048.f;
        if (lane < 16) { const float fk = 1e-4f + (float)lane * ((15.f - 1e-4f) / 15.f); zf[p * 36 + 1 + lane] = cosf(fk * om); }
        else if (lane < 32) { const float fk = 1e-4f + (float)(lane - 16) * ((15.f - 1e-4f) / 15.f); zf[p * 36 + 17 + (lane - 16)] = -sinf(fk * om); }
        else if (lane == 32) zf[p * 36] = (float)j / 2047.f; }
    LDS_WAIT(); asm volatile("" ::: "memory");
    {
        float w1c[33], w2c[64];
#pragma unroll
        for (int i = 0; i < 33; ++i) w1c[i] = F.fw1[i * 64 + lane];
#pragma unroll
        for (int i = 0; i < 64; ++i) w2c[i] = F.fw2[i * 64 + lane];
        const float bb1 = F.fb1[lane], bb2 = F.fb2[lane];
#pragma unroll
        for (int p = 0; p < 8; ++p) { float a = bb1;
#pragma unroll
            for (int i = 0; i < 33; ++i) a += zf[p * 36 + i] * w1c[i];
            h1[p * 64 + lane] = sinf(a); }
        LDS_WAIT(); asm volatile("" ::: "memory");
#pragma unroll
        for (int p = 0; p < 8; ++p) { float a = bb2;
#pragma unroll
            for (int i = 0; i < 64; ++i) a += h1[p * 64 + i] * w2c[i];
            h2[p * 64 + lane] = sinf(a); }
        LDS_WAIT(); asm volatile("" ::: "memory");
    }
    float o[8][4];
#pragma unroll
    for (int p = 0; p < 8; ++p)
#pragma unroll
        for (int q = 0; q < 4; ++q) o[p][q] = 0.f;
    const GAS float* w3 = F.fw3 + 256 * cb + lane;
#pragma unroll 1
    for (int i0 = 0; i0 < 64; i0 += 16) { float w[16][4];
#pragma unroll
        for (int i = 0; i < 16; ++i)
#pragma unroll
            for (int q = 0; q < 4; ++q) w[i][q] = w3[(size_t)(i0 + i) * 2048 + 64 * q];
#pragma unroll
        for (int i = 0; i < 16; ++i)
#pragma unroll
            for (int p = 0; p < 8; ++p) { const float hv = h2[p * 64 + i0 + i];
#pragma unroll
                for (int q = 0; q < 4; ++q) o[p][q] += hv * w[i][q]; } }
#pragma unroll
    for (int q = 0; q < 4; ++q) { const int col = 256 * cb + 64 * q + lane, oo = col >> 10, dir = (col >> 9) & 1, ch = col & 511;
        const float delta = 15.350567286626973f - (float)ch * (12.280453829301578f / 511.f);
        GAS bf16* gp = F.G_ + (size_t)(oo * 512 + ch) * 4096;
#pragma unroll
        for (int p = 0; p < 8; ++p) { const int j = 8 * g + p; const float val = o[p][q] * __expf(-((float)j / 2047.f) * delta);
            const int idx = dir ? 2048 + j : 2048 - j; if (!(dir && j == 0)) gp[idx] = (bf16)f2bf(val); }
        if (g == 0 && dir == 0) gp[0] = 0; }
    LDS_WAIT(); asm volatile("" ::: "memory");
}
constexpr int IT_IN = 16 * 136, IT_B = 8 * 32, IT_O = 16 * 32, IT_W1 = 32 * 16 * 64, IT_W2 = 32 * 16 * 32, NTR = IT_IN + 2 * IT_B + IT_O + IT_W1 + IT_W2;
struct TrItem { const GAS float* W; GAS bf16* WT; int N, Kp, drow, k0, n0, f8; };
__device__ __forceinline__ TrItem tr_decode(Frame& F, int r) {
    TrItem t; t.f8 = 0;
    if (r < IT_IN) { t.W = F.w_in; t.N = INW; t.WT = F.WIN; t.Kp = 1024; t.k0 = 64 * (r / 136); t.n0 = 32 * (r % 136); t.drow = t.n0; }
    else if ((r -= IT_IN) < IT_B) { t.W = F.w_ba; t.N = 1024; t.WT = F.WB; t.Kp = 512; t.k0 = 64 * (r / 32); t.n0 = 32 * (r % 32); t.drow = t.n0; }
    else if ((r -= IT_B) < IT_B) { t.W = F.w_bh; t.N = 1024; t.WT = F.WB + 1024 * 512; t.Kp = 512; t.k0 = 64 * (r / 32); t.n0 = 32 * (r % 32); t.drow = t.n0; }
    else if ((r -= IT_B) < IT_O) { t.W = F.w_out; t.N = 1024; t.WT = F.WO; t.Kp = 1024; t.k0 = 64 * (r / 32); t.n0 = 32 * (r % 32); t.drow = t.n0; }
    else if ((r -= IT_O) < IT_W1) { const int e = r >> 10, q = r & 1023; t.W = F.ew1 + (size_t)e * 1024 * 2048; t.N = 2048; t.WT = (GAS bf16*)((GAS unsigned char*)F.W1 + (size_t)e * 2048 * 1024); t.Kp = 1024; t.f8 = 1; t.k0 = 64 * (q >> 6); t.n0 = 32 * (q & 63);
        t.drow = t.n0 < 1024 ? (t.n0 >> 7) * 256 + (t.n0 & 127) : ((t.n0 - 1024) >> 7) * 256 + 128 + ((t.n0 - 1024) & 127); }
    else { r -= IT_W1; const int e = r >> 9, q = r & 511; t.W = F.ew2 + (size_t)e * 1024 * 1024; t.N = 1024; t.WT = (GAS bf16*)((GAS unsigned char*)F.W2 + (size_t)e * 1024 * 1024); t.Kp = 1024; t.f8 = 1; t.k0 = 64 * (q >> 5); t.n0 = 32 * (q & 31); t.drow = t.n0; }
    return t;
}
__device__ __forceinline__ void tr_load(const TrItem& t, int lane, f32x4 (&buf)[8]) {
    const GAS float* wp = t.W + (size_t)(t.k0 + (lane >> 3)) * t.N + t.n0 + 4 * (lane & 7);
#pragma unroll
    for (int i = 0; i < 8; ++i) buf[i] = __builtin_nontemporal_load((const GAS f32x4*)(wp + (size_t)(8 * i) * t.N));
}
__device__ __forceinline__ void tr_store(const TrItem& t, const f32x4 (&buf)[8], LAS float* scr, int lane) {
    const int kk = lane >> 3, c4 = lane & 7;
#pragma unroll
    for (int i = 0; i < 8; ++i) { LAS float* d = scr + (8 * i + kk) * 33 + 4 * c4; d[0] = buf[i][0]; d[1] = buf[i][1]; d[2] = buf[i][2]; d[3] = buf[i][3]; }
    LDS_WAIT(); asm volatile("" ::: "memory");
    const int c = lane & 7;
#pragma unroll
    for (int j = 0; j < 4; ++j) { const int n = (lane >> 3) + 8 * j; const LAS float* sp = scr + (8 * c) * 33 + n;
        if (t.f8) { u32x2 o; o.x = pk4_fp8(sp[0 * 33] * 256.f, sp[1 * 33] * 256.f, sp[2 * 33] * 256.f, sp[3 * 33] * 256.f); o.y = pk4_fp8(sp[4 * 33] * 256.f, sp[5 * 33] * 256.f, sp[6 * 33] * 256.f, sp[7 * 33] * 256.f);
            *(GAS u32x2*)((GAS unsigned char*)t.WT + (size_t)(t.drow + n) * t.Kp + t.k0 + 8 * c) = o; }
        else { v4u o; o.x = pk2(sp[0 * 33], sp[1 * 33]); o.y = pk2(sp[2 * 33], sp[3 * 33]); o.z = pk2(sp[4 * 33], sp[5 * 33]); o.w = pk2(sp[6 * 33], sp[7 * 33]);
            *(GAS v4u*)(t.WT + (size_t)(t.drow + n) * t.Kp + t.k0 + 8 * c) = o; } }
    LDS_WAIT(); asm volatile("" ::: "memory");
}
__device__ __forceinline__ void p1_rows(Frame& F);
__device__ __forceinline__ void p0_prologue(Frame& F) {
    LAS float* scr = (LAS float*)(F.lds + F.wave * 16384);
    const int gw = F.vcu * NWAVES + F.wave, NGW = F.G * NWAVES, lane = F.lane;
    constexpr int IT_FILT = 2048, IT_ROPE = 1, NSPEC = IT_FILT + IT_ROPE;
    if ((int)blockIdx.x < 96) p0_mod_block(F, (int)blockIdx.x);
    const bool spec_first = (F.wave & 1) != 0;
#define P0_SPECIAL() do { for (int it = gw; it < NSPEC; it += NGW) { int r = it; \
        if (r < IT_FILT) { p0_filt_item(F, scr, r >> 3, r & 7); continue; } \
        _Pragma("unroll 4") for (int i = 0; i < 16; ++i) { const int idx = lane * 16 + i, pos = idx >> 4, f = idx & 15; const float inv = exp2f(-(float)f * (13.287712379549449f / 16.f)); const float ang = (float)pos * inv; \
            F.rope[idx] = cosf(ang); F.rope[1024 + idx] = sinf(ang); } } } while (0)
    if (spec_first) P0_SPECIAL();
    if (gw < NTR) {
        int it = gw;
        TrItem c0 = tr_decode(F, it); f32x4 b0[8]; tr_load(c0, lane, b0);
        int i1 = it + NGW; bool h1 = i1 < NTR; TrItem c1 = tr_decode(F, h1 ? i1 : it); f32x4 b1[8]; tr_load(c1, lane, b1);
        for (;;) {
            const int i2 = i1 + NGW; const bool h2 = h1 && i2 < NTR;
            TrItem c2 = tr_decode(F, h2 ? i2 : it); f32x4 b2[8]; tr_load(c2, lane, b2);
            tr_store(c0, b0, scr, lane);
            if (!h1) break;
            c0 = c1; c1 = c2; it = i1; i1 = i2; h1 = h2;
#pragma unroll
            for (int i = 0; i < 8; ++i) { b0[i] = b1[i]; b1[i] = b2[i]; }
        }
    }
    if (!spec_first) P0_SPECIAL();
#undef P0_SPECIAL
    __syncthreads();
    if (F.wave == 0) { unsigned sp = 0;
        while ((unsigned)__builtin_amdgcn_readfirstlane(__hip_atomic_load(F.ctl + CW_MOD, RLX_AGENT)) < 96u) { __builtin_amdgcn_s_sleep(2); if (++sp > (1u << 22)) { if (F.lane == 0) __hip_atomic_store(F.ctl + CW_TMO, 1u, RLX_AGENT); break; } }
        __builtin_amdgcn_fence(__ATOMIC_ACQUIRE, "agent"); asm volatile("s_waitcnt vmcnt(0)" ::: "memory"); }
    __syncthreads();
    p1_rows(F);
}

template <int NR>
__device__ __forceinline__ void ln_mod_rows(const GAS float* const (&src)[NR], GAS bf16* const (&dst)[NR], const LAS float* const (&tS)[NR], const LAS float* const (&tB)[NR], int lane) {
    f32x4 v[NR][4]; float s[NR], s2[NR];
#pragma unroll
    for (int r = 0; r < NR; ++r) { const GAS f32x4* xr = (const GAS f32x4*)src[r] + lane;
#pragma unroll
        for (int j = 0; j < 4; ++j) v[r][j] = __builtin_nontemporal_load(xr + 64 * j); }
#pragma unroll
    for (int r = 0; r < NR; ++r) { s[r] = 0.f;
#pragma unroll
        for (int j = 0; j < 4; ++j) s[r] += (v[r][j].x + v[r][j].y) + (v[r][j].z + v[r][j].w); }
#pragma unroll
    for (int r = 0; r < NR; ++r) s[r] = wave_sum(s[r]) * (1.f / D);
#pragma unroll
    for (int r = 0; r < NR; ++r) { s2[r] = 0.f;
#pragma unroll
        for (int j = 0; j < 4; ++j) { v[r][j] = v[r][j] - s[r]; s2[r] += (v[r][j].x * v[r][j].x + v[r][j].y * v[r][j].y) + (v[r][j].z * v[r][j].z + v[r][j].w * v[r][j].w); } }
#pragma unroll
    for (int r = 0; r < NR; ++r) s2[r] = 1.f / sqrtf(wave_sum(s2[r]) * (1.f / D) + LN_EPS);
#pragma unroll
    for (int r = 0; r < NR; ++r)
#pragma unroll
        for (int j = 0; j < 4; ++j) { const int col = 4 * lane + 256 * j; const f32x4 sc = *(const LAS f32x4*)(tS[r] + col), sh = *(const LAS f32x4*)(tB[r] + col);
            const f32x4 o = v[r][j] * s2[r] * sc + sh; u32x2 w; w.x = pk2(o.x, o.y); w.y = pk2(o.z, o.w); *(GAS u32x2*)(dst[r] + col) = w; }
}
__device__ __forceinline__ void p1_rows(Frame& F) {
    LAS float* tA = (LAS float*)F.lds;
    for (int chunk = blockIdx.x; chunk < 256; chunk += F.G) {
        const int b = chunk >> 4;
        for (int i = F.tid; i < 4096; i += NWAVES * 64) { const int which = i >> 10, col = i & 1023, r = which < 2 ? b : 16, n = ((which & 1) ? 0 : 1024) + col;
            const float s = F.modF[r * 6144 + n]; tA[i] = (which & 1) ? s : 1.f + s; }
        __syncthreads();
#pragma unroll 1
        for (int g = 0; g < 6; ++g) {
            const GAS float* src[3]; GAS bf16* dst[3]; const LAS float* tS[3]; const LAS float* tB[3];
#pragma unroll
            for (int r = 0; r < 3; ++r) { const int rr = 3 * g + r;
                if (rr < 16) { const int row = chunk * 128 + F.wave * 16 + rr; src[r] = F.x + (size_t)row * D; dst[r] = F.HX + (size_t)row * D; tS[r] = tA; tB[r] = tA + 1024; }
                else { const int cr = chunk * 16 + F.wave * 2 + (rr - 16); src[r] = F.ctx + (size_t)cr * D; dst[r] = F.HX + (size_t)(T + cr) * D; tS[r] = tA + 2048; tB[r] = tA + 3072; } }
            ln_mod_rows<3>(src, dst, tS, tB, F.lane);
        }
        __syncthreads();
    }
}

using pg8::Unit; using pg8::f32x4; using pg8::cvt_pk_bf16;
struct SchedInProj {
    pg8::StaticOrder so; int G, c;
    __device__ __forceinline__ bool next(int i, Unit& u) const { const long L = (long)i * G + c; if (L < 2176) return so.next(i, u); if (L < 2192) { u.pm = 128 + (int)(L - 2176); u.pn = 2; return true; } return false; }
    __device__ __forceinline__ void a_ready(const Unit&) const {}
};
struct SchedPair {
    pg8::StaticOrder so;
    __device__ __forceinline__ bool next(int i, Unit& u) const { if (!so.next(i >> 1, u)) return false; if (i & 1) { u.pm += 128; u.pn += 4; } return true; }
    __device__ __forceinline__ void a_ready(const Unit&) const {}
};
struct SchedPlain { pg8::StaticOrder so;
    __device__ __forceinline__ bool next(int i, Unit& u) const { return so.next(i, u); }
    __device__ __forceinline__ void a_ready(const Unit&) const {}
};
struct SchedMoe {
    const LAS int* tp; const GAS int* tok; int nNl, G, c;
    __device__ __forceinline__ bool next(int i, Unit& u) const {
        pg8::StaticOrder so; so.init(__builtin_amdgcn_readfirstlane(tp[32]), nNl, G, c); if (!so.next(i, u)) return false;
        int e = 0;
        for (int k = 1; k < 32; ++k) e += (u.pm >= tp[k]) ? 1 : 0;
        u.pm = __builtin_amdgcn_readfirstlane(u.pm); u.pn = __builtin_amdgcn_readfirstlane(u.pn + e * nNl); return true; }
    __device__ __forceinline__ int rowoff(const Unit& u, int r) const { const int e = u.pn / nNl; int pos = (u.pm - tp[e]) * 256 + r; pos = pos < tp[33 + e] ? pos : 0; return tok[e * 32768 + pos]; }
    __device__ __forceinline__ void a_ready(const Unit&) const {}
};

struct EpiInProj {
    static constexpr bool PERM = true; static constexpr float S8 = 1.f;
    GAS bf16 *Q, *K, *VT, *KC, *VTC, *UT, *GATE; const GAS float* rope;
    __device__ __forceinline__ void operator()(const f32x4 (&acc)[2][2][4][2], const Unit& u, int wr, int wc, int fr, int fq) const {
        const int pn = u.pn; const bool isctx = u.pm >= 128;
#pragma unroll
        for (int ai = 0; ai < 2; ++ai)
#pragma unroll
            for (int m = 0; m < 4; ++m) {
                const int row = u.pm * 256 + ai * 128 + wr * 64 + m * 16 + fr;
                if (pn >= 9) {
#pragma unroll
                    for (int bj = 0; bj < 2; ++bj) { const int col = (pn - 9) * 256 + bj * 128 + wc * 32 + 8 * fq; const f32x4 v0 = acc[ai][bj][m][0] * S8, v1 = acc[ai][bj][m][1] * S8; v4u w;
                        w.x = cvt_pk_bf16(sigmoidf_(v0[0]), sigmoidf_(v0[1])); w.y = cvt_pk_bf16(sigmoidf_(v0[2]), sigmoidf_(v0[3])); w.z = cvt_pk_bf16(sigmoidf_(v1[0]), sigmoidf_(v1[1])); w.w = cvt_pk_bf16(sigmoidf_(v1[2]), sigmoidf_(v1[3]));
                        *(GAS v4u*)(GATE + (size_t)row * 2048 + col) = w; }
                } else if (pn >= 3) {
#pragma unroll
                    for (int bj = 0; bj < 2; ++bj) { const int ch = (pn - 3) * 256 + bj * 128 + wc * 32 + 8 * fq; GAS bf16* up = UT + (size_t)ch * T + row;
#pragma unroll
                        for (int n = 0; n < 2; ++n)
#pragma unroll
                            for (int j = 0; j < 4; ++j) up[(size_t)(4 * n + j) * T] = (bf16)f2bf(acc[ai][bj][m][n][j] * S8); }
                } else {
                    const int t = row & 2047;
                    const int pos = (wc & 1) ? (t & 63) : (t >> 6); const int f0 = 8 * (fq & 1); const bool hihalf = (fq >> 1) != 0;
#pragma unroll
                    for (int bj = 0; bj < 2; ++bj) {
                        if (pn == 2 && bj == 1) {
                            const int kvh = wc >> 1, d0 = (wc & 1) * 32 + 8 * fq;
                            GAS bf16* vp = isctx ? VTC + ((size_t)(((row - T) >> 8) * 2 + kvh) * 64 + d0) * 256 + ((row - T) & 255)
                                             : VT + ((size_t)((row >> 11) * 2 + kvh) * 64 + d0) * 2048 + t;
                            const int pitch = isctx ? 256 : 2048;
#pragma unroll
                            for (int n = 0; n < 2; ++n)
#pragma unroll
                                for (int j = 0; j < 4; ++j) vp[(size_t)(4 * n + j) * pitch] = (bf16)f2bf(acc[ai][bj][m][n][j] * S8);
                        } else {
                            f32x4 r[2];
#pragma unroll
                            for (int n = 0; n < 2; ++n) { const f32x4 own = acc[ai][bj][m][n] * S8; f32x4 oth;
#pragma unroll
                                for (int j = 0; j < 4; ++j) oth[j] = __shfl_xor(own[j], 32);
                                const f32x4 cs = *(const GAS f32x4*)(rope + pos * 16 + f0 + 4 * n), sn = *(const GAS f32x4*)(rope + 1024 + pos * 16 + f0 + 4 * n);
                                r[n] = hihalf ? own * cs + oth * sn : own * cs - oth * sn;
                                if (isctx) r[n] = own; }
                            if (pn < 2) { r[0] = r[0] * C2Q; r[1] = r[1] * C2Q; }
                            v4u w; w.x = cvt_pk_bf16(r[0][0], r[0][1]); w.y = cvt_pk_bf16(r[0][2], r[0][3]); w.z = cvt_pk_bf16(r[1][0], r[1][1]); w.w = cvt_pk_bf16(r[1][2], r[1][3]);
                            GAS bf16* dst = pn < 2 ? Q + (size_t)row * QW + pn * 256 + bj * 128 + wc * 32 + 8 * fq
                                               : (isctx ? KC + (size_t)(row - T) * KVW + wc * 32 + 8 * fq : K + (size_t)row * KVW + wc * 32 + 8 * fq);
                            *(GAS v4u*)dst = w;
                        }
                    }
                }
            }
    }
};
struct EpiMerge {
    static constexpr bool PERM = true;
    const GAS bf16* GATE; GAS bf16* MM;
    __device__ __forceinline__ void operator()(const f32x4 (&acc)[2][2][4][2], const Unit& u, int wr, int wc, int fr, int fq) const {
        const int which = u.pn >> 2, pnl = u.pn & 3, pml = u.pm & 127;
#pragma unroll
        for (int ai = 0; ai < 2; ++ai) {
            v4u g[4][2], p[4][2];
#pragma unroll
            for (int m = 0; m < 4; ++m)
#pragma unroll
                for (int bj = 0; bj < 2; ++bj) { const int row = pml * 256 + ai * 128 + wr * 64 + m * 16 + fr, col = pnl * 256 + bj * 128 + wc * 32 + 8 * fq;
                    g[m][bj] = *(const GAS v4u*)(GATE + (size_t)row * 2048 + which * 1024 + col); p[m][bj] = (v4u){0u, 0u, 0u, 0u}; }
            if (which) {
#pragma unroll
                for (int m = 0; m < 4; ++m)
#pragma unroll
                    for (int bj = 0; bj < 2; ++bj) { const int row = pml * 256 + ai * 128 + wr * 64 + m * 16 + fr, col = pnl * 256 + bj * 128 + wc * 32 + 8 * fq; p[m][bj] = *(const GAS v4u*)(MM + (size_t)row * 1024 + col); } }
#pragma unroll
            for (int m = 0; m < 4; ++m)
#pragma unroll
                for (int bj = 0; bj < 2; ++bj) { const int row = pml * 256 + ai * 128 + wr * 64 + m * 16 + fr, col = pnl * 256 + bj * 128 + wc * 32 + 8 * fq;
                    const v4u gg = g[m][bj], pp = p[m][bj]; const f32x4 v0 = acc[ai][bj][m][0], v1 = acc[ai][bj][m][1];
                    const float o0 = bflo(gg.x) * v0[0] + bflo(pp.x), o1 = bfhi(gg.x) * v0[1] + bfhi(pp.x), o2 = bflo(gg.y) * v0[2] + bflo(pp.y), o3 = bfhi(gg.y) * v0[3] + bfhi(pp.y);
                    const float o4 = bflo(gg.z) * v1[0] + bflo(pp.z), o5 = bfhi(gg.z) * v1[1] + bfhi(pp.z), o6 = bflo(gg.w) * v1[2] + bflo(pp.w), o7 = bfhi(gg.w) * v1[3] + bfhi(pp.w);
                    v4u w; w.x = cvt_pk_bf16(o0, o1); w.y = cvt_pk_bf16(o2, o3); w.z = cvt_pk_bf16(o4, o5); w.w = cvt_pk_bf16(o6, o7);
                    *(GAS v4u*)(MM + (size_t)row * 1024 + col) = w; }
        }
    }
};
struct EpiV1 {
    static constexpr bool PERM = false;
    const GAS float* x; const GAS float* modF; GAS bf16* V1;
    __device__ __forceinline__ void operator()(const f32x4 (&acc)[2][2][4][2], const Unit& u, int wr, int wc, int fr, int fq) const {
        const int col0 = u.pn * 256 + wc * 32 + 4 * fq; const int b = u.pm >> 3;
        f32x4 g1[2][2];
#pragma unroll
        for (int bj = 0; bj < 2; ++bj)
#pragma unroll
            for (int n = 0; n < 2; ++n) g1[bj][n] = *(const GAS f32x4*)(modF + b * 6144 + 2048 + col0 + bj * 128 + n * 16);
#pragma unroll
        for (int ai = 0; ai < 2; ++ai) {
            f32x4 xv[4][2][2];
#pragma unroll
            for (int m = 0; m < 4; ++m) { const size_t off = (size_t)(u.pm * 256 + ai * 128 + wr * 64 + m * 16 + fr) * D + col0;
#pragma unroll
                for (int bj = 0; bj < 2; ++bj)
#pragma unroll
                    for (int n = 0; n < 2; ++n) xv[m][bj][n] = *(const GAS f32x4*)(x + off + bj * 128 + n * 16); }
#pragma unroll
            for (int m = 0; m < 4; ++m) { const size_t off = (size_t)(u.pm * 256 + ai * 128 + wr * 64 + m * 16 + fr) * D + col0;
#pragma unroll
                for (int bj = 0; bj < 2; ++bj)
#pragma unroll
                    for (int n = 0; n < 2; ++n) { const f32x4 r = xv[m][bj][n] * DN_ALPHA + g1[bj][n] * acc[ai][bj][m][n]; u32x2 w; w.x = cvt_pk_bf16(r[0], r[1]); w.y = cvt_pk_bf16(r[2], r[3]); *(GAS u32x2*)(V1 + off + bj * 128 + n * 16) = w; } }
        }
    }
};
struct EpiAct {
    static constexpr bool PERM = true;
    const GAS float* b1; GAS bf16* ACT;
    __device__ __forceinline__ void operator()(const f32x4 (&acc)[2][2][4][2], const Unit& u, int wr, int wc, int fr, int fq) const {
        const int e = u.pn >> 3, pnl = u.pn & 7, colo = pnl * 128 + wc * 32 + 8 * fq;
        f32x4 bg[2], bl[2];
#pragma unroll
        for (int n = 0; n < 2; ++n) { bg[n] = *(const GAS f32x4*)(b1 + e * 2048 + colo + 4 * n); bl[n] = *(const GAS f32x4*)(b1 + e * 2048 + 1024 + colo + 4 * n); }
#pragma unroll
        for (int ai = 0; ai < 2; ++ai)
#pragma unroll
            for (int m = 0; m < 4; ++m) { const int row = u.pm * 256 + ai * 128 + wr * 64 + m * 16 + fr; float o[8];
#pragma unroll
                for (int n = 0; n < 2; ++n)
#pragma unroll
                    for (int j = 0; j < 4; ++j) { float gl = acc[ai][0][m][n][j] * (1.f / 256.f) + bg[n][j], li = acc[ai][1][m][n][j] * (1.f / 256.f) + bl[n][j];
                        gl = fminf(gl, 7.f); li = fminf(fmaxf(li, -7.f), 7.f); o[4 * n + j] = gl * sigmoidf_(1.702f * gl) * (li + 1.f); }
                u32x2 w; w.x = pk4_fp8(o[0], o[1], o[2], o[3]); w.y = pk4_fp8(o[4], o[5], o[6], o[7]);
                *(GAS u32x2*)((GAS unsigned char*)ACT + (size_t)row * 1024 + colo) = w; }
    }
};
struct EpiYb {
    static constexpr bool PERM = true;
    const GAS float* b2; GAS bf16* YB;
    __device__ __forceinline__ void operator()(const f32x4 (&acc)[2][2][4][2], const Unit& u, int wr, int wc, int fr, int fq) const {
        const int e = u.pn >> 2, pnl = u.pn & 3;
#pragma unroll
        for (int bj = 0; bj < 2; ++bj) { const int col = pnl * 256 + bj * 128 + wc * 32 + 8 * fq;
            const f32x4 b0 = *(const GAS f32x4*)(b2 + e * 1024 + col), b1v = *(const GAS f32x4*)(b2 + e * 1024 + col + 4);
#pragma unroll
            for (int ai = 0; ai < 2; ++ai)
#pragma unroll
                for (int m = 0; m < 4; ++m) { const int row = u.pm * 256 + ai * 128 + wr * 64 + m * 16 + fr; const f32x4 v0 = acc[ai][bj][m][0] * (1.f / 256.f) + b0, v1 = acc[ai][bj][m][1] * (1.f / 256.f) + b1v;
                    u32x2 w; w.x = pk4_fp8(v0[0], v0[1], v0[2], v0[3]); w.y = pk4_fp8(v1[0], v1[1], v1[2], v1[3]);
                    *(GAS u32x2*)((GAS unsigned char*)YB + (size_t)row * 1024 + col) = w; } }
    }
};

#define HPT_B(k) do { if (PROBE_SPIN == (k)) F.pt0 = rt(); } while (0)
#define HPT_E(k) do { if (PROBE_SPIN == (k)) F.ptacc += rt() - F.pt0; } while (0)
__device__ __forceinline__ int crow(int r, int hi) { return (r & 3) + 8 * (r >> 2) + 4 * hi; }
__device__ __forceinline__ void attn_step(const bool MASK, const LAS unsigned char* Kl, const LAS unsigned char* Vl, const int pitchV, const int kvoff, const bf16x8 (&qf)[2][4],
                                          float (&mrun)[2], float (&lrun)[2], f32x16 (&o)[2][2], const int r32, const int hi, const int dq0) {
    bf16x8 kf[4], vf[2][2];
#pragma unroll
    for (int ks = 0; ks < 4; ++ks) kf[ks] = *(const LAS bf16x8*)(Kl + (kvoff + r32) * 144 + ks * 32 + hi * 16);
#pragma unroll
    for (int dt = 0; dt < 2; ++dt)
#pragma unroll
        for (int s2 = 0; s2 < 2; ++s2) vf[dt][s2] = *(const LAS bf16x8*)(Vl + (32 * dt + r32) * pitchV + (kvoff + 16 * s2) * 2 + hi * 16);
#pragma unroll
    for (int qt = 0; qt < 2; ++qt) {
        f32x16 s = {0.f, 0.f, 0.f, 0.f, 0.f, 0.f, 0.f, 0.f, 0.f, 0.f, 0.f, 0.f, 0.f, 0.f, 0.f, 0.f};
#pragma unroll
        for (int ks = 0; ks < 4; ++ks) s = __builtin_amdgcn_mfma_f32_32x32x16_bf16(kf[ks], qf[qt][ks], s, 0, 0, 0);
        if (MASK) {
#pragma unroll
            for (int r = 0; r < 16; ++r) { const int dd = dq0 - 32 * qt + crow(r, hi); if (dd > 128 || dd < -128) s[r] = -INFINITY; }
        }
        float mx = fmaxf(fmaxf(s[0], s[1]), s[2]);
#pragma unroll
        for (int r = 3; r < 15; r += 2) mx = fmaxf(fmaxf(mx, s[r]), s[r + 1]);
        mx = fmaxf(mx, s[15]);
        { const unsigned u = __builtin_bit_cast(unsigned, mx); auto rr = __builtin_amdgcn_permlane32_swap(u, u, false, false); mx = fmaxf(__builtin_bit_cast(float, (unsigned)rr[0]), __builtin_bit_cast(float, (unsigned)rr[1])); }
        if (__any(mx > mrun[qt])) {
            const float mn = fmaxf(mrun[qt], mx), f = __builtin_amdgcn_exp2f(mrun[qt] - mn); mrun[qt] = mn; lrun[qt] *= f;
#pragma unroll
            for (int dt = 0; dt < 2; ++dt) o[qt][dt] = o[qt][dt] * f;
        }
        const float mn = mrun[qt];
        float ps = 0.f;
#pragma unroll
        for (int r = 0; r < 16; ++r) { const float p = __builtin_amdgcn_exp2f(s[r] - mn); s[r] = p; ps += p; }
        lrun[qt] += ps;
        bf16x8 pb[2];
#pragma unroll
        for (int s2 = 0; s2 < 2; ++s2) { v4u w; w.x = cvt_pk_bf16(s[8 * s2 + 0], s[8 * s2 + 1]); w.y = cvt_pk_bf16(s[8 * s2 + 2], s[8 * s2 + 3]); w.z = cvt_pk_bf16(s[8 * s2 + 4], s[8 * s2 + 5]); w.w = cvt_pk_bf16(s[8 * s2 + 6], s[8 * s2 + 7]);
            pb[s2] = __builtin_bit_cast(bf16x8, w); }
#pragma unroll
        for (int dt = 0; dt < 2; ++dt)
#pragma unroll
            for (int s2 = 0; s2 < 2; ++s2) o[qt][dt] = __builtin_amdgcn_mfma_f32_32x32x16_bf16(vf[dt][s2], pb[s2], o[qt][dt], 0, 0, 0);
    }
}
__device__ __forceinline__ void attn_unit(Frame& F, int b, int kvh, int qb) {
    LAS unsigned char* lds = F.lds;
    const int tid = F.tid, lane = F.lane, w = F.wave, r32 = lane & 31, hi = lane >> 5;
    const int h = kvh * 4 + (w >> 1), s0 = qb * 128, q0 = s0 + 64 * (w & 1);
    bf16x8 qf[2][4];
#pragma unroll
    for (int qt = 0; qt < 2; ++qt)
#pragma unroll
        for (int ks = 0; ks < 4; ++ks) qf[qt][ks] = *(const GAS bf16x8*)(F.Q + (size_t)(b * SEQ + q0 + 32 * qt + r32) * QW + h * 64 + 16 * ks + 8 * hi);
    float mrun[2] = {-INFINITY, -INFINITY}, lrun[2] = {0.f, 0.f};
    f32x16 o[2][2];
#pragma unroll
    for (int qt = 0; qt < 2; ++qt)
#pragma unroll
        for (int dt = 0; dt < 2; ++dt)
#pragma unroll
            for (int r = 0; r < 16; ++r) o[qt][dt][r] = 0.f;
    {
        HPT_B(30);
        LAS unsigned char* Kl = lds; LAS unsigned char* Vl = lds + 36864;
        v4u rk[4], rv[4];
#pragma unroll
        for (int i = 0; i < 4; ++i) { const int idx = tid + 512 * i; rk[i] = *(const GAS v4u*)(F.KC + (size_t)(b * CTXL + (idx >> 3)) * KVW + kvh * 64 + (idx & 7) * 8);
            rv[i] = *(const GAS v4u*)(F.VTC + (size_t)((b * 2 + kvh) * 64 + (idx >> 5)) * CTXL + (idx & 31) * 8); }
#pragma unroll
        for (int i = 0; i < 4; ++i) { const int idx = tid + 512 * i; *(LAS v4u*)(Kl + (idx >> 3) * 144 + (idx & 7) * 16) = rk[i]; { const int ch = idx & 31; LAS unsigned char* vd = Vl + (idx >> 5) * 528 + (ch >> 1) * 32 + (ch & 1) * 8; *(LAS u32x2*)vd = (u32x2){rv[i].x, rv[i].y}; *(LAS u32x2*)(vd + 16) = (u32x2){rv[i].z, rv[i].w}; } }
        __syncthreads(); HPT_E(30); HPT_B(31);
        for (int st = 0; st < 8; ++st) attn_step(false, Kl, Vl, 528, 32 * st, qf, mrun, lrun, o, r32, hi, 0);
        __syncthreads(); HPT_E(31);
    }
    {
        LAS unsigned char* Kl = lds; LAS unsigned char* Vl = lds + 55296; const int kbase = s0 - 128;
        HPT_B(32);
        v4u rk[6], rv[6];
#pragma unroll
        for (int i = 0; i < 6; ++i) { const int idx = tid + 512 * i; { const int row = idx >> 3, ch = idx & 7; int kp = kbase + row; kp = kp < 0 ? 0 : (kp >= SEQ ? SEQ - 1 : kp); rk[i] = *(const GAS v4u*)(F.K + (size_t)(b * SEQ + kp) * KVW + kvh * 64 + ch * 8); }
            { const int row = idx / 48, ch = idx % 48; int kp = kbase + 8 * ch; kp = kp < 0 ? 0 : (kp >= SEQ ? SEQ - 8 : kp); rv[i] = *(const GAS v4u*)(F.VT + (size_t)((b * 2 + kvh) * 64 + row) * SEQ + kp); } }
#pragma unroll
        for (int i = 0; i < 6; ++i) { const int idx = tid + 512 * i; *(LAS v4u*)(Kl + (idx >> 3) * 144 + (idx & 7) * 16) = rk[i]; { const int ch = idx % 48; LAS unsigned char* vd = Vl + (idx / 48) * 784 + (ch >> 1) * 32 + (ch & 1) * 8; *(LAS u32x2*)vd = (u32x2){rv[i].x, rv[i].y}; *(LAS u32x2*)(vd + 16) = (u32x2){rv[i].z, rv[i].w}; } }
        __syncthreads(); HPT_E(32); HPT_B(33);
        for (int st = 0; st < 10; ++st) { const int kp0 = q0 - 128 + 32 * st; if (kp0 < 0 || kp0 >= SEQ) continue;
            attn_step(st < 2 || st >= 8, Kl, Vl, 784, kp0 - kbase, qf, mrun, lrun, o, r32, hi, kp0 - q0 - r32); }
        __syncthreads();
    }
    HPT_E(33);
    const float sk = F.sink[h] * LOG2E;
#pragma unroll
    for (int qt = 0; qt < 2; ++qt) { float l = lrun[qt] + __shfl_xor(lrun[qt], 32); l += __builtin_amdgcn_exp2f(sk - mrun[qt]); const float inv = 1.f / l;
        GAS bf16* op = F.ATT + (size_t)(b * SEQ + q0 + 32 * qt + r32) * QW + h * 64;
#pragma unroll
        for (int dt = 0; dt < 2; ++dt)
#pragma unroll
            for (int rg = 0; rg < 4; ++rg) { u32x2 wv; wv.x = cvt_pk_bf16(o[qt][dt][4 * rg] * inv, o[qt][dt][4 * rg + 1] * inv); wv.y = cvt_pk_bf16(o[qt][dt][4 * rg + 2] * inv, o[qt][dt][4 * rg + 3] * inv);
                *(GAS u32x2*)(op + 32 * dt + 8 * rg + 4 * hi) = wv; } }
}

constexpr int HZ_PITCH = 4112, HG_OFF = 16 * HZ_PITCH  , HG_PITCH = 8224;
__device__ __forceinline__ void hy_load_filter(LAS unsigned char* GC, const GAS bf16* G, int tid) {
    const GAS v4u* gp = (const GAS v4u*)G;
    const v4u a = gp[tid]; v4u b = {0u, 0u, 0u, 0u}; if (tid < 511) b = gp[tid + 1];
    const unsigned w[8] = {a.x, a.y, a.z, a.w, b.x, b.y, b.z, b.w};
#pragma unroll
    for (int rho = 0; rho < 8; ++rho) { v4u o; unsigned t[4];
#pragma unroll
        for (int dd = 0; dd < 4; ++dd) { const int base = (rho >> 1) + dd; t[dd] = (rho & 1) ? __builtin_amdgcn_alignbit(w[base + 1 > 7 ? 7 : base + 1], w[base], 16) : w[base]; }
        o.x = t[0]; o.y = t[1]; o.z = t[2]; o.w = t[3];
        *(LAS v4u*)(GC + rho * HG_PITCH + tid * 16) = o; }
}
__device__ __forceinline__ f32x4 hy_short4(const GAS bf16* up, int t, float w0, float w1, float w2, float bs) {
    const u32x2 v = *(const GAS u32x2*)(up + t);
    const float u0 = bflo(v.x), u1 = bfhi(v.x), u2 = bflo(v.y), u3 = bfhi(v.y);
    const float um = t > 0 ? bf2f(up[t - 1]) : 0.f, up4 = t + 4 < SEQ ? bf2f(up[t + 4]) : 0.f;
    f32x4 r; r[0] = bs + w0 * um + w1 * u0 + w2 * u1; r[1] = bs + w0 * u0 + w1 * u1 + w2 * u2; r[2] = bs + w0 * u1 + w1 * u2 + w2 * u3; r[3] = bs + w0 * u2 + w1 * u3 + w2 * up4; return r;
}
__device__ __forceinline__ void hy_conv(const LAS unsigned char* Z, const LAS unsigned char* GC, int T0, int fr, int fq, f32x4 (&acc)[16]) {
    const int rho = (8 - (fr & 7)) & 7;
    const LAS unsigned char* gb = GC + rho * HG_PITCH + (2048 - fr + 8 * fq - rho - T0) * 2;
    const LAS unsigned char* zb = Z + fr * HZ_PITCH + fq * 16;
    bf16x8 W[16], Bf, nA0, nA1, nB;
#pragma unroll
    for (int m = 0; m < 16; ++m) { W[m] = *(const LAS bf16x8*)(gb + (-16 * m) * 2); acc[m] = (f32x4){0.f, 0.f, 0.f, 0.f}; }
    Bf = *(const LAS bf16x8*)zb;
    for (int jj = 0; jj < 8; ++jj) {
#pragma unroll
        for (int ji = 0; ji < 8; ++ji) {
            const int j = 8 * jj + ji, jn = j + 1 < 64 ? j + 1 : 63;
            nA0 = *(const LAS bf16x8*)(gb + (32 * jn) * 2); nA1 = *(const LAS bf16x8*)(gb + (32 * jn - 16) * 2); nB = *(const LAS bf16x8*)(zb + 64 * jn);
            __builtin_amdgcn_sched_barrier(0);
#pragma unroll
            for (int m = 0; m < 16; ++m) acc[m] = __builtin_amdgcn_mfma_f32_16x16x32_bf16(W[(m - 2 * ji) & 15], Bf, acc[m], 0, 0, 0);
            W[(-2 * (ji + 1)) & 15] = nA0; W[(1 - 2 * (ji + 1)) & 15] = nA1; Bf = nB;
        }
    }
}
__device__ __forceinline__ void hyena_channel(Frame& F, int c) {
    LAS unsigned char* Z = F.lds; LAS unsigned char* GC = F.lds + HG_OFF;
    const int tid = F.tid, lane = F.lane, fr = lane & 15, fq = lane >> 4, T0 = 256 * F.wave;
    HPT_B(13);
    { const int cv = 1024 + c; const float w0 = F.cw[cv], w1 = F.cw[1536 + cv], w2 = F.cw[3072 + cv], bs = F.cb[cv];
#pragma unroll 1
      for (int i0 = 0; i0 < 8; i0 += 4) {
      v4u raw[4]; unsigned short hm1[4], hp8[4];
#pragma unroll
      for (int i = 0; i < 4; ++i) { const int chunk = tid + 512 * (i0 + i), b = chunk >> 8, tc = (chunk & 255) * 8; const GAS bf16* up = F.UT + (size_t)cv * T + b * SEQ;
          raw[i] = *(const GAS v4u*)(up + tc); hm1[i] = tc > 0 ? up[tc - 1] : (unsigned short)0; hp8[i] = tc + 8 < SEQ ? up[tc + 8] : (unsigned short)0; }
#pragma unroll
      for (int i = 0; i < 4; ++i) { const int chunk = tid + 512 * (i0 + i), b = chunk >> 8, tc = (chunk & 255) * 8;
          float u[10]; u[0] = bf2f(hm1[i]); u[1] = bflo(raw[i].x); u[2] = bfhi(raw[i].x); u[3] = bflo(raw[i].y); u[4] = bfhi(raw[i].y); u[5] = bflo(raw[i].z); u[6] = bfhi(raw[i].z); u[7] = bflo(raw[i].w); u[8] = bfhi(raw[i].w); u[9] = bf2f(hp8[i]);
          float r[8];
#pragma unroll
          for (int k = 0; k < 8; ++k) r[k] = bs + w0 * u[k] + w1 * u[k + 1] + w2 * u[k + 2];
          v4u o; o.x = pk2(r[0], r[1]); o.y = pk2(r[2], r[3]); o.z = pk2(r[4], r[5]); o.w = pk2(r[6], r[7]);
          *(LAS v4u*)(Z + b * HZ_PITCH + tc * 2) = o; } } }
    hy_load_filter(GC, F.G_ + (size_t)c * 4096, tid);
    __syncthreads(); HPT_E(13);
    f32x4 acc[16];
    HPT_B(11); hy_conv(Z, GC, T0, fr, fq, acc); HPT_E(11);
    HPT_B(14);
    { const float w0 = F.cw[c], w1 = F.cw[1536 + c], w2 = F.cw[3072 + c], bs = F.cb[c], sk = F.skip[c]; const GAS bf16* up = F.UT + (size_t)c * T + fr * SEQ;
#pragma unroll
      for (int m = 0; m < 16; ++m) { int t = T0 + 16 * m + 4 * fq; asm volatile("" : "+v"(t)); const u32x2 zo = *(const LAS u32x2*)(Z + fr * HZ_PITCH + t * 2); const f32x4 xs = hy_short4(up, t, w0, w1, w2, bs);
          acc[m][0] = xs[0] * (acc[m][0] + sk * bflo(zo.x)); acc[m][1] = xs[1] * (acc[m][1] + sk * bfhi(zo.x)); acc[m][2] = xs[2] * (acc[m][2] + sk * bflo(zo.y)); acc[m][3] = xs[3] * (acc[m][3] + sk * bfhi(zo.y)); } }
    HPT_E(14); HPT_B(15);
    __syncthreads();
#pragma unroll
    for (int m = 0; m < 16; ++m) { const int t = T0 + 16 * m + 4 * fq; u32x2 wv; wv.x = pk2(acc[m][0], acc[m][1]); wv.y = pk2(acc[m][2], acc[m][3]); *(LAS u32x2*)(Z + fr * HZ_PITCH + t * 2) = wv; }
    hy_load_filter(GC, F.G_ + (size_t)(512 + c) * 4096, tid);
    __syncthreads(); HPT_E(15);
    HPT_B(11); hy_conv(Z, GC, T0, fr, fq, acc); HPT_E(11);
    HPT_B(12);
    { const int cx = 512 + c; const float w0 = F.cw[cx], w1 = F.cw[1536 + cx], w2 = F.cw[3072 + cx], bs = F.cb[cx], sk = F.skip[512 + c]; const GAS bf16* up = F.UT + (size_t)cx * T + fr * SEQ;
      GAS bf16* hp = F.HYT + (size_t)c * T + fr * SEQ;
#pragma unroll
      for (int m = 0; m < 16; ++m) { int t = T0 + 16 * m + 4 * fq; asm volatile("" : "+v"(t)); const u32x2 zo = *(const LAS u32x2*)(Z + fr * HZ_PITCH + t * 2); const f32x4 xs = hy_short4(up, t, w0, w1, w2, bs);
          u32x2 wv; wv.x = pk2(xs[0] * (acc[m][0] + sk * bflo(zo.x)), xs[1] * (acc[m][1] + sk * bfhi(zo.x))); wv.y = pk2(xs[2] * (acc[m][2] + sk * bflo(zo.y)), xs[3] * (acc[m][3] + sk * bfhi(zo.y)));
          *(GAS u32x2*)(hp + t) = wv; } }
    __syncthreads();
    HPT_E(12);
}

__device__ __forceinline__ void hyt_transpose(Frame& F) {
    LAS unsigned short* scr = (LAS unsigned short*)(F.lds + F.wave * 16384);
    const int gw = F.vcu * NWAVES + F.wave, NGW = F.G * NWAVES, lane = F.lane, tcx = lane & 7, r8 = lane >> 3;
    GAS bf16* HY = F.ATT + (size_t)T * QW;
    for (int it = gw; it < 4096; it += NGW) {
        const int cb = it & 7, tb = it >> 3;
        v4u raw[8];
#pragma unroll
        for (int i = 0; i < 8; ++i) raw[i] = *(const GAS v4u*)(F.HYT + (size_t)(64 * cb + r8 + 8 * i) * T + 64 * tb + 8 * tcx);
#pragma unroll
        for (int i = 0; i < 8; ++i) { const int ch = r8 + 8 * i; LAS unsigned short* d = scr + (8 * tcx) * 66 + ch;
            d[0 * 66] = (unsigned short)raw[i].x; d[1 * 66] = (unsigned short)(raw[i].x >> 16); d[2 * 66] = (unsigned short)raw[i].y; d[3 * 66] = (unsigned short)(raw[i].y >> 16);
            d[4 * 66] = (unsigned short)raw[i].z; d[5 * 66] = (unsigned short)(raw[i].z >> 16); d[6 * 66] = (unsigned short)raw[i].w; d[7 * 66] = (unsigned short)(raw[i].w >> 16); }
        LDS_WAIT(); asm volatile("" ::: "memory");
#pragma unroll
        for (int i = 0; i < 8; ++i) { const int t = r8 + 8 * i; const LAS unsigned* sp = (const LAS unsigned*)(scr + t * 66 + 8 * tcx);
            v4u o; o.x = sp[0]; o.y = sp[1]; o.z = sp[2]; o.w = sp[3];
            *(GAS v4u*)(HY + (size_t)(64 * tb + t) * HYW + 64 * cb + 8 * tcx) = o; }
        LDS_WAIT(); asm volatile("" ::: "memory");
    }
}

__device__ __forceinline__ void load_row16(const GAS bf16* base, int row, int lane, f32x4 (&v)[4]) {
    const GAS u32x2* vr = (const GAS u32x2*)(base + (size_t)row * D) + lane;
    u32x2 t[4];
#pragma unroll
    for (int j = 0; j < 4; ++j) t[j] = vr[64 * j];
#pragma unroll
    for (int j = 0; j < 4; ++j) v[j] = (f32x4){bflo(t[j].x), bfhi(t[j].x), bflo(t[j].y), bfhi(t[j].y)};
}
__device__ __forceinline__ void ln_inplace(f32x4 (&v)[4]) {
    float s = 0.f;
#pragma unroll
    for (int j = 0; j < 4; ++j) s += (v[j].x + v[j].y) + (v[j].z + v[j].w);
    const float mean = wave_sum(s) * (1.f / D); float s2 = 0.f;
#pragma unroll
    for (int j = 0; j < 4; ++j) { v[j] = v[j] - mean; s2 += (v[j].x * v[j].x + v[j].y * v[j].y) + (v[j].z * v[j].z + v[j].w * v[j].w); }
    const float rstd = 1.f / sqrtf(wave_sum(s2) * (1.f / D) + LN_EPS);
#pragma unroll
    for (int j = 0; j < 4; ++j) v[j] = v[j] * rstd;
}
typedef _Float16 f16x8 __attribute__((ext_vector_type(8)));
typedef _Float16 f16x4 __attribute__((ext_vector_type(4)));
__device__ __forceinline__ void ln_inplace4(f32x4 (&v)[4][4]) {
    float s[4], q[4];
#pragma unroll
    for (int r = 0; r < 4; ++r) { s[r] = 0.f;
#pragma unroll
        for (int j = 0; j < 4; ++j) s[r] += (v[r][j].x + v[r][j].y) + (v[r][j].z + v[r][j].w); }
#pragma unroll
    for (int r = 0; r < 4; ++r) s[r] = wave_sum(s[r]) * (1.f / D);
#pragma unroll
    for (int r = 0; r < 4; ++r) { q[r] = 0.f;
#pragma unroll
        for (int j = 0; j < 4; ++j) { v[r][j] = v[r][j] - s[r]; q[r] += (v[r][j].x * v[r][j].x + v[r][j].y * v[r][j].y) + (v[r][j].z * v[r][j].z + v[r][j].w * v[r][j].w); } }
#pragma unroll
    for (int r = 0; r < 4; ++r) q[r] = 1.f / sqrtf(wave_sum(q[r]) * (1.f / D) + LN_EPS);
#pragma unroll
    for (int r = 0; r < 4; ++r)
#pragma unroll
        for (int j = 0; j < 4; ++j) v[r][j] = v[r][j] * q[r];
}
__device__ __forceinline__ void p6_route(Frame& F) {
    constexpr int RP = 2064;
    LAS unsigned char* W16 = F.lds;
    LAS unsigned char* HT = F.lds + 32 * RP;
    LAS float* LG = (LAS float*)(F.lds + 64 * RP);
    LAS int* rec = (LAS int*)(F.lds + 64 * RP + 8192);
    LAS float* recg = (LAS float*)(F.lds + 64 * RP + 8192 + 2048);
    LAS int* lcnt = (LAS int*)(F.lds + 64 * RP + 8192 + 4096);
    LAS int* lbase = lcnt + 32;
    const int tid = F.tid, lane = F.lane, w = F.wave, fr = lane & 15, fq = lane >> 4;
    for (int i = tid; i < 32768; i += NWAVES * 64) { const int k = i >> 5, e = i & 31; *(LAS _Float16*)(W16 + e * RP + k * 2) = (_Float16)F.rw[i]; }
    if (tid < 32) lcnt[tid] = 0;
    __syncthreads();
    const float rbias = F.rb[lane & 31];
    const int mt = w & 1, nt = (w >> 1) & 1, kh = w >> 2;
    for (int chunk = blockIdx.x; chunk < 256; chunk += F.G) {
        const int b = chunk >> 4;
#pragma unroll 1
        for (int grp = 0; grp < 4; ++grp) {
            const int rg0 = chunk * 128 + grp * 32;
            {
                f32x4 v[4][4];
#pragma unroll
                for (int rr = 0; rr < 4; ++rr) load_row16(F.V1, rg0 + 4 * w + rr, lane, v[rr]);
                int lo = 4 * lane; asm volatile("" : "+v"(lo));
                ln_inplace4(v);
#pragma unroll
                for (int rr = 0; rr < 4; ++rr)
#pragma unroll
                    for (int j = 0; j < 4; ++j) v[rr][j] = v[rr][j] * *(const GAS f32x4*)(F.ln1g + lo + 256 * j) + *(const GAS f32x4*)(F.ln1b + lo + 256 * j);
                ln_inplace4(v);
#pragma unroll
                for (int rr = 0; rr < 4; ++rr) { const int rl = 4 * w + rr;
#pragma unroll
                    for (int j = 0; j < 4; ++j) { v[rr][j] = v[rr][j] * (*(const GAS f32x4*)(F.modF + b * 6144 + 4096 + lo + 256 * j) + 1.f) + *(const GAS f32x4*)(F.modF + b * 6144 + 3072 + lo + 256 * j);
                        *(GAS unsigned*)((GAS unsigned char*)F.HM + (size_t)(rg0 + rl) * D + 4 * lane + 256 * j) = pk4_fp8(v[rr][j].x, v[rr][j].y, v[rr][j].z, v[rr][j].w);
                        const f16x4 hv = {(_Float16)v[rr][j].x, (_Float16)v[rr][j].y, (_Float16)v[rr][j].z, (_Float16)v[rr][j].w};
                        *(LAS f16x4*)(HT + rl * RP + (4 * lane + 256 * j) * 2) = hv; } }
            }
            __syncthreads();
            {
                f32x4 acc = {0.f, 0.f, 0.f, 0.f};
                const LAS unsigned char* wp = W16 + (16 * nt + fr) * RP + (512 * kh + 8 * fq) * 2; const LAS unsigned char* hp = HT + (16 * mt + fr) * RP + (512 * kh + 8 * fq) * 2;
#pragma unroll 4
                for (int s2 = 0; s2 < 16; ++s2) acc = __builtin_amdgcn_mfma_f32_16x16x32_f16(*(const LAS f16x8*)(wp + 64 * s2), *(const LAS f16x8*)(hp + 64 * s2), acc, 0, 0, 0);
#pragma unroll
                for (int k = 0; k < 4; ++k) LG[(kh * 32 + 16 * mt + fr) * 32 + 16 * nt + 4 * fq + k] = acc[k];
            }
            __syncthreads();
#pragma unroll 1
            for (int i = 0; i < 4; ++i) { const int rl = 4 * w + i;
                float cur = LG[rl * 32 + (lane & 31)] + LG[(32 + rl) * 32 + (lane & 31)] + rbias;
                float tv[4]; int te[4];
#pragma unroll
                for (int k = 0; k < 4; ++k) { const float mx = wave_max(cur);
                    const unsigned long long mask = __ballot(cur == mx); const int src = __ffsll((long long)mask) - 1; te[k] = src & 31; tv[k] = mx; if ((lane & 31) == te[k]) cur = -INFINITY; }
                const float p1 = __expf(tv[1] - tv[0]), p2 = __expf(tv[2] - tv[0]), p3 = __expf(tv[3] - tv[0]), inv = 1.f / (1.f + p1 + p2 + p3);
                if (lane < 4) { const int es = lane == 0 ? te[0] : lane == 1 ? te[1] : lane == 2 ? te[2] : te[3]; const float gs = (lane == 0 ? 1.f : lane == 1 ? p1 : lane == 2 ? p2 : p3) * inv;
                    const int rc = grp * 32 + rl;
                    const int rank = __hip_atomic_fetch_add(lcnt + es, 1, __ATOMIC_RELAXED, __HIP_MEMORY_SCOPE_WORKGROUP);
                    rec[rc * 4 + lane] = es | (rank << 5); recg[rc * 4 + lane] = gs; }
            }
            __syncthreads();
        }
        if (tid < 32) { gu32* cp = F.ctl; asm volatile("" : "+s"(cp)); const int cnt = lcnt[tid]; lbase[tid] = cnt ? (int)__hip_atomic_fetch_add(cp + CW_CNT + tid, (unsigned)cnt, RLX_AGENT) : 0; }
        __syncthreads();
        { const int r = rec[tid], e = r & 31, pos = lbase[e] + (r >> 5), row = chunk * 128 + (tid >> 2);
          F.tok[e * 32768 + pos] = row; F.asg[row * 4 + (tid & 3)] = e * 32768 + pos; F.gw[row * 4 + (tid & 3)] = recg[tid]; }
        __syncthreads();
        if (tid < 32) lcnt[tid] = 0;
        __syncthreads();
    }
}
__device__ __forceinline__ void moe_tables(Frame& F) {
    LAS int* tp = (LAS int*)(F.lds + TP_OFF);
    if (F.tid < 32) { gu32* cp = F.ctl; asm volatile("" : "+s"(cp)); const int cnt = (int)__hip_atomic_load(cp + CW_CNT + F.tid, RLX_AGENT);
        tp[33 + F.tid] = cnt; tp[65 + F.tid] = (cnt + 255) >> 8; }
    __syncthreads();
    if (F.tid < 33) { int a = 0;
        for (int e = 0; e < 32; ++e) a += (e < F.tid) ? tp[65 + e] : 0;
        tp[F.tid] = a; }
    __syncthreads();
}

typedef int i32x4 __attribute__((ext_vector_type(4)));
__device__ __forceinline__ void p9_final(Frame& F) {
    const LAS int* tp = (const LAS int*)(F.lds + TP_OFF);
    const int lane = F.lane;
    f32x4 g1v[4], b1v[4], g2v[4], b2v[4];
#pragma unroll
    for (int j = 0; j < 4; ++j) { const int col = 4 * lane + 256 * j; g1v[j] = *(const GAS f32x4*)(F.ln1g + col); b1v[j] = *(const GAS f32x4*)(F.ln1b + col); g2v[j] = *(const GAS f32x4*)(F.ln2g + col); b2v[j] = *(const GAS f32x4*)(F.ln2b + col); }
    for (int chunk = blockIdx.x; chunk < 256; chunk += F.G) {
        const int b = chunk >> 4, row0 = chunk * 128 + F.wave * 16;
        f32x4 gm[4];
#pragma unroll
        for (int j = 0; j < 4; ++j) gm[j] = *(const GAS f32x4*)(F.modF + b * 6144 + 5120 + 4 * lane + 256 * j);
        f32x4 v[4]; i32x4 a = *(const GAS i32x4*)(F.asg + row0 * 4); f32x4 g = *(const GAS f32x4*)(F.gw + row0 * 4);
        load_row16(F.V1, row0, lane, v);
        for (int it = 0; it < 16; ++it) {
            const int row = row0 + it, rn = it < 15 ? row + 1 : row;
            unsigned y[4][4];
#pragma unroll
            for (int k = 0; k < 4; ++k) { const int e = a[k] >> 15, pos = a[k] & 32767; const GAS unsigned char* yp = (const GAS unsigned char*)F.YB + (size_t)(256 * tp[e] + pos) * D + 4 * lane;
#pragma unroll
                for (int j = 0; j < 4; ++j) y[k][j] = __builtin_nontemporal_load((const GAS unsigned*)(yp + 256 * j)); }
            f32x4 nv[4]; load_row16(F.V1, rn, lane, nv);
            const i32x4 na = *(const GAS i32x4*)(F.asg + rn * 4); const f32x4 ng = *(const GAS f32x4*)(F.gw + rn * 4);
            ln_inplace(v);
#pragma unroll
            for (int j = 0; j < 4; ++j) { f32x4 f = {0.f, 0.f, 0.f, 0.f};
#pragma unroll
                for (int k = 0; k < 4; ++k) { const f32x2 lo = __builtin_amdgcn_cvt_pk_f32_fp8((int)y[k][j], false), hi = __builtin_amdgcn_cvt_pk_f32_fp8((int)y[k][j], true); f[0] += g[k] * lo[0]; f[1] += g[k] * lo[1]; f[2] += g[k] * hi[0]; f[3] += g[k] * hi[1]; }
                v[j] = (v[j] * g1v[j] + b1v[j]) * DN_ALPHA + gm[j] * f; }
            ln_inplace(v);
#pragma unroll
            for (int j = 0; j < 4; ++j) __builtin_nontemporal_store(v[j] * g2v[j] + b2v[j], (GAS f32x4*)(F.out + (size_t)row * D + 4 * lane + 256 * j));
#pragma unroll
            for (int j = 0; j < 4; ++j) v[j] = nv[j];
            a = na; g = ng;
        }
    }
}

struct Args { const float* in[29]; float* out; unsigned char* ws; int ph_lo, ph_hi; };
__global__ void __launch_bounds__(NWAVES * 64, 2) mk_fwd(Args args) {
    extern __shared__ __attribute__((aligned(16))) unsigned char lds[];
    Frame F;
    F.lds = (LAS unsigned char*)lds;
    F.MISC = (volatile LAS unsigned*)(F.lds + MISC_OFF);
    F.tid = threadIdx.x; F.lane = F.tid & 63; F.wave = __builtin_amdgcn_readfirstlane(F.tid >> 6);
    F.G = gridDim.x; { const int bx = blockIdx.x; F.vcu = (F.G % 8 == 0) ? (bx % 8) * (F.G / 8) + bx / 8 : bx; }
    unsigned char* ws = args.ws;
    F.ctl = (gu32*)(ws + WS_CTL);
    F.x = (const GAS float*)args.in[0]; F.c = (const GAS float*)args.in[1]; F.ctx = (const GAS float*)args.in[2]; F.c_ctx = (const GAS float*)args.in[3]; F.w_mod = (const GAS float*)args.in[4]; F.b_mod = (const GAS float*)args.in[5]; F.w_in = (const GAS float*)args.in[6]; F.sink = (const GAS float*)args.in[7];
    F.cw = (const GAS float*)args.in[8]; F.cb = (const GAS float*)args.in[9]; F.fw1 = (const GAS float*)args.in[10]; F.fb1 = (const GAS float*)args.in[11]; F.fw2 = (const GAS float*)args.in[12]; F.fb2 = (const GAS float*)args.in[13]; F.fw3 = (const GAS float*)args.in[14]; F.skip = (const GAS float*)args.in[15];
    F.w_ba = (const GAS float*)args.in[16]; F.w_bh = (const GAS float*)args.in[17]; F.w_out = (const GAS float*)args.in[18]; F.ln1g = (const GAS float*)args.in[19]; F.ln1b = (const GAS float*)args.in[20]; F.rw = (const GAS float*)args.in[21]; F.rb = (const GAS float*)args.in[22];
    F.ew1 = (const GAS float*)args.in[23]; F.eb1 = (const GAS float*)args.in[24]; F.ew2 = (const GAS float*)args.in[25]; F.eb2 = (const GAS float*)args.in[26]; F.ln2g = (const GAS float*)args.in[27]; F.ln2b = (const GAS float*)args.in[28]; F.out = (GAS float*)args.out;
    F.modP = (GAS float*)(ws + WS_MODP); F.modF = (GAS float*)(ws + WS_MODF); F.rope = (GAS float*)(ws + WS_ROPE); F.gw = (GAS float*)(ws + WS_GW); F.V1 = (GAS bf16*)(ws + WS_V1);
    F.asg = (GAS int*)(ws + WS_ASG); F.tok = (GAS int*)(ws + WS_TOK);
    F.G_ = (GAS bf16*)(ws + WS_G); F.WB = (GAS bf16*)(ws + WS_WB); F.WO = (GAS bf16*)(ws + WS_WO); F.WIN = (GAS bf16*)(ws + WS_WIN); F.W1 = (GAS bf16*)(ws + WS_W1); F.W2 = (GAS bf16*)(ws + WS_W2);
    F.HM = (GAS bf16*)(ws + WS_HM); F.HX = (GAS bf16*)(ws + WS_HX); F.Q = (GAS bf16*)(ws + WS_Q); F.K = (GAS bf16*)(ws + WS_K); F.VT = (GAS bf16*)(ws + WS_VT); F.KC = (GAS bf16*)(ws + WS_KC); F.VTC = (GAS bf16*)(ws + WS_VTC);
    F.UT = (GAS bf16*)(ws + WS_UT); F.GATE = (GAS bf16*)(ws + WS_GATE); F.ATT = (GAS bf16*)(ws + WS_ATT); F.MM = (GAS bf16*)(ws + WS_MM); F.ACT = (GAS bf16*)(ws + WS_ACT); F.YB = (GAS bf16*)(ws + WS_YB); F.HYT = (GAS bf16*)(ws + WS_HYT);
    for (int u = F.tid; u < (LDS_BYTES - LDSCTL_OFF) / 4; u += NWAVES * 64) ((LAS unsigned*)(F.lds + LDSCTL_OFF))[u] = 0u;
    __syncthreads();
    XcdBarrier bar; bar.bar = (unsigned*)(F.ctl + CW_BAR); bar.x = 0; bar.st = nullptr;
    if (N_LAUNCHES == 1) bar = xcd_barrier_post((unsigned*)(F.ctl + CW_BAR), F.MISC + 8);
#define GRID_BAR() do { if (N_LAUNCHES == 1) { if (PROBE_SPIN == 20 || PROBE_SPIN == 21 + nbar_) pt0_ = rt(); xcd_barrier(bar); if (PROBE_SPIN == 20 || PROBE_SPIN == 21 + nbar_) ptacc_ += rt() - pt0_; ++nbar_; } } while (0)
    const int lo = args.ph_lo, hi = args.ph_hi;
#ifndef PHMASK
#define PHMASK 0x3ff
#endif
#define IN(k) (((PHMASK >> (k)) & 1) && lo <= (k) && (k) < hi)
#define BOTH(k) (IN(k) && IN((k) + 1))
#define FRESH() do { F.lane = pg8::lane_id_v(); F.tid = F.wave * 64 + F.lane; } while (0)
    const int bx = (int)blockIdx.x;
    unsigned long long pt0_ = 0, ptacc_ = 0; F.pt0 = 0; F.ptacc = 0; int nbar_ = 0;
#define PT_BEGIN(k) do { if (PROBE_SPIN == (k)) pt0_ = rt(); } while (0)
#define PT_END(k) do { if (PROBE_SPIN == (k)) ptacc_ += rt() - pt0_; } while (0)

    if (IN(0)) { FRESH(); PT_BEGIN(0); p0_prologue(F); if (IN(2)) GRID_BAR(); PT_END(0); }
    if (IN(2)) { FRESH();
        pg8::Gemm g{(const bf16*)F.HX, (const bf16*)F.WIN, 1024, F.wave}; SchedInProj S; S.so.init(128, 17, F.G, bx); S.G = F.G; S.c = bx;
        EpiInProj E{F.Q, F.K, F.VT, F.KC, F.VTC, F.UT, F.GATE, F.rope};
        PT_BEGIN(2); pg8::gemm_phase<EpiInProj, SchedInProj, true, false>(F.lds, g, S, E);
        if (BOTH(2)) GRID_BAR(); PT_END(2);
    }
    if (IN(3)) { FRESH();
        PT_BEGIN(3); for (int u = bx; u < 512; u += F.G) attn_unit(F, u >> 5, (u >> 4) & 1, u & 15); PT_END(3);
        FRESH(); PT_BEGIN(10); for (int ch = F.vcu; ch < 512; ch += F.G) hyena_channel(F, ch);
        if (BOTH(3)) GRID_BAR(); PT_END(10);
    }
    if (IN(4)) { FRESH();
        PT_BEGIN(4); hyt_transpose(F); GRID_BAR(); PT_END(4);
        pg8::Gemm g{(const bf16*)F.ATT, (const bf16*)F.WB, 512, F.wave}; SchedPair S; S.so.init(128, 4, F.G, bx);
        EpiMerge E{F.GATE, F.MM};
        PT_BEGIN(17); pg8::gemm_phase<EpiMerge, SchedPair, true, false>(F.lds, g, S, E);
        if (BOTH(4)) GRID_BAR(); PT_END(17);
    }
    if (IN(5)) { FRESH();
        pg8::Gemm g{(const bf16*)F.MM, (const bf16*)F.WO, 1024, F.wave}; SchedPlain S; S.so.init(128, 4, F.G, bx);
        EpiV1 E{F.x, F.modF, F.V1};
        PT_BEGIN(5); pg8::gemm_phase<EpiV1, SchedPlain, true, false>(F.lds, g, S, E);
        if (BOTH(5)) GRID_BAR(); PT_END(5);
    }
    if (IN(6)) { FRESH(); PT_BEGIN(6); p6_route(F); if (BOTH(6)) GRID_BAR(); PT_END(6); }
    if (IN(7)) { FRESH();
        moe_tables(F);
        pg8::Gemm g{(const bf16*)F.HM, (const bf16*)F.W1, 512, F.wave}; SchedMoe S{(const LAS int*)(F.lds + TP_OFF), F.tok, 8, F.G, bx};
        EpiAct E{F.eb1, F.ACT};
        PT_BEGIN(7); pg8::gemm_phase<EpiAct, SchedMoe, true, true, true>(F.lds, g, S, E);
        if (BOTH(7)) GRID_BAR(); PT_END(7);
    }
    if (IN(8)) { FRESH();
        moe_tables(F);
        pg8::Gemm g{(const bf16*)F.ACT, (const bf16*)F.W2, 512, F.wave}; SchedMoe S{(const LAS int*)(F.lds + TP_OFF), F.tok, 4, F.G, bx};
        EpiYb E{F.eb2, F.YB};
        PT_BEGIN(8); pg8::gemm_phase<EpiYb, SchedMoe, true, false, true>(F.lds, g, S, E);
        if (BOTH(8)) GRID_BAR(); PT_END(8);
    }
    if (IN(9)) { FRESH(); PT_BEGIN(9); moe_tables(F); p9_final(F); PT_END(9); }
    if (PROBE_SPIN >= 0 && bx == 0) { const unsigned long long t0_ = rt(); const unsigned long long gacc_ = (PROBE_SPIN == 18 || PROBE_SPIN == 19) ? *(volatile LAS unsigned long long*)(F.lds + 153600) : 0ull; while (rt() - t0_ < ptacc_ + F.ptacc + gacc_) __builtin_amdgcn_s_sleep(8); }
#undef IN
#undef BOTH
#undef GRID_BAR
}

extern "C" void kernel_launch(void* const* d_in, const int* in_sizes, int n_in, void* d_out, int out_size, void* d_ws, size_t ws_size, hipStream_t stream) {
    static int grid = 0;
    if (grid == 0) {
        if (n_in != 29 || in_sizes[0] != T * D || out_size != T * D || ws_size < WS_END) { fprintf(stderr, "kernel_launch: unexpected shapes (n_in %d, in0 %d, out %d, ws %zu); nothing launched\n", n_in, n_in > 0 ? in_sizes[0] : -1, out_size, ws_size); grid = -1; return; }
        int dev = 0, cus = 0, per_cu = 0;
        if (hipGetDevice(&dev) != hipSuccess || hipDeviceGetAttribute(&cus, hipDeviceAttributeMultiprocessorCount, dev) != hipSuccess) { grid = -1; return; }
        if (hipFuncSetAttribute((const void*)mk_fwd, hipFuncAttributeMaxDynamicSharedMemorySize, LDS_BYTES) != hipSuccess) { fprintf(stderr, "kernel_launch: hipFuncSetAttribute failed\n"); grid = -1; return; }
        if (hipOccupancyMaxActiveBlocksPerMultiprocessor(&per_cu, (const void*)mk_fwd, NWAVES * 64, LDS_BYTES) != hipSuccess || per_cu < 1) { fprintf(stderr, "kernel_launch: occupancy query reports %d workgroups per CU\n", per_cu); }
        (void)hipGetLastError();
        grid = cus < 256 ? cus : 256;
    }
    if (grid < 0) return;
    if (hipMemsetAsync((char*)d_ws + WS_CTL, 0, CTL_ZERO_BYTES, stream) != hipSuccess) return;
    Args a{};
    for (int i = 0; i < 29; ++i) a.in[i] = (const float*)d_in[i];
    a.out = (float*)d_out; a.ws = (unsigned char*)d_ws;
    if (N_LAUNCHES == 1) { a.ph_lo = 0; a.ph_hi = NPH; hipLaunchKernelGGL(mk_fwd, dim3(grid), dim3(NWAVES * 64), LDS_BYTES, stream, a); }
    else for (int p = 0; p < NPH; ++p) { a.ph_lo = p; a.ph_hi = p + 1; hipLaunchKernelGGL(mk_fwd, dim3(grid), dim3(NWAVES * 64), LDS_BYTES, stream, a); }
}
```

```cpp
#include <hip/hip_runtime.h>
#include <cstdio>
#include <cstdint>
#include <cmath>
namespace pg8 {
#define PG8_LAS __attribute__((address_space(3)))
typedef unsigned short bf16_t;
typedef short bf16x8 __attribute__((ext_vector_type(8)));
typedef float f32x4 __attribute__((ext_vector_type(4)));
typedef unsigned u32x4 __attribute__((ext_vector_type(4)));
constexpr int BM = 256, BK = 64, HALF = 128, HTB = HALF * BK * 2  , STAGE_BYTES = 8 * HTB, NXCD = 8, WGM = 8;

__host__ __device__ __forceinline__ int lds_byte(int r, int c) { const int st = (r >> 4) * 2 + (c >> 5), rr = r & 15, cc = c & 31, ob = rr * 64 + cc * 2; return st * 1024 + (ob ^ (((ob >> 9) & 1) << 5)); }
__host__ __device__ __forceinline__ void stage_rc(int b, int& R, int& C) { const int st = b / 1024, sb = b % 1024, swz = sb ^ (((sb >> 9) & 1) << 5); R = (st >> 1) * 16 + swz / 64; C = (st & 1) * 32 + (swz % 64) / 2; }
__host__ __device__ __forceinline__ int perm32(int rho) { const int n = rho >> 4, i = rho & 15; return 8 * (i >> 2) + 4 * n + (i & 3); }

struct Unit { int pm, pn; };
struct Gemm { const bf16_t* A; const bf16_t* Bt; int K; int wave; };

struct StaticOrder {
    int nM, nN, nwg, G, c, wgm = WGM;
    __host__ __device__ void init(int nM_, int nN_, int G_, int c_) { nM = nM_; nN = nN_; nwg = nM * nN; G = G_; c = c_; }
    __host__ __device__ bool next(int i, Unit& u) const {
        const long L = (long)i * G + c; if (L >= nwg) return false;
        int wgid = (int)L; { const int q = nwg / NXCD, r = nwg % NXCD, xcd = wgid % NXCD, off = wgid / NXCD; wgid = (xcd < r ? xcd * (q + 1) : r * (q + 1) + (xcd - r) * q) + off; }
        const int nig = wgm * nN, gid = wgid / nig, fm = gid * wgm, gsz = (nM - fm) < wgm ? (nM - fm) : wgm;
        u.pm = fm + ((wgid % nig) % gsz); u.pn = (wgid % nig) / gsz; return true;
    }
};

typedef float f32x2_cv __attribute__((ext_vector_type(2))); typedef __bf16 bf16x2_cv __attribute__((ext_vector_type(2)));
__device__ __forceinline__ unsigned cvt_pk_bf16(float lo, float hi) { const f32x2_cv v = {lo, hi}; const bf16x2_cv b = __builtin_convertvector(v, bf16x2_cv); return __builtin_bit_cast(unsigned, b); }

__device__ __forceinline__ int lane_id_v() { int l; asm volatile("v_mbcnt_lo_u32_b32 %0, -1, 0\n\tv_mbcnt_hi_u32_b32 %0, -1, %0" : "=v"(l)); return l; }
typedef int i32x4_t __attribute__((ext_vector_type(4)));
typedef int i32x8_t __attribute__((ext_vector_type(8)));
__device__ __forceinline__ i32x8_t cat8(bf16x8 lo, bf16x8 hi) { const i32x4_t a = __builtin_bit_cast(i32x4_t, lo), b = __builtin_bit_cast(i32x4_t, hi); return __builtin_shufflevector(a, b, 0, 1, 2, 3, 4, 5, 6, 7); }
#ifndef PROBE_SPIN
#define PROBE_SPIN -1
#endif
#define PG8_PT_B(k) do { if (PROBE_SPIN == (k) && FP8 && !GATHER && tid == 0) pt_t0 = __builtin_amdgcn_s_memrealtime(); } while (0)
#define PG8_PT_E(k) do { if (PROBE_SPIN == (k) && FP8 && !GATHER && tid == 0) *(volatile PG8_LAS unsigned long long*)(lds + 153600) += __builtin_amdgcn_s_memrealtime() - pt_t0; } while (0)
template <class E, class = void> struct epi_wide { static constexpr bool value = false; };
template <class E> struct epi_wide<E, decltype((void)E::WIDE)> { static constexpr bool value = E::WIDE; };
template <class Epi, class Sched, bool ALIGN_EPI, bool GATHER, bool FP8 = false, int VAR = 0>
__device__ __forceinline__ void gemm_phase(PG8_LAS unsigned char* lds, const Gemm g, const Sched& S, const Epi& E) {
    const int wid = g.wave, lane = lane_id_v(), tid = wid * 64 + lane, wr = wid >> 2, wc = wid & 3, fr = lane & 15, fq = lane >> 4;
    const int K = g.K, nt = K / BK;
    unsigned voffA[2], voffB[2]; int gR[2]; unsigned gC[2];
    constexpr bool WIDE = epi_wide<Epi>::value;
#pragma unroll
    for (int i = 0; i < 2; ++i) { int R, C; stage_rc(tid * 16 + i * 8192, R, C); const int Rb = WIDE ? (64 * (R >> 5) + perm32(R & 31)) : (Epi::PERM ? ((R & ~31) + perm32(R & 31)) : R);
        voffA[i] = (unsigned)(R * K + C) * 2u; voffB[i] = (unsigned)(Rb * K + C) * 2u; gR[i] = R; gC[i] = (unsigned)C * 2u; }
    const size_t kstep = (size_t)(BK * 2);
    const size_t hstep = (size_t)HALF * K * 2;
    const size_t tstep = 2 * hstep;
    const size_t r64 = (size_t)64 * K * 2;
    const size_t hstepB = WIDE ? (size_t)32 * K * 2 : hstep, r64B = WIDE ? (size_t)128 * K * 2 : r64;
    const unsigned ldsw = (unsigned)wid * 1024u;
    const int aoff = lds_byte(wr * 64 + fr, fq * 8), boff = lds_byte(wc * 32 + fr, fq * 8);
#define PG8_SA(b, h) (((b) * 2 + (h)) * HTB)
#define PG8_SB(b, h) ((4 + (b) * 2 + (h)) * HTB)
#define PG8_STAGE(bufoff, gbase, voff) do { if constexpr (VAR != 2 && VAR != 5 && VAR != 6) _Pragma("unroll") for (int _i = 0; _i < 2; ++_i) { unsigned v_ = (voff)[0]; if constexpr (FP8 && GATHER) asm volatile("" : "+v"(v_)); \
        __builtin_amdgcn_global_load_lds((const unsigned*)((const char*)(gbase) + (size_t)_i * r64 + v_), (PG8_LAS unsigned*)(lds + (bufoff) + ldsw + _i * 8192), 16, 0, 0); } } while (0)
#define PG8_STAGE_B(bufoff, gbase) do { if constexpr (VAR != 2 && VAR != 5 && VAR != 6) _Pragma("unroll") for (int _i = 0; _i < 2; ++_i) { unsigned v_ = voffB[0]; if constexpr (FP8 && GATHER) asm volatile("" : "+v"(v_)); \
        __builtin_amdgcn_global_load_lds((const unsigned*)((const char*)(gbase) + (size_t)_i * r64B + v_), (PG8_LAS unsigned*)(lds + (bufoff) + ldsw + _i * 8192), 16, 0, 0); } } while (0)
#define PG8_STAGE_G(bufoff, gbase, pk) do { if constexpr (VAR != 2) _Pragma("unroll") for (int _i = 0; _i < 2; ++_i) { unsigned p_ = (pk); asm volatile("" : "+v"(p_));   \
        __builtin_amdgcn_global_load_lds((const unsigned*)((const char*)(gbase) + (((p_ >> (16 * _i)) & 0xffffu) * (unsigned)(K * 2) + gC[0])), (PG8_LAS unsigned*)(lds + (bufoff) + ldsw + _i * 8192), 16, 0, 0); } } while (0)
#define PG8_STAGE_A(b, h, kp, VS) do { if constexpr (GATHER) { PG8_STAGE_G(PG8_SA(b, h), (kp), VS[h]); } else { PG8_STAGE(PG8_SA(b, h), (kp) + (size_t)(h) * hstep, voffA); } } while (0)
#define PG8_LDA(dst, b, h) do { if constexpr (VAR != 1 && VAR != 5 && VAR != 6) _Pragma("unroll") for (int m = 0; m < 4; ++m) { if constexpr (FP8) { dst##8[m] = __builtin_shufflevector(*(const PG8_LAS i32x4_t*)(lds + PG8_SA(b, h) + aoff + m * 2048), *(const PG8_LAS i32x4_t*)(lds + PG8_SA(b, h) + aoff + m * 2048 + 1024), 0, 1, 2, 3, 4, 5, 6, 7); } \
        else { _Pragma("unroll") for (int k = 0; k < 2; ++k) dst[m][k] = *(const PG8_LAS bf16x8*)(lds + PG8_SA(b, h) + aoff + m * 2048 + k * 1024); } } } while (0)
#define PG8_LDB(dst, b, h) do { if constexpr (VAR != 1 && VAR != 5 && VAR != 6) _Pragma("unroll") for (int n = 0; n < 2; ++n) { if constexpr (FP8) { dst##8[n] = __builtin_shufflevector(*(const PG8_LAS i32x4_t*)(lds + PG8_SB(b, h) + boff + n * 2048), *(const PG8_LAS i32x4_t*)(lds + PG8_SB(b, h) + boff + n * 2048 + 1024), 0, 1, 2, 3, 4, 5, 6, 7); } \
        else { _Pragma("unroll") for (int k = 0; k < 2; ++k) dst[n][k] = *(const PG8_LAS bf16x8*)(lds + PG8_SB(b, h) + boff + n * 2048 + k * 1024); } } } while (0)
#define PG8_MMA(ai, bj, At, Bt) do { if constexpr (VAR != 4) __builtin_amdgcn_s_setprio(1); if constexpr (VAR == 3 || VAR == 5 || VAR == 6) { _Pragma("unroll") for (int m_ = 0; m_ < 4; ++m_) { if constexpr (FP8) asm volatile("" :: "v"(At##8[m_])); } _Pragma("unroll") for (int n_ = 0; n_ < 2; ++n_) { if constexpr (FP8) asm volatile("" :: "v"(Bt##8[n_])); } } if constexpr (VAR != 3 && VAR != 5 && VAR != 6) _Pragma("unroll") for (int m = 0; m < 4; ++m) _Pragma("unroll") for (int n = 0; n < 2; ++n) { \
        if constexpr (FP8) { acc[ai][bj][m][n] = __builtin_amdgcn_mfma_scale_f32_16x16x128_f8f6f4(Bt##8[n], At##8[m], acc[ai][bj][m][n], 0, 0, 0, 0, 0, 0); } \
        else { _Pragma("unroll") for (int k = 0; k < 2; ++k) acc[ai][bj][m][n] = __builtin_amdgcn_mfma_f32_16x16x32_bf16(Bt[n][k], At[m][k], acc[ai][bj][m][n], 0, 0, 0); } } if constexpr (VAR != 4) __builtin_amdgcn_s_setprio(0); } while (0)
#define PG8_WAIT_V(n) asm volatile("s_waitcnt vmcnt(" #n ")" ::: "memory")
#define PG8_WAIT_V8_SKIPPABLE do { if (!(VAR == 10 && ui > 0 && t == 0)) asm volatile("s_waitcnt vmcnt(8)" ::: "memory"); } while (0)
#define PG8_WAIT_L(n) asm volatile("s_waitcnt lgkmcnt(" #n ")" ::: "memory")
#define PG8_BAR do { if constexpr (VAR != 6) __builtin_amdgcn_s_barrier(); } while (0)
#define PG8_SCHED __builtin_amdgcn_sched_barrier(0)
    unsigned long long pt_t0 = 0;
    Unit cur, nxt; int ui = 0;
    if (!S.next(0, cur)) return;
    f32x4 acc[2][2][4][2];
#pragma unroll
    for (int a = 0; a < 2; ++a)
#pragma unroll
        for (int b = 0; b < 2; ++b)
#pragma unroll
            for (int m = 0; m < 4; ++m)
#pragma unroll
                for (int n = 0; n < 2; ++n) acc[a][b][m][n] = (f32x4){0.f, 0.f, 0.f, 0.f};
    bf16x8 At[4][2] = {}, B0[2][2] = {}, B1[2][2] = {}; i32x8_t At8[4] = {}, B08[2] = {}, B18[2] = {};
    unsigned vAc[2];
    const char* cA = GATHER ? (const char*)g.A : (const char*)g.A + (size_t)cur.pm * tstep; const char* cB = (const char*)g.Bt + (size_t)cur.pn * tstep;
    if constexpr (GATHER) {
#pragma unroll
        for (int h = 0; h < 2; ++h) vAc[h] = (unsigned)S.rowoff(cur, h * HALF + gR[0]) | ((unsigned)S.rowoff(cur, h * HALF + gR[0] + 64) << 16);
    }
    PG8_STAGE_B(PG8_SB(0, 0), cB); PG8_STAGE_B(PG8_SB(0, 1), cB + hstepB); PG8_STAGE_A(0, 0, cA, vAc); PG8_STAGE_A(0, 1, cA, vAc);
    if (wr == 1) PG8_BAR;
    PG8_WAIT_V(2); PG8_BAR;
    PG8_STAGE_B(PG8_SB(1, 0), cB + kstep); PG8_STAGE_A(1, 0, cA + kstep, vAc); PG8_STAGE_B(PG8_SB(1, 1), cB + hstepB + kstep);
    PG8_WAIT_V(6); PG8_BAR;
    for (;;) {
        const bool has_next = S.next(ui + 1, nxt);
        const char* nA = GATHER ? cA : (has_next ? (const char*)g.A + (size_t)nxt.pm * tstep : cA); const char* nB = has_next ? (const char*)g.Bt + (size_t)nxt.pn * tstep : cB;
        int gr0 = 0, gr1 = 0, gr2 = 0, gr3 = 0;
        if constexpr (GATHER) {
            const int t_ = wid * 64 + lane_id_v(); int R_, C_; stage_rc(t_ * 16, R_, C_);
            if (has_next) { gr0 = S.rowoff(nxt, R_); gr1 = S.rowoff(nxt, R_ + 64); gr2 = S.rowoff(nxt, HALF + R_); gr3 = S.rowoff(nxt, HALF + R_ + 64); }
        }
#pragma unroll 1
        for (int t = 0; t < nt; t += 2) {
            const bool last = (t == nt - 2);
            const char* a1 = cA + (size_t)(t + 1) * kstep;
            const char* a2 = last ? nA : cA + (size_t)(t + 2) * kstep; const char* b2 = last ? nB : cB + (size_t)(t + 2) * kstep;
            const char* a3 = a2 + kstep; const char* b3 = b2 + kstep;
            PG8_LDB(B0, 0, 0); PG8_LDB(B1, 0, 1); PG8_SCHED; PG8_LDA(At, 0, 0); PG8_STAGE_A(1, 1, a1, vAc);
            if constexpr (GATHER) { if (last && has_next) { vAc[0] = (unsigned)gr0 | ((unsigned)gr1 << 16); vAc[1] = (unsigned)gr2 | ((unsigned)gr3 << 16); } }
            PG8_WAIT_V8_SKIPPABLE; PG8_WAIT_L(0); PG8_BAR; PG8_MMA(0, 0, At, B0); PG8_MMA(0, 1, At, B1); PG8_BAR; PG8_SCHED;
            PG8_LDA(At, 0, 1); PG8_STAGE_B(PG8_SB(0, 0), b2); PG8_STAGE_B(PG8_SB(0, 1), b2 + hstepB); PG8_STAGE_A(0, 0, a2, vAc);
            PG8_WAIT_V8_SKIPPABLE; PG8_WAIT_L(0); PG8_BAR; PG8_MMA(1, 0, At, B0); PG8_MMA(1, 1, At, B1); PG8_BAR; PG8_SCHED;
            PG8_LDB(B0, 1, 0); PG8_LDB(B1, 1, 1); PG8_SCHED; PG8_LDA(At, 1, 0); PG8_STAGE_A(0, 1, a2, vAc);
            PG8_WAIT_V8_SKIPPABLE; PG8_WAIT_L(0); PG8_BAR; PG8_MMA(0, 0, At, B0); PG8_MMA(0, 1, At, B1); PG8_BAR; PG8_SCHED;
            PG8_LDA(At, 1, 1); PG8_STAGE_B(PG8_SB(1, 0), b3); PG8_STAGE_B(PG8_SB(1, 1), b3 + hstepB); PG8_STAGE_A(1, 0, a3, vAc);
            PG8_WAIT_V(8); PG8_WAIT_L(0); PG8_BAR; PG8_MMA(1, 0, At, B0); PG8_MMA(1, 1, At, B1); PG8_BAR; PG8_SCHED;
        }
        PG8_PT_B(18);
        if constexpr (ALIGN_EPI) { if (wr == 0) PG8_BAR; }
        PG8_PT_B(19); if constexpr (VAR != 7) { const int l_ = lane_id_v(); E(acc, cur, wr, wc, l_ & 15, l_ >> 4); } else { asm volatile("" :: "v"(acc[0][0][0][0]), "v"(acc[1][1][3][1])); } PG8_PT_E(19);
        if (!has_next) break;
#pragma unroll
        for (int a = 0; a < 2; ++a)
#pragma unroll
            for (int b = 0; b < 2; ++b)
#pragma unroll
                for (int m = 0; m < 4; ++m)
#pragma unroll
                    for (int n = 0; n < 2; ++n) acc[a][b][m][n] = (f32x4){0.f, 0.f, 0.f, 0.f};
        cur = nxt; cA = nA; cB = nB; ++ui;
        if constexpr (ALIGN_EPI) { if (wr == 1) PG8_BAR; }
        PG8_PT_E(18);
    }
    PG8_WAIT_V(0);
    if constexpr (!ALIGN_EPI) { if (wr == 0) PG8_BAR; }
    PG8_BAR;
#undef PG8_SA
#undef PG8_SB
#undef PG8_STAGE
#undef PG8_STAGE_A
#undef PG8_STAGE_B
#undef PG8_STAGE_G
#undef PG8_LDA
#undef PG8_LDB
#undef PG8_MMA
#undef PG8_WAIT_V
#undef PG8_WAIT_V8_SKIPPABLE
#undef PG8_WAIT_L
#undef PG8_BAR
#undef PG8_SCHED
}
}
#define GAS __attribute__((address_space(1)))
#define LAS __attribute__((address_space(3)))
typedef unsigned short bf16;
typedef unsigned v4u __attribute__((ext_vector_type(4)));
typedef float f32x4 __attribute__((ext_vector_type(4)));
typedef short bf16x8 __attribute__((ext_vector_type(8)));
typedef GAS unsigned gu32;
typedef GAS unsigned long long gu64;
#define RLX_AGENT __ATOMIC_RELAXED, __HIP_MEMORY_SCOPE_AGENT
#define LDS_WAIT() asm volatile("s_waitcnt lgkmcnt(0)" ::: "memory")
#define VM_WAIT() asm volatile("s_waitcnt vmcnt(0)" ::: "memory")
__device__ __forceinline__ unsigned long long rt() { return __builtin_amdgcn_s_memrealtime(); }
__device__ __forceinline__ unsigned f2bf(float f) { unsigned u = __builtin_bit_cast(unsigned, f); return (u + 0x7fffu + ((u >> 16) & 1u)) >> 16; }
__device__ __forceinline__ unsigned pk2(float lo, float hi) { return f2bf(lo) | (f2bf(hi) << 16); }

#define XB_TMO      128
#define XB_XCNT(j)  (256  + 64 * (j))
#define XB_XSUB(j)  (1280 + 64 * (j))
#define XB_XGEN(j)  (2304 + 64 * (j))
#define XB_TOP      3328
#define XB_TOPGEN   3392
#define XCD_BAR_WORDS 3456
#define XB_SPIN_CAP (1u << 18)

__device__ __forceinline__ unsigned xb_ld(unsigned* p)              { return __hip_atomic_load(p, __ATOMIC_RELAXED, __HIP_MEMORY_SCOPE_AGENT); }
__device__ __forceinline__ unsigned xb_add(unsigned* p, unsigned v) { return __hip_atomic_fetch_add(p, v, __ATOMIC_RELAXED, __HIP_MEMORY_SCOPE_AGENT); }
__device__ __forceinline__ unsigned xb_xcc_id() { return (unsigned)__builtin_amdgcn_s_getreg((3 << 11) | 20) & 0xFu; }
#define XB_SPIN(cond, bar) do { unsigned _sp = 0; while (cond) { __builtin_amdgcn_s_sleep(1); \
    if ((++_sp & 255u) == 0u) { if (xb_ld(&(bar)[XB_TMO])) break; if (_sp > XB_SPIN_CAP) { atomicAdd(&(bar)[XB_TMO], 1u); break; } } } } while (0)

struct XcdBarrier {
    unsigned* bar; unsigned x;
    volatile LAS unsigned* st;
};

__device__ __forceinline__ XcdBarrier xcd_barrier_post(unsigned* bar, volatile LAS unsigned* st) {
    XcdBarrier b; b.bar = bar; b.x = xb_xcc_id(); b.st = st;
    if (threadIdx.x == 0) (void)xb_add(&bar[XB_XCNT(b.x)], 1u);
    return b;
}
__device__ __forceinline__ void xcd_barrier_complete(unsigned* bar, unsigned x, unsigned& nloc, unsigned& nx) {
    const unsigned G = gridDim.x * gridDim.y * gridDim.z;
    unsigned sum, cnt, mine, sp = 0u;
    for (;;) {
        sum = 0u; cnt = 0u; mine = 0u;
#pragma unroll
        for (unsigned j = 0; j < 16; ++j) { const unsigned c = xb_ld(&bar[XB_XCNT(j)]); sum += c; cnt += (c > 0u) ? 1u : 0u; mine = (j == x) ? c : mine; }
        if (sum == G) break;
        __builtin_amdgcn_s_sleep(1);
        if ((++sp & 255u) == 0u) { if (xb_ld(&bar[XB_TMO])) break; if (sp > XB_SPIN_CAP) { atomicAdd(&bar[XB_TMO], 1u); break; } }
    }
    nloc = mine > 0u ? mine : 1u; nx = cnt > 0u ? cnt : 1u;
}

__device__ __forceinline__ void xcd_barrier(const XcdBarrier& b) {
    asm volatile("s_waitcnt vmcnt(0)" ::: "memory");
    __syncthreads();
    if (threadIdx.x == 0) {
        unsigned* bar = b.bar;
        __builtin_amdgcn_s_waitcnt(0);
        unsigned nloc = b.st[0], nx = b.st[1];
        if (nloc == 0u) { xcd_barrier_complete(bar, b.x, nloc, nx); b.st[0] = nloc; b.st[1] = nx; }
        const unsigned old = xb_add(&bar[XB_XSUB(b.x)], 1u);
        const unsigned gen = old / nloc;
        if (old + 1u == (gen + 1u) * nloc) {
            __builtin_amdgcn_fence(__ATOMIC_RELEASE, "agent");
            asm volatile("s_waitcnt vmcnt(0)" ::: "memory");
            const unsigned og = xb_add(&bar[XB_TOP], 1u);
            const unsigned tg = og / nx;
            if (og + 1u == (tg + 1u) * nx) xb_add(&bar[XB_TOPGEN], 1u);
            else XB_SPIN(xb_ld(&bar[XB_TOPGEN]) == tg, bar);
            __builtin_amdgcn_fence(__ATOMIC_ACQUIRE, "agent");
            xb_add(&bar[XB_XGEN(b.x)], 1u);
            asm volatile("s_waitcnt vmcnt(0)" ::: "memory");
        } else {
            XB_SPIN(xb_ld(&bar[XB_XGEN(b.x)]) == gen, bar);
            __builtin_amdgcn_fence(__ATOMIC_ACQUIRE, "agent");
            asm volatile("s_waitcnt vmcnt(0)" ::: "memory");
        }
    }
    __syncthreads();
}

constexpr int NWAVES = 8;
constexpr int D = 1024, NB = 16, SEQ = 2048, T = NB * SEQ, CTXL = 256, TC = NB * CTXL;
constexpr int QW = 512, KVW = 128, HYW = 512, INW = 4352, NE = 32, DFF = 1024;
constexpr float LN_EPS = 1e-5f;
constexpr float DN_ALPHA = 1.189207115002721f;
constexpr float LOG2E = 1.4426950408889634f;
constexpr float C2Q = 0.125f * LOG2E;
constexpr int NPH = 10;
#ifndef MK_N_LAUNCHES
#define MK_N_LAUNCHES 1
#endif
constexpr int N_LAUNCHES = MK_N_LAUNCHES;

constexpr size_t MiB = 1u << 20;
constexpr size_t WS_CTL = 0, CTL_ZERO_BYTES = 128 * 1024;
constexpr size_t WS_MODP = 1 * MiB;
constexpr size_t WS_MODF = 8 * MiB;
constexpr size_t WS_ROPE = 9 * MiB;
constexpr size_t WS_ASG = 10 * MiB;
constexpr size_t WS_GW = 10 * MiB + 512 * 1024;
constexpr size_t WS_TOK = 11 * MiB;
constexpr size_t WS_G = 16 * MiB;
constexpr size_t WS_WB = 24 * MiB;
constexpr size_t WS_WO = 26 * MiB;
constexpr size_t WS_WIN = 28 * MiB;
constexpr size_t WS_W1 = 40 * MiB;
constexpr size_t WS_W2 = 168 * MiB;
constexpr size_t WS_V1 = 232 * MiB;
constexpr size_t WS_HM = 360 * MiB;
constexpr size_t WS_HX = 424 * MiB;
constexpr size_t WS_Q = 496 * MiB;
constexpr size_t WS_K = 528 * MiB;
constexpr size_t WS_VT = 536 * MiB;
constexpr size_t WS_KC = 544 * MiB;
constexpr size_t WS_VTC = 545 * MiB;
constexpr size_t WS_UT = 546 * MiB;
constexpr size_t WS_GATE = 642 * MiB;
constexpr size_t WS_ATT = 770 * MiB;
constexpr size_t WS_HYT = 898 * MiB;
constexpr size_t WS_MM = 834 * MiB;
constexpr size_t WS_ACT = 424 * MiB;
constexpr size_t WS_YB = 696 * MiB;
constexpr size_t WS_END = 1024 * MiB;
static_assert(WS_ACT + (size_t)139264 * 2048 <= WS_YB && WS_YB + (size_t)139264 * 2048 <= WS_END && WS_MM + (size_t)T * 2048 <= WS_END, "d_ws map");
constexpr int CW_TMO = 0, CW_CODE = 1, CW_BAR = 4096, CW_CNT = 16384, CW_MOD = 16384 + 64;
static_assert((CW_MOD + 1) * 4 <= (int)CTL_ZERO_BYTES && (CW_BAR + 3456) <= CW_CNT, "control words inside the per-call memset");

constexpr int RING_BYTES = 131072;
constexpr int LDSCTL_OFF = 151552;
constexpr int MISC_OFF = LDSCTL_OFF + 320;
constexpr int TP_OFF = LDSCTL_OFF + 1024;
constexpr int LDS_BYTES = 155648;

typedef float f32x16 __attribute__((ext_vector_type(16)));
typedef float f32x2 __attribute__((ext_vector_type(2)));
typedef unsigned u32x2 __attribute__((ext_vector_type(2)));

struct Frame {
    unsigned long long pt0, ptacc;
    LAS unsigned char* lds;
    volatile LAS unsigned* MISC;
    gu32* ctl;
    int tid, lane, wave, vcu, G;
    const GAS float *x, *c, *ctx, *c_ctx, *w_mod, *b_mod, *w_in, *sink, *cw, *cb, *fw1, *fb1, *fw2, *fb2, *fw3, *skip, *w_ba, *w_bh, *w_out, *ln1g, *ln1b, *rw, *rb, *ew1, *eb1, *ew2, *eb2, *ln2g, *ln2b;
    GAS float* out;
    GAS float *modP, *modF, *rope, *gw; GAS bf16* V1;
    GAS int *asg, *tok;
    GAS bf16 *G_, *WB, *WO, *WIN, *W1, *W2, *HM, *HX, *Q, *K, *VT, *KC, *VTC, *UT, *GATE, *ATT, *MM, *ACT, *YB, *HYT;
};

template <int CTRL> __device__ __forceinline__ float dpp_f(float v) { return __builtin_bit_cast(float, __builtin_amdgcn_update_dpp(0, __builtin_bit_cast(int, v), CTRL, 0xF, 0xF, true)); }
__device__ __forceinline__ float wave_sum(float v) {
    v += dpp_f<0xB1>(v); v += dpp_f<0x4E>(v); v += dpp_f<0x141>(v); v += dpp_f<0x140>(v);
    { const unsigned u = __builtin_bit_cast(unsigned, v); auto r = __builtin_amdgcn_permlane16_swap(u, u, false, false); v = __builtin_bit_cast(float, (unsigned)r[0]) + __builtin_bit_cast(float, (unsigned)r[1]); }
    { const unsigned u = __builtin_bit_cast(unsigned, v); auto r = __builtin_amdgcn_permlane32_swap(u, u, false, false); v = __builtin_bit_cast(float, (unsigned)r[0]) + __builtin_bit_cast(float, (unsigned)r[1]); }
    return v;
}
__device__ __forceinline__ float wave_max(float v) {
    v = fmaxf(v, dpp_f<0xB1>(v)); v = fmaxf(v, dpp_f<0x4E>(v)); v = fmaxf(v, dpp_f<0x141>(v)); v = fmaxf(v, dpp_f<0x140>(v));
    { const unsigned u = __builtin_bit_cast(unsigned, v); auto r = __builtin_amdgcn_permlane16_swap(u, u, false, false); v = fmaxf(__builtin_bit_cast(float, (unsigned)r[0]), __builtin_bit_cast(float, (unsigned)r[1])); }
    { const unsigned u = __builtin_bit_cast(unsigned, v); auto r = __builtin_amdgcn_permlane32_swap(u, u, false, false); v = fmaxf(__builtin_bit_cast(float, (unsigned)r[0]), __builtin_bit_cast(float, (unsigned)r[1])); }
    return v;
}
__device__ __forceinline__ float bf2f(unsigned short h) { return __builtin_bit_cast(float, (unsigned)h << 16); }
__device__ __forceinline__ float bflo(unsigned w) { return __builtin_bit_cast(float, w << 16); }
__device__ __forceinline__ float bfhi(unsigned w) { return __builtin_bit_cast(float, w & 0xffff0000u); }
__device__ __forceinline__ float sigmoidf_(float x) { return __builtin_amdgcn_rcpf(1.f + __builtin_amdgcn_exp2f(-LOG2E * x)); }
__device__ __forceinline__ unsigned pk4_fp8(float a, float b, float c, float d) { int w = 0; w = __builtin_amdgcn_cvt_pk_fp8_f32(a, b, w, false); w = __builtin_amdgcn_cvt_pk_fp8_f32(c, d, w, true); return (unsigned)w; }

__device__ __forceinline__ void p0_mod_block(Frame& F, int cb) {
    const int lane = F.lane, w = F.wave;
    LAS float* scr = (LAS float*)(F.lds + w * 16384);
    LAS float* part = (LAS float*)(F.lds + 8704);
    float xs[17][2];
#pragma unroll
    for (int r = 0; r < 17; ++r) { const GAS float* src = r < 16 ? F.c + r * D : F.c_ctx; xs[r][0] = src[128 * w + lane]; xs[r][1] = src[128 * w + 64 + lane]; }
#pragma unroll
    for (int r = 0; r < 17; ++r) { scr[r * 128 + lane] = xs[r][0] / (1.f + __expf(-xs[r][0])); scr[r * 128 + 64 + lane] = xs[r][1] / (1.f + __expf(-xs[r][1])); }
    LDS_WAIT(); asm volatile("" ::: "memory");
    float acc[17];
#pragma unroll
    for (int r = 0; r < 17; ++r) acc[r] = 0.f;
    const GAS float* wp = F.w_mod + (size_t)(128 * w) * 6144 + 64 * cb + lane;
#pragma unroll 1
    for (int k0 = 0; k0 < 128; k0 += 64) { float wv[64];
#pragma unroll
        for (int k = 0; k < 64; ++k) wv[k] = wp[(size_t)(k0 + k) * 6144];
#pragma unroll
        for (int k = 0; k < 64; ++k) {
#pragma unroll
            for (int r = 0; r < 17; ++r) acc[r] += scr[r * 128 + k0 + k] * wv[k]; } }
#pragma unroll
    for (int r = 0; r < 17; ++r) part[w * 4096 + r * 64 + lane] = acc[r];
    __syncthreads();
    for (int i = F.tid; i < 17 * 64; i += NWAVES * 64) { const int r = i >> 6, c = i & 63; float sum = F.b_mod[64 * cb + c];
#pragma unroll
        for (int ww = 0; ww < 8; ++ww) sum += part[ww * 4096 + r * 64 + c];
        F.modF[r * 6144 + 64 * cb + c] = sum; }
    asm volatile("s_waitcnt vmcnt(0)" ::: "memory"); __syncthreads();
    if (F.tid == 0) { __builtin_amdgcn_fence(__ATOMIC_RELEASE, "agent"); asm volatile("s_waitcnt vmcnt(0)" ::: "memory"); __hip_atomic_fetch_add(F.ctl + CW_MOD, 1u, RLX_AGENT); }
    __syncthreads();
}
__device__ __forceinline__ void p0_filt_item(Frame& F, LAS float* scr, int g, int cb) {
    int lane = F.lane; asm volatile("" : "+v"(lane));
    LAS float* zf = scr; LAS float* h1 = scr + 8 * 36; LAS float* h2 = h1 + 8 * 64;
#pragma unroll
    for (int p = 0; p < 8; ++p) { const int j = 8 * g + p; const float om = (6.283185307179586f * (float)j) / 2048.f;
        if (lane < 16) { const float fk = 1e-4f + (float)lane * ((15.f - 1e-4f) / 15.f); zf[p * 36 + 1 + lane] = cosf(fk * om); }
        else if (lane < 32) { const float fk = 1e-4f + (float)(lane - 16) * ((15.f - 1e-4f) / 15.f); zf[p * 36 + 17 + (lane - 16)] = -sinf(fk * om); }
        else if (lane == 32) zf[p * 36] = (float)j / 2047.f; }
    LDS_WAIT(); asm volatile("" ::: "memory");
    {
        float w1c[33], w2c[64];
#pragma unroll
        for (int i = 0; i < 33; ++i) w1c[i] = F.fw1[i * 64 + lane];
#pragma unroll
        for (int i = 0; i < 64; ++i) w2c[i] = F.fw2[i * 64 + lane];
        const float bb1 = F.fb1[lane], bb2 = F.fb2[lane];
#pragma unroll
        for (int p = 0; p < 8; ++p) { float a = bb1;
#pragma unroll
            for (int i = 0; i < 33; ++i) a += zf[p * 36 + i] * w1c[i];
            h1[p * 64 + lane] = sinf(a); }
        LDS_WAIT(); asm volatile("" ::: "memory");
#pragma unroll
        for (int p = 0; p < 8; ++p) { float a = bb2;
#pragma unroll
            for (int i = 0; i < 64; ++i) a += h1[p * 64 + i] * w2c[i];
            h2[p * 64 + lane] = sinf(a); }
        LDS_WAIT(); asm volatile("" ::: "memory");
    }
    float o[8][4];
#pragma unroll
    for (int p = 0; p < 8; ++p)
#pragma unroll
        for (int q = 0; q < 4; ++q) o[p][q] = 0.f;
    const GAS float* w3 = F.fw3 + 256 * cb + lane;
#pragma unroll 1
    for (int i0 = 0; i0 < 64; i0 += 16) { float w[16][4];
#pragma unroll
        for (int i = 0; i < 16; ++i)
#pragma unroll
            for (int q = 0; q < 4; ++q) w[i][q] = w3[(size_t)(i0 + i) * 2048 + 64 * q];
#pragma unroll
        for (int i = 0; i < 16; ++i)
#pragma unroll
            for (int p = 0; p < 8; ++p) { const float hv = h2[p * 64 + i0 + i];
#pragma unroll
                for (int q = 0; q < 4; ++q) o[p][q] += hv * w[i][q]; } }
#pragma unroll
    for (int q = 0; q < 4; ++q) { const int col = 256 * cb + 64 * q + lane, oo = col >> 10, dir = (col >> 9) & 1, ch = col & 511;
        const float delta = 15.350567286626973f - (float)ch * (12.280453829301578f / 511.f);
        GAS bf16* gp = F.G_ + (size_t)(oo * 512 + ch) * 4096;
#pragma unroll
        for (int p = 0; p < 8; ++p) { const int j = 8 * g + p; const float val = o[p][q] * __expf(-((float)j / 2047.f) * delta);
            const int idx = dir ? 2048 + j : 2048 - j; if (!(dir && j == 0)) gp[idx] = (bf16)f2bf(val); }
        if (g == 0 && dir == 0) gp[0] = 0; }
    LDS_WAIT(); asm volatile("" ::: "memory");
}
constexpr int IT_IN = 16 * 136, IT_B = 8 * 32, IT_O = 16 * 32, IT_W1 = 32 * 16 * 64, IT_W2 = 32 * 16 * 32, NTR = IT_IN + 2 * IT_B + IT_O + IT_W1 + IT_W2;
struct TrItem { const GAS float* W; GAS bf16* WT; int N, Kp, drow, k0, n0, f8; };
__device__ __forceinline__ TrItem tr_decode(Frame& F, int r) {
    TrItem t; t.f8 = 0;
    if (r < IT_IN) { t.W = F.w_in; t.N = INW; t.WT = F.WIN; t.Kp = 1024; t.k0 = 64 * (r / 136); t.n0 = 32 * (r % 136); t.drow = t.n0; }
    else if ((r -= IT_IN) < IT_B) { t.W = F.w_ba; t.N = 1024; t.WT = F.WB; t.Kp = 512; t.k0 = 64 * (r / 32); t.n0 = 32 * (r % 32); t.drow = t.n0; }
    else if ((r -= IT_B) < IT_B) { t.W = F.w_bh; t.N = 1024; t.WT = F.WB + 1024 * 512; t.Kp = 512; t.k0 = 64 * (r / 32); t.n0 = 32 * (r % 32); t.drow = t.n0; }
    else if ((r -= IT_B) < IT_O) { t.W = F.w_out; t.N = 1024; t.WT = F.WO; t.Kp = 1024; t.k0 = 64 * (r / 32); t.n0 = 32 * (r % 32); t.drow = t.n0; }
    else if ((r -= IT_O) < IT_W1) { const int e = r >> 10, q = r & 1023; t.W = F.ew1 + (size_t)e * 1024 * 2048; t.N = 2048; t.WT = (GAS bf16*)((GAS unsigned char*)F.W1 + (size_t)e * 2048 * 1024); t.Kp = 1024; t.f8 = 1; t.k0 = 64 * (q >> 6); t.n0 = 32 * (q & 63);
        t.drow = t.n0 < 1024 ? (t.n0 >> 7) * 256 + (t.n0 & 127) : ((t.n0 - 1024) >> 7) * 256 + 128 + ((t.n0 - 1024) & 127); }
    else { r -= IT_W1; const int e = r >> 9, q = r & 511; t.W = F.ew2 + (size_t)e * 1024 * 1024; t.N = 1024; t.WT = (GAS bf16*)((GAS unsigned char*)F.W2 + (size_t)e * 1024 * 1024); t.Kp = 1024; t.f8 = 1; t.k0 = 64 * (q >> 5); t.n0 = 32 * (q & 31); t.drow = t.n0; }
    return t;
}
__device__ __forceinline__ void tr_load(const TrItem& t, int lane, f32x4 (&buf)[8]) {
    const GAS float* wp = t.W + (size_t)(t.k0 + (lane >> 3)) * t.N + t.n0 + 4 * (lane & 7);
#pragma unroll
    for (int i = 0; i < 8; ++i) buf[i] = __builtin_nontemporal_load((const GAS f32x4*)(wp + (size_t)(8 * i) * t.N));
}
__device__ __forceinline__ void tr_store(const TrItem& t, const f32x4 (&buf)[8], LAS float* scr, int lane) {
    const int kk = lane >> 3, c4 = lane & 7;
#pragma unroll
    for (int i = 0; i < 8; ++i) { LAS float* d = scr + (8 * i + kk) * 33 + 4 * c4; d[0] = buf[i][0]; d[1] = buf[i][1]; d[2] = buf[i][2]; d[3] = buf[i][3]; }
    LDS_WAIT(); asm volatile("" ::: "memory");
    const int c = lane & 7;
#pragma unroll
    for (int j = 0; j < 4; ++j) { const int n = (lane >> 3) + 8 * j; const LAS float* sp = scr + (8 * c) * 33 + n;
        if (t.f8) { u32x2 o; o.x = pk4_fp8(sp[0 * 33] * 256.f, sp[1 * 33] * 256.f, sp[2 * 33] * 256.f, sp[3 * 33] * 256.f); o.y = pk4_fp8(sp[4 * 33] * 256.f, sp[5 * 33] * 256.f, sp[6 * 33] * 256.f, sp[7 * 33] * 256.f);
            *(GAS u32x2*)((GAS unsigned char*)t.WT + (size_t)(t.drow + n) * t.Kp + t.k0 + 8 * c) = o; }
        else { v4u o; o.x = pk2(sp[0 * 33], sp[1 * 33]); o.y = pk2(sp[2 * 33], sp[3 * 33]); o.z = pk2(sp[4 * 33], sp[5 * 33]); o.w = pk2(sp[6 * 33], sp[7 * 33]);
            *(GAS v4u*)(t.WT + (size_t)(t.drow + n) * t.Kp + t.k0 + 8 * c) = o; } }
    LDS_WAIT(); asm volatile("" ::: "memory");
}
__device__ __forceinline__ void p1_rows(Frame& F);
__device__ __forceinline__ void p0_prologue(Frame& F) {
    LAS float* scr = (LAS float*)(F.lds + F.wave * 16384);
    const int gw = F.vcu * NWAVES + F.wave, NGW = F.G * NWAVES, lane = F.lane;
    constexpr int IT_FILT = 2048, IT_ROPE = 1, NSPEC = IT_FILT + IT_ROPE;
    if ((int)blockIdx.x < 96) p0_mod_block(F, (int)blockIdx.x);
    const bool spec_first = (F.wave & 1) != 0;
#define P0_SPECIAL() do { for (int it = gw; it < NSPEC; it += NGW) { int r = it; \
        if (r < IT_FILT) { p0_filt_item(F, scr, r >> 3, r & 7); continue; } \
        _Pragma("unroll 4") for (int i = 0; i < 16; ++i) { const int idx = lane * 16 + i, pos = idx >> 4, f = idx & 15; const float inv = exp2f(-(float)f * (13.287712379549449f / 16.f)); const float ang = (float)pos * inv; \
            F.rope[idx] = cosf(ang); F.rope[1024 + idx] = sinf(ang); } } } while (0)
    if (spec_first) P0_SPECIAL();
    if (gw < NTR) {
        int it = gw;
        TrItem c0 = tr_decode(F, it); f32x4 b0[8]; tr_load(c0, lane, b0);
        int i1 = it + NGW; bool h1 = i1 < NTR; TrItem c1 = tr_decode(F, h1 ? i1 : it); f32x4 b1[8]; tr_load(c1, lane, b1);
        for (;;) {
            const int i2 = i1 + NGW; const bool h2 = h1 && i2 < NTR;
            TrItem c2 = tr_decode(F, h2 ? i2 : it); f32x4 b2[8]; tr_load(c2, lane, b2);
            tr_store(c0, b0, scr, lane);
            if (!h1) break;
            c0 = c1; c1 = c2; it = i1; i1 = i2; h1 = h2;
#pragma unroll
            for (int i = 0; i < 8; ++i) { b0[i] = b1[i]; b1[i] = b2[i]; }
        }
    }
    if (!spec_first) P0_SPECIAL();
#undef P0_SPECIAL
    __syncthreads();
    if (F.wave == 0) { unsigned sp = 0;
        while ((unsigned)__builtin_amdgcn_readfirstlane(__hip_atomic_load(F.ctl + CW_MOD, RLX_AGENT)) < 96u) { __builtin_amdgcn_s_sleep(2); if (++sp > (1u << 22)) { if (F.lane == 0) __hip_atomic_store(F.ctl + CW_TMO, 1u, RLX_AGENT); break; } }
        __builtin_amdgcn_fence(__ATOMIC_ACQUIRE, "agent"); asm volatile("s_waitcnt vmcnt(0)" ::: "memory"); }
    __syncthreads();
    p1_rows(F);
}

template <int NR>
__device__ __forceinline__ void ln_mod_rows(const GAS float* const (&src)[NR], GAS bf16* const (&dst)[NR], const LAS float* const (&tS)[NR], const LAS float* const (&tB)[NR], int lane) {
    f32x4 v[NR][4]; float s[NR], s2[NR];
#pragma unroll
    for (int r = 0; r < NR; ++r) { const GAS f32x4* xr = (const GAS f32x4*)src[r] + lane;
#pragma unroll
        for (int j = 0; j < 4; ++j) v[r][j] = __builtin_nontemporal_load(xr + 64 * j); }
#pragma unroll
    for (int r = 0; r < NR; ++r) { s[r] = 0.f;
#pragma unroll
        for (int j = 0; j < 4; ++j) s[r] += (v[r][j].x + v[r][j].y) + (v[r][j].z + v[r][j].w); }
#pragma unroll
    for (int r = 0; r < NR; ++r) s[r] = wave_sum(s[r]) * (1.f / D);
#pragma unroll
    for (int r = 0; r < NR; ++r) { s2[r] = 0.f;
#pragma unroll
        for (int j = 0; j < 4; ++j) { v[r][j] = v[r][j] - s[r]; s2[r] += (v[r][j].x * v[r][j].x + v[r][j].y * v[r][j].y) + (v[r][j].z * v[r][j].z + v[r][j].w * v[r][j].w); } }
#pragma unroll
    for (int r = 0; r < NR; ++r) s2[r] = 1.f / sqrtf(wave_sum(s2[r]) * (1.f / D) + LN_EPS);
#pragma unroll
    for (int r = 0; r < NR; ++r)
#pragma unroll
        for (int j = 0; j < 4; ++j) { const int col = 4 * lane + 256 * j; const f32x4 sc = *(const LAS f32x4*)(tS[r] + col), sh = *(const LAS f32x4*)(tB[r] + col);
            const f32x4 o = v[r][j] * s2[r] * sc + sh; u32x2 w; w.x = pk2(o.x, o.y); w.y = pk2(o.z, o.w); *(GAS u32x2*)(dst[r] + col) = w; }
}
__device__ __forceinline__ void p1_rows(Frame& F) {
    LAS float* tA = (LAS float*)F.lds;
    for (int chunk = blockIdx.x; chunk < 256; chunk += F.G) {
        const int b = chunk >> 4;
        for (int i = F.tid; i < 4096; i += NWAVES * 64) { const int which = i >> 10, col = i & 1023, r = which < 2 ? b : 16, n = ((which & 1) ? 0 : 1024) + col;
            const float s = F.modF[r * 6144 + n]; tA[i] = (which & 1) ? s : 1.f + s; }
        __syncthreads();
#pragma unroll 1
        for (int g = 0; g < 6; ++g) {
            const GAS float* src[3]; GAS bf16* dst[3]; const LAS float* tS[3]; const LAS float* tB[3];
#pragma unroll
            for (int r = 0; r < 3; ++r) { const int rr = 3 * g + r;
                if (rr < 16) { const int row = chunk * 128 + F.wave * 16 + rr; src[r] = F.x + (size_t)row * D; dst[r] = F.HX + (size_t)row * D; tS[r] = tA; tB[r] = tA + 1024; }
                else { const int cr = chunk * 16 + F.wave * 2 + (rr - 16); src[r] = F.ctx + (size_t)cr * D; dst[r] = F.HX + (size_t)(T + cr) * D; tS[r] = tA + 2048; tB[r] = tA + 3072; } }
            ln_mod_rows<3>(src, dst, tS, tB, F.lane);
        }
        __syncthreads();
    }
}

using pg8::Unit; using pg8::f32x4; using pg8::cvt_pk_bf16;
struct SchedInProj {
    pg8::StaticOrder so; int G, c;
    __device__ __forceinline__ bool next(int i, Unit& u) const { const long L = (long)i * G + c; if (L < 2176) return so.next(i, u); if (L < 2192) { u.pm = 128 + (int)(L - 2176); u.pn = 2; return true; } return false; }
    __device__ __forceinline__ void a_ready(const Unit&) const {}
};
struct SchedPair {
    pg8::StaticOrder so;
    __device__ __forceinline__ bool next(int i, Unit& u) const { if (!so.next(i >> 1, u)) return false; if (i & 1) { u.pm += 128; u.pn += 4; } return true; }
    __device__ __forceinline__ void a_ready(const Unit&) const {}
};
struct SchedPlain { pg8::StaticOrder so;
    __device__ __forceinline__ bool next(int i, Unit& u) const { return so.next(i, u); }
    __device__ __forceinline__ void a_ready(const Unit&) const {}
};
struct SchedMoe {
    const LAS int* tp; const GAS int* tok; int nNl, G, c;
    __device__ __forceinline__ bool next(int i, Unit& u) const {
        pg8::StaticOrder so; so.init(__builtin_amdgcn_readfirstlane(tp[32]), nNl, G, c); if (!so.next(i, u)) return false;
        int e = 0;
        for (int k = 1; k < 32; ++k) e += (u.pm >= tp[k]) ? 1 : 0;
        u.pm = __builtin_amdgcn_readfirstlane(u.pm); u.pn = __builtin_amdgcn_readfirstlane(u.pn + e * nNl); return true; }
    __device__ __forceinline__ int rowoff(const Unit& u, int r) const { const int e = u.pn / nNl; int pos = (u.pm - tp[e]) * 256 + r; pos = pos < tp[33 + e] ? pos : 0; return tok[e * 32768 + pos]; }
    __device__ __forceinline__ void a_ready(const Unit&) const {}
};

struct EpiInProj {
    static constexpr bool PERM = true; static constexpr float S8 = 1.f;
    GAS bf16 *Q, *K, *VT, *KC, *VTC, *UT, *GATE; const GAS float* rope;
    __device__ __forceinline__ void operator()(const f32x4 (&acc)[2][2][4][2], const Unit& u, int wr, int wc, int fr, int fq) const {
        const int pn = u.pn; const bool isctx = u.pm >= 128;
#pragma unroll
        for (int ai = 0; ai < 2; ++ai)
#pragma unroll
            for (int m = 0; m < 4; ++m) {
                const int row = u.pm * 256 + ai * 128 + wr * 64 + m * 16 + fr;
                if (pn >= 9) {
#pragma unroll
                    for (int bj = 0; bj < 2; ++bj) { const int col = (pn - 9) * 256 + bj * 128 + wc * 32 + 8 * fq; const f32x4 v0 = acc[ai][bj][m][0] * S8, v1 = acc[ai][bj][m][1] * S8; v4u w;
                        w.x = cvt_pk_bf16(sigmoidf_(v0[0]), sigmoidf_(v0[1])); w.y = cvt_pk_bf16(sigmoidf_(v0[2]), sigmoidf_(v0[3])); w.z = cvt_pk_bf16(sigmoidf_(v1[0]), sigmoidf_(v1[1])); w.w = cvt_pk_bf16(sigmoidf_(v1[2]), sigmoidf_(v1[3]));
                        *(GAS v4u*)(GATE + (size_t)row * 2048 + col) = w; }
                } else if (pn >= 3) {
#pragma unroll
                    for (int bj = 0; bj < 2; ++bj) { const int ch = (pn - 3) * 256 + bj * 128 + wc * 32 + 8 * fq; GAS bf16* up = UT + (size_t)ch * T + row;
#pragma unroll
                        for (int n = 0; n < 2; ++n)
#pragma unroll
                            for (int j = 0; j < 4; ++j) up[(size_t)(4 * n + j) * T] = (bf16)f2bf(acc[ai][bj][m][n][j] * S8); }
                } else {
                    const int t = row & 2047;
                    const int pos = (wc & 1) ? (t & 63) : (t >> 6); const int f0 = 8 * (fq & 1); const bool hihalf = (fq >> 1) != 0;
#pragma unroll
                    for (int bj = 0; bj < 2; ++bj) {
                        if (pn == 2 && bj == 1) {
                            const int kvh = wc >> 1, d0 = (wc & 1) * 32 + 8 * fq;
                            GAS bf16* vp = isctx ? VTC + ((size_t)(((row - T) >> 8) * 2 + kvh) * 64 + d0) * 256 + ((row - T) & 255)
                                             : VT + ((size_t)((row >> 11) * 2 + kvh) * 64 + d0) * 2048 + t;
                            const int pitch = isctx ? 256 : 2048;
#pragma unroll
                            for (int n = 0; n < 2; ++n)
#pragma unroll
                                for (int j = 0; j < 4; ++j) vp[(size_t)(4 * n + j) * pitch] = (bf16)f2bf(acc[ai][bj][m][n][j] * S8);
                        } else {
                            f32x4 r[2];
#pragma unroll
                            for (int n = 0; n < 2; ++n) { const f32x4 own = acc[ai][bj][m][n] * S8; f32x4 oth;
#pragma unroll
                                for (int j = 0; j < 4; ++j) oth[j] = __shfl_xor(own[j], 32);
                                const f32x4 cs = *(const GAS f32x4*)(rope + pos * 16 + f0 + 4 * n), sn = *(const GAS f32x4*)(rope + 1024 + pos * 16 + f0 + 4 * n);
                                r[n] = hihalf ? own * cs + oth * sn : own * cs - oth * sn;
                                if (isctx) r[n] = own; }
                            if (pn < 2) { r[0] = r[0] * C2Q; r[1] = r[1] * C2Q; }
                            v4u w; w.x = cvt_pk_bf16(r[0][0], r[0][1]); w.y = cvt_pk_bf16(r[0][2], r[0][3]); w.z = cvt_pk_bf16(r[1][0], r[1][1]); w.w = cvt_pk_bf16(r[1][2], r[1][3]);
                            GAS bf16* dst = pn < 2 ? Q + (size_t)row * QW + pn * 256 + bj * 128 + wc * 32 + 8 * fq
                                               : (isctx ? KC + (size_t)(row - T) * KVW + wc * 32 + 8 * fq : K + (size_t)row * KVW + wc * 32 + 8 * fq);
                            *(GAS v4u*)dst = w;
                        }
                    }
                }
            }
    }
};
struct EpiMerge {
    static constexpr bool PERM = true;
    const GAS bf16* GATE; GAS bf16* MM;
    __device__ __forceinline__ void operator()(const f32x4 (&acc)[2][2][4][2], const Unit& u, int wr, int wc, int fr, int fq) const {
        const int which = u.pn >> 2, pnl = u.pn & 3, pml = u.pm & 127;
#pragma unroll
        for (int ai = 0; ai < 2; ++ai) {
            v4u g[4][2], p[4][2];
#pragma unroll
            for (int m = 0; m < 4; ++m)
#pragma unroll
                for (int bj = 0; bj < 2; ++bj) { const int row = pml * 256 + ai * 128 + wr * 64 + m * 16 + fr, col = pnl * 256 + bj * 128 + wc * 32 + 8 * fq;
                    g[m][bj] = *(const GAS v4u*)(GATE + (size_t)row * 2048 + which * 1024 + col); p[m][bj] = (v4u){0u, 0u, 0u, 0u}; }
            if (which) {
#pragma unroll
                for (int m = 0; m < 4; ++m)
#pragma unroll
                    for (int bj = 0; bj < 2; ++bj) { const int row = pml * 256 + ai * 128 + wr * 64 + m * 16 + fr, col = pnl * 256 + bj * 128 + wc * 32 + 8 * fq; p[m][bj] = *(const GAS v4u*)(MM + (size_t)row * 1024 + col); } }
#pragma unroll
            for (int m = 0; m < 4; ++m)
#pragma unroll
                for (int bj = 0; bj < 2; ++bj) { const int row = pml * 256 + ai * 128 + wr * 64 + m * 16 + fr, col = pnl * 256 + bj * 128 + wc * 32 + 8 * fq;
                    const v4u gg = g[m][bj], pp = p[m][bj]; const f32x4 v0 = acc[ai][bj][m][0], v1 = acc[ai][bj][m][1];
                    const float o0 = bflo(gg.x) * v0[0] + bflo(pp.x), o1 = bfhi(gg.x) * v0[1] + bfhi(pp.x), o2 = bflo(gg.y) * v0[2] + bflo(pp.y), o3 = bfhi(gg.y) * v0[3] + bfhi(pp.y);
                    const float o4 = bflo(gg.z) * v1[0] + bflo(pp.z), o5 = bfhi(gg.z) * v1[1] + bfhi(pp.z), o6 = bflo(gg.w) * v1[2] + bflo(pp.w), o7 = bfhi(gg.w) * v1[3] + bfhi(pp.w);
                    v4u w; w.x = cvt_pk_bf16(o0, o1); w.y = cvt_pk_bf16(o2, o3); w.z = cvt_pk_bf16(o4, o5); w.w = cvt_pk_bf16(o6, o7);
                    *(GAS v4u*)(MM + (size_t)row * 1024 + col) = w; }
        }
    }
};
struct EpiV1 {
    static constexpr bool PERM = false;
    const GAS float* x; const GAS float* modF; GAS bf16* V1;
    __device__ __forceinline__ void operator()(const f32x4 (&acc)[2][2][4][2], const Unit& u, int wr, int wc, int fr, int fq) const {
        const int col0 = u.pn * 256 + wc * 32 + 4 * fq; const int b = u.pm >> 3;
        f32x4 g1[2][2];
#pragma unroll
        for (int bj = 0; bj < 2; ++bj)
#pragma unroll
            for (int n = 0; n < 2; ++n) g1[bj][n] = *(const GAS f32x4*)(modF + b * 6144 + 2048 + col0 + bj * 128 + n * 16);
#pragma unroll
        for (int ai = 0; ai < 2; ++ai) {
            f32x4 xv[4][2][2];
#pragma unroll
            for (int m = 0; m < 4; ++m) { const size_t off = (size_t)(u.pm * 256 + ai * 128 + wr * 64 + m * 16 + fr) * D + col0;
#pragma unroll
                for (int bj = 0; bj < 2; ++bj)
#pragma unroll
                    for (int n = 0; n < 2; ++n) xv[m][bj][n] = *(const GAS f32x4*)(x + off + bj * 128 + n * 16); }
#pragma unroll
            for (int m = 0; m < 4; ++m) { const size_t off = (size_t)(u.pm * 256 + ai * 128 + wr * 64 + m * 16 + fr) * D + col0;
#pragma unroll
                for (int bj = 0; bj < 2; ++bj)
#pragma unroll
                    for (int n = 0; n < 2; ++n) { const f32x4 r = xv[m][bj][n] * DN_ALPHA + g1[bj][n] * acc[ai][bj][m][n]; u32x2 w; w.x = cvt_pk_bf16(r[0], r[1]); w.y = cvt_pk_bf16(r[2], r[3]); *(GAS u32x2*)(V1 + off + bj * 128 + n * 16) = w; } }
        }
    }
};
struct EpiAct {
    static constexpr bool PERM = true;
    const GAS float* b1; GAS bf16* ACT;
    __device__ __forceinline__ void operator()(const f32x4 (&acc)[2][2][4][2], const Unit& u, int wr, int wc, int fr, int fq) const {
        const int e = u.pn >> 3, pnl = u.pn & 7, colo = pnl * 128 + wc * 32 + 8 * fq;
        f32x4 bg[2], bl[2];
#pragma unroll
        for (int n = 0; n < 2; ++n) { bg[n] = *(const GAS f32x4*)(b1 + e * 2048 + colo + 4 * n); bl[n] = *(const GAS f32x4*)(b1 + e * 2048 + 1024 + colo + 4 * n); }
#pragma unroll
        for (int ai = 0; ai < 2; ++ai)
#pragma unroll
            for (int mp = 0; mp < 2; ++mp) { unsigned wx[2], wy[2];
#pragma unroll
                for (int q = 0; q < 2; ++q) { const int m = 2 * mp + q; float o[8];
#pragma unroll
                    for (int n = 0; n < 2; ++n)
#pragma unroll
                        for (int j = 0; j < 4; ++j) { float gl = acc[ai][0][m][n][j] * (1.f / 256.f) + bg[n][j], li = acc[ai][1][m][n][j] * (1.f / 256.f) + bl[n][j];
                            gl = fminf(gl, 7.f); li = fminf(fmaxf(li, -7.f), 7.f); o[4 * n + j] = gl * sigmoidf_(1.702f * gl) * (li + 1.f); }
                    wx[q] = pk4_fp8(o[0], o[1], o[2], o[3]); wy[q] = pk4_fp8(o[4], o[5], o[6], o[7]); }
                auto rx = __builtin_amdgcn_permlane16_swap(wx[0], wx[1], false, false); auto ry = __builtin_amdgcn_permlane16_swap(wy[0], wy[1], false, false);
                const v4u w = {(unsigned)rx[0], (unsigned)ry[0], (unsigned)rx[1], (unsigned)ry[1]};
                const int row = u.pm * 256 + ai * 128 + wr * 64 + (2 * mp + (fq & 1)) * 16 + fr;
                *(GAS v4u*)((GAS unsigned char*)ACT + (size_t)row * 1024 + colo - 8 * (fq & 1)) = w; }
    }
};
#ifndef ABL_EPI
#define ABL_EPI 0
#endif
struct EpiYb {
    static constexpr bool PERM = true;
    const GAS float* b2; GAS bf16* YB; int abl = 0;
    __device__ __forceinline__ void operator()(const f32x4 (&acc)[2][2][4][2], const Unit& u, int wr, int wc, int fr, int fq) const {
        const int e = u.pn >> 2, pnl = u.pn & 3;
#pragma unroll
        for (int bj = 0; bj < 2; ++bj) { const int col = pnl * 256 + bj * 128 + wc * 32 + 8 * fq;
            const f32x4 b0 = *(const GAS f32x4*)(b2 + e * 1024 + col), b1v = *(const GAS f32x4*)(b2 + e * 1024 + col + 4);
#pragma unroll
            for (int ai = 0; ai < 2; ++ai)
#pragma unroll
                for (int mp = 0; mp < 2; ++mp) { unsigned wx[2], wy[2];
#pragma unroll
                    for (int q = 0; q < 2; ++q) { const int m = 2 * mp + q; const f32x4 v0 = acc[ai][bj][m][0] * (1.f / 256.f) + b0, v1 = acc[ai][bj][m][1] * (1.f / 256.f) + b1v;
                        wx[q] = pk4_fp8(v0[0], v0[1], v0[2], v0[3]); wy[q] = pk4_fp8(v1[0], v1[1], v1[2], v1[3]); }
                    auto rx = __builtin_amdgcn_permlane16_swap(wx[0], wx[1], false, false); auto ry = __builtin_amdgcn_permlane16_swap(wy[0], wy[1], false, false);
                    const v4u w = {(unsigned)rx[0], (unsigned)ry[0], (unsigned)rx[1], (unsigned)ry[1]};
                    const int row = u.pm * 256 + ai * 128 + wr * 64 + (2 * mp + (fq & 1)) * 16 + fr;
                    *(GAS v4u*)((GAS unsigned char*)YB + (size_t)row * 1024 + col - 8 * (fq & 1)) = w; } }
    }
};
struct EpiYbW {
    static constexpr bool PERM = true, WIDE = true;
    const GAS float* b2; GAS bf16* YB; int abl = 0;
    __device__ __forceinline__ void operator()(const f32x4 (&acc)[2][2][4][2], const Unit& u, int wr, int wc, int fr, int fq) const {
        const int e = u.pn >> 2, pnl = u.pn & 3;
#pragma unroll
        for (int bj = 0; bj < 2; ++bj) { const int col = pnl * 256 + wc * 64 + bj * 32 + 8 * fq;
            f32x4 b0 = {0.f, 0.f, 0.f, 0.f}, b1v = {0.f, 0.f, 0.f, 0.f}; if (abl != 2) { b0 = *(const GAS f32x4*)(b2 + e * 1024 + col); b1v = *(const GAS f32x4*)(b2 + e * 1024 + col + 4); }
#pragma unroll
            for (int ai = 0; ai < 2; ++ai)
#pragma unroll
                for (int m = 0; m < 4; ++m) { const int row = u.pm * 256 + ai * 128 + wr * 64 + m * 16 + fr; const f32x4 v0 = acc[ai][bj][m][0] * (1.f / 256.f) + b0, v1 = acc[ai][bj][m][1] * (1.f / 256.f) + b1v;
                    u32x2 w; w.x = pk4_fp8(v0[0], v0[1], v0[2], v0[3]); w.y = pk4_fp8(v1[0], v1[1], v1[2], v1[3]);
                    if (abl != 1) *(GAS u32x2*)((GAS unsigned char*)YB + (size_t)row * 1024 + col) = w; else asm volatile("" :: "v"(w)); } }
    }
};

struct EpiYbX {
    static constexpr bool PERM = true;
    const GAS float* b2; GAS bf16* YB; int abl = 0;
    __device__ __forceinline__ void operator()(const f32x4 (&acc)[2][2][4][2], const Unit& u, int wr, int wc, int fr, int fq) const {
        const int e = u.pn >> 2, pnl = u.pn & 3;
#pragma unroll
        for (int bj = 0; bj < 2; ++bj) { const int col = pnl * 256 + bj * 128 + wc * 32 + 8 * fq;
            const f32x4 b0 = *(const GAS f32x4*)(b2 + e * 1024 + col), b1v = *(const GAS f32x4*)(b2 + e * 1024 + col + 4);
#pragma unroll
            for (int ai = 0; ai < 2; ++ai)
#pragma unroll
                for (int mp = 0; mp < 2; ++mp) { unsigned wx[2], wy[2];
#pragma unroll
                    for (int q = 0; q < 2; ++q) { const int m = 2 * mp + q; const f32x4 v0 = acc[ai][bj][m][0] * (1.f / 256.f) + b0, v1 = acc[ai][bj][m][1] * (1.f / 256.f) + b1v;
                        wx[q] = pk4_fp8(v0[0], v0[1], v0[2], v0[3]); wy[q] = pk4_fp8(v1[0], v1[1], v1[2], v1[3]); }
                    auto rx = __builtin_amdgcn_permlane16_swap(wx[0], wx[1], false, false); auto ry = __builtin_amdgcn_permlane16_swap(wy[0], wy[1], false, false);
                    const v4u o = {(unsigned)rx[0], (unsigned)ry[0], (unsigned)rx[1], (unsigned)ry[1]};
                    const int row = u.pm * 256 + ai * 128 + wr * 64 + (2 * mp + (fq & 1)) * 16 + fr;
                    *(GAS v4u*)((GAS unsigned char*)YB + (size_t)row * 1024 + col - 8 * (fq & 1)) = o; } }
    }
};


#define HPT_B(k) do { if (PROBE_SPIN == (k)) F.pt0 = rt(); } while (0)
#define HPT_E(k) do { if (PROBE_SPIN == (k)) F.ptacc += rt() - F.pt0; } while (0)
__device__ __forceinline__ int crow(int r, int hi) { return (r & 3) + 8 * (r >> 2) + 4 * hi; }
__device__ __forceinline__ void attn_step(const bool MASK, const LAS unsigned char* Kl, const LAS unsigned char* Vl, const int pitchV, const int kvoff, const bf16x8 (&qf)[2][4],
                                          float (&mrun)[2], float (&lrun)[2], f32x16 (&o)[2][2], const int r32, const int hi, const int dq0) {
    bf16x8 kf[4], vf[2][2];
#pragma unroll
    for (int ks = 0; ks < 4; ++ks) kf[ks] = *(const LAS bf16x8*)(Kl + (kvoff + r32) * 144 + ks * 32 + hi * 16);
#pragma unroll
    for (int dt = 0; dt < 2; ++dt)
#pragma unroll
        for (int s2 = 0; s2 < 2; ++s2) vf[dt][s2] = *(const LAS bf16x8*)(Vl + (32 * dt + r32) * pitchV + (kvoff + 16 * s2) * 2 + hi * 16);
#pragma unroll
    for (int qt = 0; qt < 2; ++qt) {
        f32x16 s = {0.f, 0.f, 0.f, 0.f, 0.f, 0.f, 0.f, 0.f, 0.f, 0.f, 0.f, 0.f, 0.f, 0.f, 0.f, 0.f};
#pragma unroll
        for (int ks = 0; ks < 4; ++ks) s = __builtin_amdgcn_mfma_f32_32x32x16_bf16(kf[ks], qf[qt][ks], s, 0, 0, 0);
        if (MASK) {
#pragma unroll
            for (int r = 0; r < 16; ++r) { const int dd = dq0 - 32 * qt + crow(r, hi); if (dd > 128 || dd < -128) s[r] = -INFINITY; }
        }
        float mx = fmaxf(fmaxf(s[0], s[1]), s[2]);
#pragma unroll
        for (int r = 3; r < 15; r += 2) mx = fmaxf(fmaxf(mx, s[r]), s[r + 1]);
        mx = fmaxf(mx, s[15]);
        { const unsigned u = __builtin_bit_cast(unsigned, mx); auto rr = __builtin_amdgcn_permlane32_swap(u, u, false, false); mx = fmaxf(__builtin_bit_cast(float, (unsigned)rr[0]), __builtin_bit_cast(float, (unsigned)rr[1])); }
        if (__any(mx > mrun[qt])) {
            const float mn = fmaxf(mrun[qt], mx), f = __builtin_amdgcn_exp2f(mrun[qt] - mn); mrun[qt] = mn; lrun[qt] *= f;
#pragma unroll
            for (int dt = 0; dt < 2; ++dt) o[qt][dt] = o[qt][dt] * f;
        }
        const float mn = mrun[qt];
        float ps = 0.f;
#pragma unroll
        for (int r = 0; r < 16; ++r) { const float p = __builtin_amdgcn_exp2f(s[r] - mn); s[r] = p; ps += p; }
        lrun[qt] += ps;
        bf16x8 pb[2];
#pragma unroll
        for (int s2 = 0; s2 < 2; ++s2) { v4u w; w.x = cvt_pk_bf16(s[8 * s2 + 0], s[8 * s2 + 1]); w.y = cvt_pk_bf16(s[8 * s2 + 2], s[8 * s2 + 3]); w.z = cvt_pk_bf16(s[8 * s2 + 4], s[8 * s2 + 5]); w.w = cvt_pk_bf16(s[8 * s2 + 6], s[8 * s2 + 7]);
            pb[s2] = __builtin_bit_cast(bf16x8, w); }
#pragma unroll
        for (int dt = 0; dt < 2; ++dt)
#pragma unroll
            for (int s2 = 0; s2 < 2; ++s2) o[qt][dt] = __builtin_amdgcn_mfma_f32_32x32x16_bf16(vf[dt][s2], pb[s2], o[qt][dt], 0, 0, 0);
    }
}
__device__ __forceinline__ void attn_unit(Frame& F, int b, int kvh, int qb) {
    LAS unsigned char* lds = F.lds;
    const int tid = F.tid, lane = F.lane, w = F.wave, r32 = lane & 31, hi = lane >> 5;
    const int h = kvh * 4 + (w >> 1), s0 = qb * 128, q0 = s0 + 64 * (w & 1);
    bf16x8 qf[2][4];
#pragma unroll
    for (int qt = 0; qt < 2; ++qt)
#pragma unroll
        for (int ks = 0; ks < 4; ++ks) qf[qt][ks] = *(const GAS bf16x8*)(F.Q + (size_t)(b * SEQ + q0 + 32 * qt + r32) * QW + h * 64 + 16 * ks + 8 * hi);
    float mrun[2] = {-INFINITY, -INFINITY}, lrun[2] = {0.f, 0.f};
    f32x16 o[2][2];
#pragma unroll
    for (int qt = 0; qt < 2; ++qt)
#pragma unroll
        for (int dt = 0; dt < 2; ++dt)
#pragma unroll
            for (int r = 0; r < 16; ++r) o[qt][dt][r] = 0.f;
    {
        HPT_B(30);
        LAS unsigned char* Kl = lds; LAS unsigned char* Vl = lds + 36864;
        v4u rk[4], rv[4];
#pragma unroll
        for (int i = 0; i < 4; ++i) { const int idx = tid + 512 * i; rk[i] = *(const GAS v4u*)(F.KC + (size_t)(b * CTXL + (idx >> 3)) * KVW + kvh * 64 + (idx & 7) * 8);
            rv[i] = *(const GAS v4u*)(F.VTC + (size_t)((b * 2 + kvh) * 64 + (idx >> 5)) * CTXL + (idx & 31) * 8); }
#pragma unroll
        for (int i = 0; i < 4; ++i) { const int idx = tid + 512 * i; *(LAS v4u*)(Kl + (idx >> 3) * 144 + (idx & 7) * 16) = rk[i]; { const int ch = idx & 31; LAS unsigned char* vd = Vl + (idx >> 5) * 528 + (ch >> 1) * 32 + (ch & 1) * 8; *(LAS u32x2*)vd = (u32x2){rv[i].x, rv[i].y}; *(LAS u32x2*)(vd + 16) = (u32x2){rv[i].z, rv[i].w}; } }
        __syncthreads(); HPT_E(30); HPT_B(31);
        for (int st = 0; st < 8; ++st) attn_step(false, Kl, Vl, 528, 32 * st, qf, mrun, lrun, o, r32, hi, 0);
        __syncthreads(); HPT_E(31);
    }
    {
        LAS unsigned char* Kl = lds; LAS unsigned char* Vl = lds + 55296; const int kbase = s0 - 128;
        HPT_B(32);
        v4u rk[6], rv[6];
#pragma unroll
        for (int i = 0; i < 6; ++i) { const int idx = tid + 512 * i; { const int row = idx >> 3, ch = idx & 7; int kp = kbase + row; kp = kp < 0 ? 0 : (kp >= SEQ ? SEQ - 1 : kp); rk[i] = *(const GAS v4u*)(F.K + (size_t)(b * SEQ + kp) * KVW + kvh * 64 + ch * 8); }
            { const int row = idx / 48, ch = idx % 48; int kp = kbase + 8 * ch; kp = kp < 0 ? 0 : (kp >= SEQ ? SEQ - 8 : kp); rv[i] = *(const GAS v4u*)(F.VT + (size_t)((b * 2 + kvh) * 64 + row) * SEQ + kp); } }
#pragma unroll
        for (int i = 0; i < 6; ++i) { const int idx = tid + 512 * i; *(LAS v4u*)(Kl + (idx >> 3) * 144 + (idx & 7) * 16) = rk[i]; { const int ch = idx % 48; LAS unsigned char* vd = Vl + (idx / 48) * 784 + (ch >> 1) * 32 + (ch & 1) * 8; *(LAS u32x2*)vd = (u32x2){rv[i].x, rv[i].y}; *(LAS u32x2*)(vd + 16) = (u32x2){rv[i].z, rv[i].w}; } }
        __syncthreads(); HPT_E(32); HPT_B(33);
        for (int st = 0; st < 10; ++st) { const int kp0 = q0 - 128 + 32 * st; if (kp0 < 0 || kp0 >= SEQ) continue;
            attn_step(st < 2 || st >= 8, Kl, Vl, 784, kp0 - kbase, qf, mrun, lrun, o, r32, hi, kp0 - q0 - r32); }
        __syncthreads();
    }
    HPT_E(33);
    const float sk = F.sink[h] * LOG2E;
#pragma unroll
    for (int qt = 0; qt < 2; ++qt) { float l = lrun[qt] + __shfl_xor(lrun[qt], 32); l += __builtin_amdgcn_exp2f(sk - mrun[qt]); const float inv = 1.f / l;
        GAS bf16* op = F.ATT + (size_t)(b * SEQ + q0 + 32 * qt + r32) * QW + h * 64;
#pragma unroll
        for (int dt = 0; dt < 2; ++dt)
#pragma unroll
            for (int rg = 0; rg < 4; ++rg) { u32x2 wv; wv.x = cvt_pk_bf16(o[qt][dt][4 * rg] * inv, o[qt][dt][4 * rg + 1] * inv); wv.y = cvt_pk_bf16(o[qt][dt][4 * rg + 2] * inv, o[qt][dt][4 * rg + 3] * inv);
                *(GAS u32x2*)(op + 32 * dt + 8 * rg + 4 * hi) = wv; } }
}

constexpr int HZ_PITCH = 4112, HG_OFF = 16 * HZ_PITCH  , HG_PITCH = 8224;
__device__ __forceinline__ void hy_load_filter(LAS unsigned char* GC, const GAS bf16* G, int tid) {
    const GAS v4u* gp = (const GAS v4u*)G;
    const v4u a = gp[tid]; v4u b = {0u, 0u, 0u, 0u}; if (tid < 511) b = gp[tid + 1];
    const unsigned w[8] = {a.x, a.y, a.z, a.w, b.x, b.y, b.z, b.w};
#pragma unroll
    for (int rho = 0; rho < 8; ++rho) { v4u o; unsigned t[4];
#pragma unroll
        for (int dd = 0; dd < 4; ++dd) { const int base = (rho >> 1) + dd; t[dd] = (rho & 1) ? __builtin_amdgcn_alignbit(w[base + 1 > 7 ? 7 : base + 1], w[base], 16) : w[base]; }
        o.x = t[0]; o.y = t[1]; o.z = t[2]; o.w = t[3];
        *(LAS v4u*)(GC + rho * HG_PITCH + tid * 16) = o; }
}
__device__ __forceinline__ f32x4 hy_short4(const GAS bf16* up, int t, float w0, float w1, float w2, float bs) {
    const u32x2 v = *(const GAS u32x2*)(up + t);
    const float u0 = bflo(v.x), u1 = bfhi(v.x), u2 = bflo(v.y), u3 = bfhi(v.y);
    const float um = t > 0 ? bf2f(up[t - 1]) : 0.f, up4 = t + 4 < SEQ ? bf2f(up[t + 4]) : 0.f;
    f32x4 r; r[0] = bs + w0 * um + w1 * u0 + w2 * u1; r[1] = bs + w0 * u0 + w1 * u1 + w2 * u2; r[2] = bs + w0 * u1 + w1 * u2 + w2 * u3; r[3] = bs + w0 * u2 + w1 * u3 + w2 * up4; return r;
}
__device__ __forceinline__ void hy_conv(const LAS unsigned char* Z, const LAS unsigned char* GC, int T0, int fr, int fq, f32x4 (&acc)[16]) {
    const int rho = (8 - (fr & 7)) & 7;
    const LAS unsigned char* gb = GC + rho * HG_PITCH + (2048 - fr + 8 * fq - rho - T0) * 2;
    const LAS unsigned char* zb = Z + fr * HZ_PITCH + fq * 16;
    bf16x8 W[16], Bf, nA0, nA1, nB;
#pragma unroll
    for (int m = 0; m < 16; ++m) { W[m] = *(const LAS bf16x8*)(gb + (-16 * m) * 2); acc[m] = (f32x4){0.f, 0.f, 0.f, 0.f}; }
    Bf = *(const LAS bf16x8*)zb;
    for (int jj = 0; jj < 8; ++jj) {
#pragma unroll
        for (int ji = 0; ji < 8; ++ji) {
            const int j = 8 * jj + ji, jn = j + 1 < 64 ? j + 1 : 63;
            nA0 = *(const LAS bf16x8*)(gb + (32 * jn) * 2); nA1 = *(const LAS bf16x8*)(gb + (32 * jn - 16) * 2); nB = *(const LAS bf16x8*)(zb + 64 * jn);
            __builtin_amdgcn_sched_barrier(0);
#pragma unroll
            for (int m = 0; m < 16; ++m) acc[m] = __builtin_amdgcn_mfma_f32_16x16x32_bf16(W[(m - 2 * ji) & 15], Bf, acc[m], 0, 0, 0);
            W[(-2 * (ji + 1)) & 15] = nA0; W[(1 - 2 * (ji + 1)) & 15] = nA1; Bf = nB;
        }
    }
}
__device__ __forceinline__ void hyena_channel(Frame& F, int c) {
    LAS unsigned char* Z = F.lds; LAS unsigned char* GC = F.lds + HG_OFF;
    const int tid = F.tid, lane = F.lane, fr = lane & 15, fq = lane >> 4, T0 = 256 * F.wave;
    HPT_B(13);
    { const int cv = 1024 + c; const float w0 = F.cw[cv], w1 = F.cw[1536 + cv], w2 = F.cw[3072 + cv], bs = F.cb[cv];
#pragma unroll 1
      for (int i0 = 0; i0 < 8; i0 += 4) {
      v4u raw[4]; unsigned short hm1[4], hp8[4];
#pragma unroll
      for (int i = 0; i < 4; ++i) { const int chunk = tid + 512 * (i0 + i), b = chunk >> 8, tc = (chunk & 255) * 8; const GAS bf16* up = F.UT + (size_t)cv * T + b * SEQ;
          raw[i] = *(const GAS v4u*)(up + tc); hm1[i] = tc > 0 ? up[tc - 1] : (unsigned short)0; hp8[i] = tc + 8 < SEQ ? up[tc + 8] : (unsigned short)0; }
#pragma unroll
      for (int i = 0; i < 4; ++i) { const int chunk = tid + 512 * (i0 + i), b = chunk >> 8, tc = (chunk & 255) * 8;
          float u[10]; u[0] = bf2f(hm1[i]); u[1] = bflo(raw[i].x); u[2] = bfhi(raw[i].x); u[3] = bflo(raw[i].y); u[4] = bfhi(raw[i].y); u[5] = bflo(raw[i].z); u[6] = bfhi(raw[i].z); u[7] = bflo(raw[i].w); u[8] = bfhi(raw[i].w); u[9] = bf2f(hp8[i]);
          float r[8];
#pragma unroll
          for (int k = 0; k < 8; ++k) r[k] = bs + w0 * u[k] + w1 * u[k + 1] + w2 * u[k + 2];
          v4u o; o.x = pk2(r[0], r[1]); o.y = pk2(r[2], r[3]); o.z = pk2(r[4], r[5]); o.w = pk2(r[6], r[7]);
          *(LAS v4u*)(Z + b * HZ_PITCH + tc * 2) = o; } } }
    hy_load_filter(GC, F.G_ + (size_t)c * 4096, tid);
    __syncthreads(); HPT_E(13);
    f32x4 acc[16];
    HPT_B(11); hy_conv(Z, GC, T0, fr, fq, acc); HPT_E(11);
    HPT_B(14);
    { const float w0 = F.cw[c], w1 = F.cw[1536 + c], w2 = F.cw[3072 + c], bs = F.cb[c], sk = F.skip[c]; const GAS bf16* up = F.UT + (size_t)c * T + fr * SEQ;
#pragma unroll
      for (int m = 0; m < 16; ++m) { int t = T0 + 16 * m + 4 * fq; asm volatile("" : "+v"(t)); const u32x2 zo = *(const LAS u32x2*)(Z + fr * HZ_PITCH + t * 2); const f32x4 xs = hy_short4(up, t, w0, w1, w2, bs);
          acc[m][0] = xs[0] * (acc[m][0] + sk * bflo(zo.x)); acc[m][1] = xs[1] * (acc[m][1] + sk * bfhi(zo.x)); acc[m][2] = xs[2] * (acc[m][2] + sk * bflo(zo.y)); acc[m][3] = xs[3] * (acc[m][3] + sk * bfhi(zo.y)); } }
    HPT_E(14); HPT_B(15);
    __syncthreads();
#pragma unroll
    for (int m = 0; m < 16; ++m) { const int t = T0 + 16 * m + 4 * fq; u32x2 wv; wv.x = pk2(acc[m][0], acc[m][1]); wv.y = pk2(acc[m][2], acc[m][3]); *(LAS u32x2*)(Z + fr * HZ_PITCH + t * 2) = wv; }
    hy_load_filter(GC, F.G_ + (size_t)(512 + c) * 4096, tid);
    __syncthreads(); HPT_E(15);
    HPT_B(11); hy_conv(Z, GC, T0, fr, fq, acc); HPT_E(11);
    HPT_B(12);
    { const int cx = 512 + c; const float w0 = F.cw[cx], w1 = F.cw[1536 + cx], w2 = F.cw[3072 + cx], bs = F.cb[cx], sk = F.skip[512 + c]; const GAS bf16* up = F.UT + (size_t)cx * T + fr * SEQ;
      GAS bf16* hp = F.HYT + (size_t)c * T + fr * SEQ;
#pragma unroll
      for (int m = 0; m < 16; ++m) { int t = T0 + 16 * m + 4 * fq; asm volatile("" : "+v"(t)); const u32x2 zo = *(const LAS u32x2*)(Z + fr * HZ_PITCH + t * 2); const f32x4 xs = hy_short4(up, t, w0, w1, w2, bs);
          u32x2 wv; wv.x = pk2(xs[0] * (acc[m][0] + sk * bflo(zo.x)), xs[1] * (acc[m][1] + sk * bfhi(zo.x))); wv.y = pk2(xs[2] * (acc[m][2] + sk * bflo(zo.y)), xs[3] * (acc[m][3] + sk * bfhi(zo.y)));
          *(GAS u32x2*)(hp + t) = wv; } }
    __syncthreads();
    HPT_E(12);
}

__device__ __forceinline__ void hyt_transpose(Frame& F) {
    LAS unsigned short* scr = (LAS unsigned short*)(F.lds + F.wave * 16384);
    const int gw = F.vcu * NWAVES + F.wave, NGW = F.G * NWAVES, lane = F.lane, tcx = lane & 7, r8 = lane >> 3;
    GAS bf16* HY = F.ATT + (size_t)T * QW;
    for (int it = gw; it < 4096; it += NGW) {
        const int cb = it & 7, tb = it >> 3;
        v4u raw[8];
#pragma unroll
        for (int i = 0; i < 8; ++i) raw[i] = *(const GAS v4u*)(F.HYT + (size_t)(64 * cb + r8 + 8 * i) * T + 64 * tb + 8 * tcx);
#pragma unroll
        for (int i = 0; i < 8; ++i) { const int ch = r8 + 8 * i; LAS unsigned short* d = scr + (8 * tcx) * 66 + ch;
            d[0 * 66] = (unsigned short)raw[i].x; d[1 * 66] = (unsigned short)(raw[i].x >> 16); d[2 * 66] = (unsigned short)raw[i].y; d[3 * 66] = (unsigned short)(raw[i].y >> 16);
            d[4 * 66] = (unsigned short)raw[i].z; d[5 * 66] = (unsigned short)(raw[i].z >> 16); d[6 * 66] = (unsigned short)raw[i].w; d[7 * 66] = (unsigned short)(raw[i].w >> 16); }
        LDS_WAIT(); asm volatile("" ::: "memory");
#pragma unroll
        for (int i = 0; i < 8; ++i) { const int t = r8 + 8 * i; const LAS unsigned* sp = (const LAS unsigned*)(scr + t * 66 + 8 * tcx);
            v4u o; o.x = sp[0]; o.y = sp[1]; o.z = sp[2]; o.w = sp[3];
            *(GAS v4u*)(HY + (size_t)(64 * tb + t) * HYW + 64 * cb + 8 * tcx) = o; }
        LDS_WAIT(); asm volatile("" ::: "memory");
    }
}

__device__ __forceinline__ void load_row16(const GAS bf16* base, int row, int lane, f32x4 (&v)[4]) {
    const GAS u32x2* vr = (const GAS u32x2*)(base + (size_t)row * D) + lane;
    u32x2 t[4];
#pragma unroll
    for (int j = 0; j < 4; ++j) t[j] = vr[64 * j];
#pragma unroll
    for (int j = 0; j < 4; ++j) v[j] = (f32x4){bflo(t[j].x), bfhi(t[j].x), bflo(t[j].y), bfhi(t[j].y)};
}
__device__ __forceinline__ void ln_inplace(f32x4 (&v)[4]) {
    float s = 0.f;
#pragma unroll
    for (int j = 0; j < 4; ++j) s += (v[j].x + v[j].y) + (v[j].z + v[j].w);
    const float mean = wave_sum(s) * (1.f / D); float s2 = 0.f;
#pragma unroll
    for (int j = 0; j < 4; ++j) { v[j] = v[j] - mean; s2 += (v[j].x * v[j].x + v[j].y * v[j].y) + (v[j].z * v[j].z + v[j].w * v[j].w); }
    const float rstd = 1.f / sqrtf(wave_sum(s2) * (1.f / D) + LN_EPS);
#pragma unroll
    for (int j = 0; j < 4; ++j) v[j] = v[j] * rstd;
}
typedef _Float16 f16x8 __attribute__((ext_vector_type(8)));
typedef _Float16 f16x4 __attribute__((ext_vector_type(4)));
__device__ __forceinline__ void ln_inplace4(f32x4 (&v)[4][4]) {
    float s[4], q[4];
#pragma unroll
    for (int r = 0; r < 4; ++r) { s[r] = 0.f;
#pragma unroll
        for (int j = 0; j < 4; ++j) s[r] += (v[r][j].x + v[r][j].y) + (v[r][j].z + v[r][j].w); }
#pragma unroll
    for (int r = 0; r < 4; ++r) s[r] = wave_sum(s[r]) * (1.f / D);
#pragma unroll
    for (int r = 0; r < 4; ++r) { q[r] = 0.f;
#pragma unroll
        for (int j = 0; j < 4; ++j) { v[r][j] = v[r][j] - s[r]; q[r] += (v[r][j].x * v[r][j].x + v[r][j].y * v[r][j].y) + (v[r][j].z * v[r][j].z + v[r][j].w * v[r][j].w); } }
#pragma unroll
    for (int r = 0; r < 4; ++r) q[r] = 1.f / sqrtf(wave_sum(q[r]) * (1.f / D) + LN_EPS);
#pragma unroll
    for (int r = 0; r < 4; ++r)
#pragma unroll
        for (int j = 0; j < 4; ++j) v[r][j] = v[r][j] * q[r];
}
__device__ __forceinline__ void p6_route(Frame& F) {
    constexpr int RP = 2064;
    LAS unsigned char* W16 = F.lds;
    LAS unsigned char* HT = F.lds + 32 * RP;
    LAS float* LG = (LAS float*)(F.lds + 64 * RP);
    LAS int* rec = (LAS int*)(F.lds + 64 * RP + 8192);
    LAS float* recg = (LAS float*)(F.lds + 64 * RP + 8192 + 2048);
    LAS int* lcnt = (LAS int*)(F.lds + 64 * RP + 8192 + 4096);
    LAS int* lbase = lcnt + 32;
    const int tid = F.tid, lane = F.lane, w = F.wave, fr = lane & 15, fq = lane >> 4;
    for (int i = tid; i < 32768; i += NWAVES * 64) { const int k = i >> 5, e = i & 31; *(LAS _Float16*)(W16 + e * RP + k * 2) = (_Float16)F.rw[i]; }
    if (tid < 32) lcnt[tid] = 0;
    __syncthreads();
    const float rbias = F.rb[lane & 31];
    const int mt = w & 1, nt = (w >> 1) & 1, kh = w >> 2;
    for (int chunk = blockIdx.x; chunk < 256; chunk += F.G) {
        const int b = chunk >> 4;
#pragma unroll 1
        for (int grp = 0; grp < 4; ++grp) {
            const int rg0 = chunk * 128 + grp * 32;
            {
                f32x4 v[4][4];
#pragma unroll
                for (int rr = 0; rr < 4; ++rr) load_row16(F.V1, rg0 + 4 * w + rr, lane, v[rr]);
                int lo = 4 * lane; asm volatile("" : "+v"(lo));
                ln_inplace4(v);
#pragma unroll
                for (int rr = 0; rr < 4; ++rr)
#pragma unroll
                    for (int j = 0; j < 4; ++j) v[rr][j] = v[rr][j] * *(const GAS f32x4*)(F.ln1g + lo + 256 * j) + *(const GAS f32x4*)(F.ln1b + lo + 256 * j);
                ln_inplace4(v);
#pragma unroll
                for (int rr = 0; rr < 4; ++rr) { const int rl = 4 * w + rr;
#pragma unroll
                    for (int j = 0; j < 4; ++j) { v[rr][j] = v[rr][j] * (*(const GAS f32x4*)(F.modF + b * 6144 + 4096 + lo + 256 * j) + 1.f) + *(const GAS f32x4*)(F.modF + b * 6144 + 3072 + lo + 256 * j);
                        *(GAS unsigned*)((GAS unsigned char*)F.HM + (size_t)(rg0 + rl) * D + 4 * lane + 256 * j) = pk4_fp8(v[rr][j].x, v[rr][j].y, v[rr][j].z, v[rr][j].w);
                        const f16x4 hv = {(_Float16)v[rr][j].x, (_Float16)v[rr][j].y, (_Float16)v[rr][j].z, (_Float16)v[rr][j].w};
                        *(LAS f16x4*)(HT + rl * RP + (4 * lane + 256 * j) * 2) = hv; } }
            }
            __syncthreads();
            {
                f32x4 acc = {0.f, 0.f, 0.f, 0.f};
                const LAS unsigned char* wp = W16 + (16 * nt + fr) * RP + (512 * kh + 8 * fq) * 2; const LAS unsigned char* hp = HT + (16 * mt + fr) * RP + (512 * kh + 8 * fq) * 2;
#pragma unroll 4
                for (int s2 = 0; s2 < 16; ++s2) acc = __builtin_amdgcn_mfma_f32_16x16x32_f16(*(const LAS f16x8*)(wp + 64 * s2), *(const LAS f16x8*)(hp + 64 * s2), acc, 0, 0, 0);
#pragma unroll
                for (int k = 0; k < 4; ++k) LG[(kh * 32 + 16 * mt + fr) * 32 + 16 * nt + 4 * fq + k] = acc[k];
            }
            __syncthreads();
#pragma unroll 1
            for (int i = 0; i < 4; ++i) { const int rl = 4 * w + i;
                float cur = LG[rl * 32 + (lane & 31)] + LG[(32 + rl) * 32 + (lane & 31)] + rbias;
                float tv[4]; int te[4];
#pragma unroll
                for (int k = 0; k < 4; ++k) { const float mx = wave_max(cur);
                    const unsigned long long mask = __ballot(cur == mx); const int src = __ffsll((long long)mask) - 1; te[k] = src & 31; tv[k] = mx; if ((lane & 31) == te[k]) cur = -INFINITY; }
                const float p1 = __expf(tv[1] - tv[0]), p2 = __expf(tv[2] - tv[0]), p3 = __expf(tv[3] - tv[0]), inv = 1.f / (1.f + p1 + p2 + p3);
                if (lane < 4) { const int es = lane == 0 ? te[0] : lane == 1 ? te[1] : lane == 2 ? te[2] : te[3]; const float gs = (lane == 0 ? 1.f : lane == 1 ? p1 : lane == 2 ? p2 : p3) * inv;
                    const int rc = grp * 32 + rl;
                    const int rank = __hip_atomic_fetch_add(lcnt + es, 1, __ATOMIC_RELAXED, __HIP_MEMORY_SCOPE_WORKGROUP);
                    rec[rc * 4 + lane] = es | (rank << 5); recg[rc * 4 + lane] = gs; }
            }
            __syncthreads();
        }
        if (tid < 32) { gu32* cp = F.ctl; asm volatile("" : "+s"(cp)); const int cnt = lcnt[tid]; lbase[tid] = cnt ? (int)__hip_atomic_fetch_add(cp + CW_CNT + tid, (unsigned)cnt, RLX_AGENT) : 0; }
        __syncthreads();
        { const int r = rec[tid], e = r & 31, pos = lbase[e] + (r >> 5), row = chunk * 128 + (tid >> 2);
          F.tok[e * 32768 + pos] = row; F.asg[row * 4 + (tid & 3)] = e * 32768 + pos; F.gw[row * 4 + (tid & 3)] = recg[tid]; }
        __syncthreads();
        if (tid < 32) lcnt[tid] = 0;
        __syncthreads();
    }
}
__device__ __forceinline__ void moe_tables(Frame& F) {
    LAS int* tp = (LAS int*)(F.lds + TP_OFF);
    if (F.tid < 32) { gu32* cp = F.ctl; asm volatile("" : "+s"(cp)); const int cnt = (int)__hip_atomic_load(cp + CW_CNT + F.tid, RLX_AGENT);
        tp[33 + F.tid] = cnt; tp[65 + F.tid] = (cnt + 255) >> 8; }
    __syncthreads();
    if (F.tid < 33) { int a = 0;
        for (int e = 0; e < 32; ++e) a += (e < F.tid) ? tp[65 + e] : 0;
        tp[F.tid] = a; }
    __syncthreads();
}

typedef int i32x4 __attribute__((ext_vector_type(4)));
__device__ __forceinline__ void p9_final(Frame& F) {
    const LAS int* tp = (const LAS int*)(F.lds + TP_OFF);
    const int lane = F.lane;
    f32x4 g1v[4], b1v[4], g2v[4], b2v[4];
#pragma unroll
    for (int j = 0; j < 4; ++j) { const int col = 4 * lane + 256 * j; g1v[j] = *(const GAS f32x4*)(F.ln1g + col); b1v[j] = *(const GAS f32x4*)(F.ln1b + col); g2v[j] = *(const GAS f32x4*)(F.ln2g + col); b2v[j] = *(const GAS f32x4*)(F.ln2b + col); }
    for (int chunk = blockIdx.x; chunk < 256; chunk += F.G) {
        const int b = chunk >> 4, row0 = chunk * 128 + F.wave * 16;
        f32x4 gm[4];
#pragma unroll
        for (int j = 0; j < 4; ++j) gm[j] = *(const GAS f32x4*)(F.modF + b * 6144 + 5120 + 4 * lane + 256 * j);
        f32x4 v[4]; i32x4 a = *(const GAS i32x4*)(F.asg + row0 * 4); f32x4 g = *(const GAS f32x4*)(F.gw + row0 * 4);
        load_row16(F.V1, row0, lane, v);
        for (int it = 0; it < 16; ++it) {
            const int row = row0 + it, rn = it < 15 ? row + 1 : row;
            unsigned y[4][4];
#pragma unroll
            for (int k = 0; k < 4; ++k) { const int e = a[k] >> 15, pos = a[k] & 32767; const GAS unsigned char* yp = (const GAS unsigned char*)F.YB + (size_t)(256 * tp[e] + pos) * D + 4 * lane;
#pragma unroll
                for (int j = 0; j < 4; ++j) y[k][j] = __builtin_nontemporal_load((const GAS unsigned*)(yp + 256 * j)); }
            f32x4 nv[4]; load_row16(F.V1, rn, lane, nv);
            const i32x4 na = *(const GAS i32x4*)(F.asg + rn * 4); const f32x4 ng = *(const GAS f32x4*)(F.gw + rn * 4);
            ln_inplace(v);
#pragma unroll
            for (int j = 0; j < 4; ++j) { f32x4 f = {0.f, 0.f, 0.f, 0.f};
#pragma unroll
                for (int k = 0; k < 4; ++k) { const f32x2 lo = __builtin_amdgcn_cvt_pk_f32_fp8((int)y[k][j], false), hi = __builtin_amdgcn_cvt_pk_f32_fp8((int)y[k][j], true); f[0] += g[k] * lo[0]; f[1] += g[k] * lo[1]; f[2] += g[k] * hi[0]; f[3] += g[k] * hi[1]; }
                v[j] = (v[j] * g1v[j] + b1v[j]) * DN_ALPHA + gm[j] * f; }
            ln_inplace(v);
#pragma unroll
            for (int j = 0; j < 4; ++j) __builtin_nontemporal_store(v[j] * g2v[j] + b2v[j], (GAS f32x4*)(F.out + (size_t)row * D + 4 * lane + 256 * j));
#pragma unroll
            for (int j = 0; j < 4; ++j) v[j] = nv[j];
            a = na; g = ng;
        }
    }
}

struct Args { const float* in[29]; float* out; unsigned char* ws; int ph_lo, ph_hi; };
__global__ void __launch_bounds__(NWAVES * 64, 2) mk_fwd(Args args) {
    extern __shared__ __attribute__((aligned(16))) unsigned char lds[];
    Frame F;
    F.lds = (LAS unsigned char*)lds;
    F.MISC = (volatile LAS unsigned*)(F.lds + MISC_OFF);
    F.tid = threadIdx.x; F.lane = F.tid & 63; F.wave = __builtin_amdgcn_readfirstlane(F.tid >> 6);
    F.G = gridDim.x; { const int bx = blockIdx.x; F.vcu = (F.G % 8 == 0) ? (bx % 8) * (F.G / 8) + bx / 8 : bx; }
    unsigned char* ws = args.ws;
    F.ctl = (gu32*)(ws + WS_CTL);
    F.x = (const GAS float*)args.in[0]; F.c = (const GAS float*)args.in[1]; F.ctx = (const GAS float*)args.in[2]; F.c_ctx = (const GAS float*)args.in[3]; F.w_mod = (const GAS float*)args.in[4]; F.b_mod = (const GAS float*)args.in[5]; F.w_in = (const GAS float*)args.in[6]; F.sink = (const GAS float*)args.in[7];
    F.cw = (const GAS float*)args.in[8]; F.cb = (const GAS float*)args.in[9]; F.fw1 = (const GAS float*)args.in[10]; F.fb1 = (const GAS float*)args.in[11]; F.fw2 = (const GAS float*)args.in[12]; F.fb2 = (const GAS float*)args.in[13]; F.fw3 = (const GAS float*)args.in[14]; F.skip = (const GAS float*)args.in[15];
    F.w_ba = (const GAS float*)args.in[16]; F.w_bh = (const GAS float*)args.in[17]; F.w_out = (const GAS float*)args.in[18]; F.ln1g = (const GAS float*)args.in[19]; F.ln1b = (const GAS float*)args.in[20]; F.rw = (const GAS float*)args.in[21]; F.rb = (const GAS float*)args.in[22];
    F.ew1 = (const GAS float*)args.in[23]; F.eb1 = (const GAS float*)args.in[24]; F.ew2 = (const GAS float*)args.in[25]; F.eb2 = (const GAS float*)args.in[26]; F.ln2g = (const GAS float*)args.in[27]; F.ln2b = (const GAS float*)args.in[28]; F.out = (GAS float*)args.out;
    F.modP = (GAS float*)(ws + WS_MODP); F.modF = (GAS float*)(ws + WS_MODF); F.rope = (GAS float*)(ws + WS_ROPE); F.gw = (GAS float*)(ws + WS_GW); F.V1 = (GAS bf16*)(ws + WS_V1);
    F.asg = (GAS int*)(ws + WS_ASG); F.tok = (GAS int*)(ws + WS_TOK);
    F.G_ = (GAS bf16*)(ws + WS_G); F.WB = (GAS bf16*)(ws + WS_WB); F.WO = (GAS bf16*)(ws + WS_WO); F.WIN = (GAS bf16*)(ws + WS_WIN); F.W1 = (GAS bf16*)(ws + WS_W1); F.W2 = (GAS bf16*)(ws + WS_W2);
    F.HM = (GAS bf16*)(ws + WS_HM); F.HX = (GAS bf16*)(ws + WS_HX); F.Q = (GAS bf16*)(ws + WS_Q); F.K = (GAS bf16*)(ws + WS_K); F.VT = (GAS bf16*)(ws + WS_VT); F.KC = (GAS bf16*)(ws + WS_KC); F.VTC = (GAS bf16*)(ws + WS_VTC);
    F.UT = (GAS bf16*)(ws + WS_UT); F.GATE = (GAS bf16*)(ws + WS_GATE); F.ATT = (GAS bf16*)(ws + WS_ATT); F.MM = (GAS bf16*)(ws + WS_MM); F.ACT = (GAS bf16*)(ws + WS_ACT); F.YB = (GAS bf16*)(ws + WS_YB); F.HYT = (GAS bf16*)(ws + WS_HYT);
    for (int u = F.tid; u < (LDS_BYTES - LDSCTL_OFF) / 4; u += NWAVES * 64) ((LAS unsigned*)(F.lds + LDSCTL_OFF))[u] = 0u;
    __syncthreads();
    XcdBarrier bar; bar.bar = (unsigned*)(F.ctl + CW_BAR); bar.x = 0; bar.st = nullptr;
    if (N_LAUNCHES == 1) bar = xcd_barrier_post((unsigned*)(F.ctl + CW_BAR), F.MISC + 8);
#define GRID_BAR() do { if (N_LAUNCHES == 1) { if (PROBE_SPIN == 20 || PROBE_SPIN == 21 + nbar_) pt0_ = rt(); xcd_barrier(bar); if (PROBE_SPIN == 20 || PROBE_SPIN == 21 + nbar_) ptacc_ += rt() - pt0_; ++nbar_; } } while (0)
    const int lo = args.ph_lo, hi = args.ph_hi;
#ifndef PHMASK
#define PHMASK 0x3ff
#endif
#define IN(k) (((PHMASK >> (k)) & 1) && lo <= (k) && (k) < hi)
#define BOTH(k) (IN(k) && IN((k) + 1))
#define FRESH() do { F.lane = pg8::lane_id_v(); F.tid = F.wave * 64 + F.lane; } while (0)
    const int bx = (int)blockIdx.x;
    unsigned long long pt0_ = 0, ptacc_ = 0; F.pt0 = 0; F.ptacc = 0; int nbar_ = 0;
#define PT_BEGIN(k) do { if (PROBE_SPIN == (k)) pt0_ = rt(); } while (0)
#define PT_END(k) do { if (PROBE_SPIN == (k)) ptacc_ += rt() - pt0_; } while (0)

    if (IN(0)) { FRESH(); PT_BEGIN(0); p0_prologue(F); if (IN(2)) GRID_BAR(); PT_END(0); }
    if (IN(2)) { FRESH();
        pg8::Gemm g{(const bf16*)F.HX, (const bf16*)F.WIN, 1024, F.wave}; SchedInProj S; S.so.init(128, 17, F.G, bx); S.G = F.G; S.c = bx;
        EpiInProj E{F.Q, F.K, F.VT, F.KC, F.VTC, F.UT, F.GATE, F.rope};
        PT_BEGIN(2); pg8::gemm_phase<EpiInProj, SchedInProj, true, false>(F.lds, g, S, E);
        if (BOTH(2)) GRID_BAR(); PT_END(2);
    }
    if (IN(3)) { FRESH();
        PT_BEGIN(3); for (int u = bx; u < 512; u += F.G) attn_unit(F, u >> 5, (u >> 4) & 1, u & 15); PT_END(3);
        FRESH(); PT_BEGIN(10); for (int ch = F.vcu; ch < 512; ch += F.G) hyena_channel(F, ch);
        if (BOTH(3)) GRID_BAR(); PT_END(10);
    }
    if (IN(4)) { FRESH();
        PT_BEGIN(4); hyt_transpose(F); GRID_BAR(); PT_END(4);
        pg8::Gemm g{(const bf16*)F.ATT, (const bf16*)F.WB, 512, F.wave}; SchedPair S; S.so.init(128, 4, F.G, bx);
        EpiMerge E{F.GATE, F.MM};
        PT_BEGIN(17); pg8::gemm_phase<EpiMerge, SchedPair, true, false>(F.lds, g, S, E);
        if (BOTH(4)) GRID_BAR(); PT_END(17);
    }
    if (IN(5)) { FRESH();
        pg8::Gemm g{(const bf16*)F.MM, (const bf16*)F.WO, 1024, F.wave}; SchedPlain S; S.so.init(128, 4, F.G, bx);
        EpiV1 E{F.x, F.modF, F.V1};
        PT_BEGIN(5); pg8::gemm_phase<EpiV1, SchedPlain, true, false>(F.lds, g, S, E);
        if (BOTH(5)) GRID_BAR(); PT_END(5);
    }
    if (IN(6)) { FRESH(); PT_BEGIN(6); p6_route(F); if (BOTH(6)) GRID_BAR(); PT_END(6); }
    if (IN(7)) { FRESH();
        moe_tables(F);
        pg8::Gemm g{(const bf16*)F.HM, (const bf16*)F.W1, 512, F.wave}; SchedMoe S{(const LAS int*)(F.lds + TP_OFF), F.tok, 8, F.G, bx};
        EpiAct E{F.eb1, F.ACT};
        PT_BEGIN(7); pg8::gemm_phase<EpiAct, SchedMoe, true, true, true>(F.lds, g, S, E);
        if (BOTH(7)) GRID_BAR(); PT_END(7);
    }
    if (IN(8)) { FRESH();
        moe_tables(F);
        pg8::Gemm g{(const bf16*)F.ACT, (const bf16*)F.W2, 512, F.wave}; SchedMoe S{(const LAS int*)(F.lds + TP_OFF), F.tok, 4, F.G, bx};
        EpiYb E{F.eb2, F.YB};
        PT_BEGIN(8); pg8::gemm_phase<EpiYb, SchedMoe, true, false, true>(F.lds, g, S, E);
        if (BOTH(8)) GRID_BAR(); PT_END(8);
    }
    if (IN(9)) { FRESH(); PT_BEGIN(9); moe_tables(F); p9_final(F); PT_END(9); }
#ifdef ABL_VAR
    if (IN(9)) { GRID_BAR(); FRESH();
#ifdef ABL_STAGGER
        { const unsigned long long t0s = rt(), dl = (unsigned long long)((bx >> 3) & 3) * ABL_STAGGER; while (rt() - t0s < dl) __builtin_amdgcn_s_sleep(4); }
#endif
        pg8::Gemm g{(const bf16*)F.ACT, (const bf16*)F.W2, 512, F.wave}; SchedMoe S{(const LAS int*)(F.lds + TP_OFF), F.tok, 4, F.G, bx};
#if defined(ABL_X16)
        EpiYbX E{F.eb2, F.YB, ABL_EPI};
        pg8::gemm_phase<EpiYbX, SchedMoe, true, false, true, ABL_VAR>(F.lds, g, S, E); }
#elif defined(ABL_WIDE)
        EpiYbW E{F.eb2, F.YB, ABL_EPI};
        pg8::gemm_phase<EpiYbW, SchedMoe, true, false, true, ABL_VAR>(F.lds, g, S, E); }
#else
        EpiYb E{F.eb2, F.YB, ABL_EPI};
        pg8::gemm_phase<EpiYb, SchedMoe, true, false, true, ABL_VAR>(F.lds, g, S, E); }
#endif
#endif
    if (PROBE_SPIN >= 0 && bx == 0) { const unsigned long long t0_ = rt(); const unsigned long long gacc_ = (PROBE_SPIN == 18 || PROBE_SPIN == 19) ? *(volatile LAS unsigned long long*)(F.lds + 153600) : 0ull; while (rt() - t0_ < ptacc_ + F.ptacc + gacc_) __builtin_amdgcn_s_sleep(8); }
#undef IN
#undef BOTH
#undef GRID_BAR
}

extern "C" void kernel_launch(void* const* d_in, const int* in_sizes, int n_in, void* d_out, int out_size, void* d_ws, size_t ws_size, hipStream_t stream) {
    static int grid = 0;
    if (grid == 0) {
        if (n_in != 29 || in_sizes[0] != T * D || out_size != T * D || ws_size < WS_END) { fprintf(stderr, "kernel_launch: unexpected shapes (n_in %d, in0 %d, out %d, ws %zu); nothing launched\n", n_in, n_in > 0 ? in_sizes[0] : -1, out_size, ws_size); grid = -1; return; }
        int dev = 0, cus = 0, per_cu = 0;
        if (hipGetDevice(&dev) != hipSuccess || hipDeviceGetAttribute(&cus, hipDeviceAttributeMultiprocessorCount, dev) != hipSuccess) { grid = -1; return; }
        if (hipFuncSetAttribute((const void*)mk_fwd, hipFuncAttributeMaxDynamicSharedMemorySize, LDS_BYTES) != hipSuccess) { fprintf(stderr, "kernel_launch: hipFuncSetAttribute failed\n"); grid = -1; return; }
        if (hipOccupancyMaxActiveBlocksPerMultiprocessor(&per_cu, (const void*)mk_fwd, NWAVES * 64, LDS_BYTES) != hipSuccess || per_cu < 1) { fprintf(stderr, "kernel_launch: occupancy query reports %d workgroups per CU\n", per_cu); }
        (void)hipGetLastError();
        grid = cus < 256 ? cus : 256;
    }
    if (grid < 0) return;
    if (hipMemsetAsync((char*)d_ws + WS_CTL, 0, CTL_ZERO_BYTES, stream) != hipSuccess) return;
    Args a{};
    for (int i = 0; i < 29; ++i) a.in[i] = (const float*)d_in[i];
    a.out = (float*)d_out; a.ws = (unsigned char*)d_ws;
    if (N_LAUNCHES == 1) { a.ph_lo = 0; a.ph_hi = NPH; hipLaunchKernelGGL(mk_fwd, dim3(grid), dim3(NWAVES * 64), LDS_BYTES, stream, a); }
    else for (int p = 0; p < NPH; ++p) { a.ph_lo = p; a.ph_hi = p + 1; hipLaunchKernelGGL(mk_fwd, dim3(grid), dim3(NWAVES * 64), LDS_BYTES, stream, a); }
}
```

```cpp
#include <hip/hip_runtime.h>
#include <cstdio>
#include <cstdint>
#include <cmath>
namespace pg8 {
#define PG8_LAS __attribute__((address_space(3)))
typedef unsigned short bf16_t;
typedef short bf16x8 __attribute__((ext_vector_type(8)));
typedef float f32x4 __attribute__((ext_vector_type(4)));
typedef unsigned u32x4 __attribute__((ext_vector_type(4)));
constexpr int BM = 256, BK = 64, HALF = 128, HTB = HALF * BK * 2  , STAGE_BYTES = 8 * HTB, NXCD = 8, WGM = 8;

__host__ __device__ __forceinline__ int lds_byte(int r, int c) { const int st = (r >> 4) * 2 + (c >> 5), rr = r & 15, cc = c & 31, ob = rr * 64 + cc * 2; return st * 1024 + (ob ^ (((ob >> 9) & 1) << 5)); }
__host__ __device__ __forceinline__ void stage_rc(int b, int& R, int& C) { const int st = b / 1024, sb = b % 1024, swz = sb ^ (((sb >> 9) & 1) << 5); R = (st >> 1) * 16 + swz / 64; C = (st & 1) * 32 + (swz % 64) / 2; }
__host__ __device__ __forceinline__ int perm32(int rho) { const int n = rho >> 4, i = rho & 15; return 8 * (i >> 2) + 4 * n + (i & 3); }

struct Unit { int pm, pn; };
struct Gemm { const bf16_t* A; const bf16_t* Bt; int K; int wave; };

struct StaticOrder {
    int nM, nN, nwg, G, c, wgm = WGM;
    __host__ __device__ void init(int nM_, int nN_, int G_, int c_) { nM = nM_; nN = nN_; nwg = nM * nN; G = G_; c = c_; }
    __host__ __device__ bool next(int i, Unit& u) const {
        const long L = (long)i * G + c; if (L >= nwg) return false;
        int wgid = (int)L; { const int q = nwg / NXCD, r = nwg % NXCD, xcd = wgid % NXCD, off = wgid / NXCD; wgid = (xcd < r ? xcd * (q + 1) : r * (q + 1) + (xcd - r) * q) + off; }
        const int nig = wgm * nN, gid = wgid / nig, fm = gid * wgm, gsz = (nM - fm) < wgm ? (nM - fm) : wgm;
        u.pm = fm + ((wgid % nig) % gsz); u.pn = (wgid % nig) / gsz; return true;
    }
};

typedef float f32x2_cv __attribute__((ext_vector_type(2))); typedef __bf16 bf16x2_cv __attribute__((ext_vector_type(2)));
__device__ __forceinline__ unsigned cvt_pk_bf16(float lo, float hi) { const f32x2_cv v = {lo, hi}; const bf16x2_cv b = __builtin_convertvector(v, bf16x2_cv); return __builtin_bit_cast(unsigned, b); }

__device__ __forceinline__ int lane_id_v() { int l; asm volatile("v_mbcnt_lo_u32_b32 %0, -1, 0\n\tv_mbcnt_hi_u32_b32 %0, -1, %0" : "=v"(l)); return l; }
typedef int i32x4_t __attribute__((ext_vector_type(4)));
typedef int i32x8_t __attribute__((ext_vector_type(8)));
__device__ __forceinline__ i32x8_t cat8(bf16x8 lo, bf16x8 hi) { const i32x4_t a = __builtin_bit_cast(i32x4_t, lo), b = __builtin_bit_cast(i32x4_t, hi); return __builtin_shufflevector(a, b, 0, 1, 2, 3, 4, 5, 6, 7); }
#ifndef PROBE_SPIN
#define PROBE_SPIN -1
#endif
#define PG8_PT_B(k) do { if (PROBE_SPIN == (k) && FP8 && !GATHER && tid == 0) pt_t0 = __builtin_amdgcn_s_memrealtime(); } while (0)
#define PG8_PT_E(k) do { if (PROBE_SPIN == (k) && FP8 && !GATHER && tid == 0) *(volatile PG8_LAS unsigned long long*)(lds + 153600) += __builtin_amdgcn_s_memrealtime() - pt_t0; } while (0)
template <class E, class = void> struct epi_wide { static constexpr bool value = false; };
template <class E> struct epi_wide<E, decltype((void)E::WIDE)> { static constexpr bool value = E::WIDE; };
template <class E, class = void> struct epi_tr { static constexpr bool value = false; };
template <class E> struct epi_tr<E, decltype((void)E::TR)> { static constexpr bool value = E::TR; };
template <class Epi, class Sched, bool ALIGN_EPI, bool GATHER, bool FP8 = false, int VAR = 0>
__device__ __forceinline__ void gemm_phase(PG8_LAS unsigned char* lds, const Gemm g, const Sched& S, const Epi& E) {
    const int wid = g.wave, lane = lane_id_v(), tid = wid * 64 + lane, wr = wid >> 2, wc = wid & 3, fr = lane & 15, fq = lane >> 4;
    const int K = g.K, nt = K / BK;
    unsigned voffA[2], voffB[2]; int gR[2]; unsigned gC[2];
    constexpr bool WIDE = epi_wide<Epi>::value, TR = epi_tr<Epi>::value;
#pragma unroll
    for (int i = 0; i < 2; ++i) { int R, C; stage_rc(tid * 16 + i * 8192, R, C); const int Rb = WIDE ? (64 * (R >> 5) + perm32(R & 31)) : (Epi::PERM ? ((R & ~31) + perm32(R & 31)) : R);
        voffA[i] = (unsigned)(R * K + C) * 2u; voffB[i] = (unsigned)(Rb * K + C) * 2u; gR[i] = R; gC[i] = (unsigned)C * 2u; }
    const size_t kstep = (size_t)(BK * 2);
    const size_t hstep = (size_t)HALF * K * 2;
    const size_t tstep = 2 * hstep;
    const size_t r64 = (size_t)64 * K * 2;
    const size_t hstepB = WIDE ? (size_t)32 * K * 2 : hstep, r64B = WIDE ? (size_t)128 * K * 2 : r64;
    const unsigned ldsw = (unsigned)wid * 1024u;
    const int aoff = lds_byte(wr * 64 + fr, fq * 8), boff = lds_byte(wc * 32 + fr, fq * 8);
#define PG8_SA(b, h) (((b) * 2 + (h)) * HTB)
#define PG8_SB(b, h) ((4 + (b) * 2 + (h)) * HTB)
#define PG8_STAGE(bufoff, gbase, voff) do { if constexpr (VAR != 2 && VAR != 5 && VAR != 6) _Pragma("unroll") for (int _i = 0; _i < 2; ++_i) { unsigned v_ = (voff)[0]; if constexpr (FP8 && GATHER) asm volatile("" : "+v"(v_)); \
        __builtin_amdgcn_global_load_lds((const unsigned*)((const char*)(gbase) + (size_t)_i * r64 + v_), (PG8_LAS unsigned*)(lds + (bufoff) + ldsw + _i * 8192), 16, 0, 0); } } while (0)
#define PG8_STAGE_B(bufoff, gbase) do { if constexpr (VAR != 2 && VAR != 5 && VAR != 6) _Pragma("unroll") for (int _i = 0; _i < 2; ++_i) { unsigned v_ = voffB[0]; if constexpr (FP8 && GATHER) asm volatile("" : "+v"(v_)); \
        __builtin_amdgcn_global_load_lds((const unsigned*)((const char*)(gbase) + (size_t)_i * r64B + v_), (PG8_LAS unsigned*)(lds + (bufoff) + ldsw + _i * 8192), 16, 0, 0); } } while (0)
#define PG8_STAGE_G(bufoff, gbase, pk) do { if constexpr (VAR != 2) _Pragma("unroll") for (int _i = 0; _i < 2; ++_i) { unsigned p_ = (pk); asm volatile("" : "+v"(p_));   \
        __builtin_amdgcn_global_load_lds((const unsigned*)((const char*)(gbase) + (((p_ >> (16 * _i)) & 0xffffu) * (unsigned)(K * 2) + gC[0])), (PG8_LAS unsigned*)(lds + (bufoff) + ldsw + _i * 8192), 16, 0, 0); } } while (0)
#define PG8_STAGE_A(b, h, kp, VS) do { if constexpr (GATHER) { PG8_STAGE_G(PG8_SA(b, h), (kp), VS[h]); } else { PG8_STAGE(PG8_SA(b, h), (kp) + (size_t)(h) * hstep, voffA); } } while (0)
#define PG8_LDA(dst, b, h) do { if constexpr (VAR != 1 && VAR != 5 && VAR != 6) _Pragma("unroll") for (int m = 0; m < 4; ++m) { if constexpr (FP8) { dst##8[m] = __builtin_shufflevector(*(const PG8_LAS i32x4_t*)(lds + PG8_SA(b, h) + aoff + m * 2048), *(const PG8_LAS i32x4_t*)(lds + PG8_SA(b, h) + aoff + m * 2048 + 1024), 0, 1, 2, 3, 4, 5, 6, 7); } \
        else { _Pragma("unroll") for (int k = 0; k < 2; ++k) dst[m][k] = *(const PG8_LAS bf16x8*)(lds + PG8_SA(b, h) + aoff + m * 2048 + k * 1024); } } } while (0)
#define PG8_LDB(dst, b, h) do { if constexpr (VAR != 1 && VAR != 5 && VAR != 6) _Pragma("unroll") for (int n = 0; n < 2; ++n) { if constexpr (FP8) { dst##8[n] = __builtin_shufflevector(*(const PG8_LAS i32x4_t*)(lds + PG8_SB(b, h) + boff + n * 2048), *(const PG8_LAS i32x4_t*)(lds + PG8_SB(b, h) + boff + n * 2048 + 1024), 0, 1, 2, 3, 4, 5, 6, 7); } \
        else { _Pragma("unroll") for (int k = 0; k < 2; ++k) dst[n][k] = *(const PG8_LAS bf16x8*)(lds + PG8_SB(b, h) + boff + n * 2048 + k * 1024); } } } while (0)
#define PG8_MMA(ai, bj, At, Bt) do { if constexpr (VAR != 4) __builtin_amdgcn_s_setprio(1); if constexpr (VAR == 3 || VAR == 5 || VAR == 6) { _Pragma("unroll") for (int m_ = 0; m_ < 4; ++m_) { if constexpr (FP8) asm volatile("" :: "v"(At##8[m_])); } _Pragma("unroll") for (int n_ = 0; n_ < 2; ++n_) { if constexpr (FP8) asm volatile("" :: "v"(Bt##8[n_])); } } if constexpr (VAR != 3 && VAR != 5 && VAR != 6) _Pragma("unroll") for (int m = 0; m < 4; ++m) _Pragma("unroll") for (int n = 0; n < 2; ++n) { \
        if constexpr (FP8) { acc[ai][bj][m][n] = __builtin_amdgcn_mfma_scale_f32_16x16x128_f8f6f4(Bt##8[n], At##8[m], acc[ai][bj][m][n], 0, 0, 0, 0, 0, 0); } \
        else if constexpr (TR) { _Pragma("unroll") for (int k = 0; k < 2; ++k) acc[ai][bj][m][n] = __builtin_amdgcn_mfma_f32_16x16x32_bf16(At[m][k], Bt[n][k], acc[ai][bj][m][n], 0, 0, 0); } \
        else { _Pragma("unroll") for (int k = 0; k < 2; ++k) acc[ai][bj][m][n] = __builtin_amdgcn_mfma_f32_16x16x32_bf16(Bt[n][k], At[m][k], acc[ai][bj][m][n], 0, 0, 0); } } if constexpr (VAR != 4) __builtin_amdgcn_s_setprio(0); } while (0)
#define PG8_WAIT_V(n) asm volatile("s_waitcnt vmcnt(" #n ")" ::: "memory")
#define PG8_WAIT_V8_SKIPPABLE do { if (!(VAR == 10 && ui > 0 && t == 0)) asm volatile("s_waitcnt vmcnt(8)" ::: "memory"); } while (0)
#define PG8_WAIT_L(n) asm volatile("s_waitcnt lgkmcnt(" #n ")" ::: "memory")
#define PG8_BAR do { if constexpr (VAR != 6) __builtin_amdgcn_s_barrier(); } while (0)
#define PG8_SCHED __builtin_amdgcn_sched_barrier(0)
    unsigned long long pt_t0 = 0;
    Unit cur, nxt; int ui = 0;
    if (!S.next(0, cur)) return;
    f32x4 acc[2][2][4][2];
#pragma unroll
    for (int a = 0; a < 2; ++a)
#pragma unroll
        for (int b = 0; b < 2; ++b)
#pragma unroll
            for (int m = 0; m < 4; ++m)
#pragma unroll
                for (int n = 0; n < 2; ++n) acc[a][b][m][n] = (f32x4){0.f, 0.f, 0.f, 0.f};
    bf16x8 At[4][2] = {}, B0[2][2] = {}, B1[2][2] = {}; i32x8_t At8[4] = {}, B08[2] = {}, B18[2] = {};
    unsigned vAc[2];
    const char* cA = GATHER ? (const char*)g.A : (const char*)g.A + (size_t)cur.pm * tstep; const char* cB = (const char*)g.Bt + (size_t)cur.pn * tstep;
    if constexpr (GATHER) {
#pragma unroll
        for (int h = 0; h < 2; ++h) vAc[h] = (unsigned)S.rowoff(cur, h * HALF + gR[0]) | ((unsigned)S.rowoff(cur, h * HALF + gR[0] + 64) << 16);
    }
    PG8_STAGE_B(PG8_SB(0, 0), cB); PG8_STAGE_B(PG8_SB(0, 1), cB + hstepB); PG8_STAGE_A(0, 0, cA, vAc); PG8_STAGE_A(0, 1, cA, vAc);
    if (wr == 1) PG8_BAR;
    PG8_WAIT_V(2); PG8_BAR;
    PG8_STAGE_B(PG8_SB(1, 0), cB + kstep); PG8_STAGE_A(1, 0, cA + kstep, vAc); PG8_STAGE_B(PG8_SB(1, 1), cB + hstepB + kstep);
    PG8_WAIT_V(6); PG8_BAR;
    for (;;) {
        const bool has_next = S.next(ui + 1, nxt);
        const char* nA = GATHER ? cA : (has_next ? (const char*)g.A + (size_t)nxt.pm * tstep : cA); const char* nB = has_next ? (const char*)g.Bt + (size_t)nxt.pn * tstep : cB;
        int gr0 = 0, gr1 = 0, gr2 = 0, gr3 = 0;
        if constexpr (GATHER) {
            const int t_ = wid * 64 + lane_id_v(); int R_, C_; stage_rc(t_ * 16, R_, C_);
            if (has_next) { gr0 = S.rowoff(nxt, R_); gr1 = S.rowoff(nxt, R_ + 64); gr2 = S.rowoff(nxt, HALF + R_); gr3 = S.rowoff(nxt, HALF + R_ + 64); }
        }
#pragma unroll 1
        for (int t = 0; t < nt; t += 2) {
            const bool last = (t == nt - 2);
            const char* a1 = cA + (size_t)(t + 1) * kstep;
            const char* a2 = last ? nA : cA + (size_t)(t + 2) * kstep; const char* b2 = last ? nB : cB + (size_t)(t + 2) * kstep;
            const char* a3 = a2 + kstep; const char* b3 = b2 + kstep;
            PG8_LDB(B0, 0, 0); PG8_LDB(B1, 0, 1); PG8_SCHED; PG8_LDA(At, 0, 0); PG8_STAGE_A(1, 1, a1, vAc);
            if constexpr (GATHER) { if (last && has_next) { vAc[0] = (unsigned)gr0 | ((unsigned)gr1 << 16); vAc[1] = (unsigned)gr2 | ((unsigned)gr3 << 16); } }
            PG8_WAIT_V8_SKIPPABLE; PG8_WAIT_L(0); PG8_BAR; PG8_MMA(0, 0, At, B0); PG8_MMA(0, 1, At, B1); PG8_BAR; PG8_SCHED;
            PG8_LDA(At, 0, 1); PG8_STAGE_B(PG8_SB(0, 0), b2); PG8_STAGE_B(PG8_SB(0, 1), b2 + hstepB); PG8_STAGE_A(0, 0, a2, vAc);
            PG8_WAIT_V8_SKIPPABLE; PG8_WAIT_L(0); PG8_BAR; PG8_MMA(1, 0, At, B0); PG8_MMA(1, 1, At, B1); PG8_BAR; PG8_SCHED;
            PG8_LDB(B0, 1, 0); PG8_LDB(B1, 1, 1); PG8_SCHED; PG8_LDA(At, 1, 0); PG8_STAGE_A(0, 1, a2, vAc);
            PG8_WAIT_V8_SKIPPABLE; PG8_WAIT_L(0); PG8_BAR; PG8_MMA(0, 0, At, B0); PG8_MMA(0, 1, At, B1); PG8_BAR; PG8_SCHED;
            PG8_LDA(At, 1, 1); PG8_STAGE_B(PG8_SB(1, 0), b3); PG8_STAGE_B(PG8_SB(1, 1), b3 + hstepB); PG8_STAGE_A(1, 0, a3, vAc);
            PG8_WAIT_V(8); PG8_WAIT_L(0); PG8_BAR; PG8_MMA(1, 0, At, B0); PG8_MMA(1, 1, At, B1); PG8_BAR; PG8_SCHED;
        }
        PG8_PT_B(18);
        if constexpr (ALIGN_EPI) { if (wr == 0) PG8_BAR; }
        PG8_PT_B(19); if constexpr (VAR != 7) { const int l_ = lane_id_v(); E(acc, cur, wr, wc, l_ & 15, l_ >> 4); } else { asm volatile("" :: "v"(acc[0][0][0][0]), "v"(acc[1][1][3][1])); } PG8_PT_E(19);
        if (!has_next) break;
#pragma unroll
        for (int a = 0; a < 2; ++a)
#pragma unroll
            for (int b = 0; b < 2; ++b)
#pragma unroll
                for (int m = 0; m < 4; ++m)
#pragma unroll
                    for (int n = 0; n < 2; ++n) acc[a][b][m][n] = (f32x4){0.f, 0.f, 0.f, 0.f};
        cur = nxt; cA = nA; cB = nB; ++ui;
        if constexpr (ALIGN_EPI) { if (wr == 1) PG8_BAR; }
        PG8_PT_E(18);
    }
    PG8_WAIT_V(0);
    if constexpr (!ALIGN_EPI) { if (wr == 0) PG8_BAR; }
    PG8_BAR;
#undef PG8_SA
#undef PG8_SB
#undef PG8_STAGE
#undef PG8_STAGE_A
#undef PG8_STAGE_B
#undef PG8_STAGE_G
#undef PG8_LDA
#undef PG8_LDB
#undef PG8_MMA
#undef PG8_WAIT_V
#undef PG8_WAIT_V8_SKIPPABLE
#undef PG8_WAIT_L
#undef PG8_BAR
#undef PG8_SCHED
}
}
#define GAS __attribute__((address_space(1)))
#define LAS __attribute__((address_space(3)))
typedef unsigned short bf16;
typedef unsigned v4u __attribute__((ext_vector_type(4)));
typedef float f32x4 __attribute__((ext_vector_type(4)));
typedef short bf16x8 __attribute__((ext_vector_type(8)));
typedef GAS unsigned gu32;
typedef GAS unsigned long long gu64;
#define RLX_AGENT __ATOMIC_RELAXED, __HIP_MEMORY_SCOPE_AGENT
#define LDS_WAIT() asm volatile("s_waitcnt lgkmcnt(0)" ::: "memory")
#define VM_WAIT() asm volatile("s_waitcnt vmcnt(0)" ::: "memory")
__device__ __forceinline__ unsigned long long rt() { return __builtin_amdgcn_s_memrealtime(); }
__device__ __forceinline__ unsigned f2bf(float f) { unsigned u = __builtin_bit_cast(unsigned, f); return (u + 0x7fffu + ((u >> 16) & 1u)) >> 16; }
__device__ __forceinline__ unsigned pk2(float lo, float hi) { return f2bf(lo) | (f2bf(hi) << 16); }

#define XB_TMO      128
#define XB_XCNT(j)  (256  + 64 * (j))
#define XB_XSUB(j)  (1280 + 64 * (j))
#define XB_XGEN(j)  (2304 + 64 * (j))
#define XB_TOP      3328
#define XB_TOPGEN   3392
#define XCD_BAR_WORDS 3456
#define XB_SPIN_CAP (1u << 18)

__device__ __forceinline__ unsigned xb_ld(unsigned* p)              { return __hip_atomic_load(p, __ATOMIC_RELAXED, __HIP_MEMORY_SCOPE_AGENT); }
__device__ __forceinline__ unsigned xb_add(unsigned* p, unsigned v) { return __hip_atomic_fetch_add(p, v, __ATOMIC_RELAXED, __HIP_MEMORY_SCOPE_AGENT); }
__device__ __forceinline__ unsigned xb_xcc_id() { return (unsigned)__builtin_amdgcn_s_getreg((3 << 11) | 20) & 0xFu; }
#define XB_SPIN(cond, bar) do { unsigned _sp = 0; while (cond) { __builtin_amdgcn_s_sleep(1); \
    if ((++_sp & 255u) == 0u) { if (xb_ld(&(bar)[XB_TMO])) break; if (_sp > XB_SPIN_CAP) { atomicAdd(&(bar)[XB_TMO], 1u); break; } } } } while (0)

struct XcdBarrier {
    unsigned* bar; unsigned x;
    volatile LAS unsigned* st;
};

__device__ __forceinline__ XcdBarrier xcd_barrier_post(unsigned* bar, volatile LAS unsigned* st) {
    XcdBarrier b; b.bar = bar; b.x = xb_xcc_id(); b.st = st;
    if (threadIdx.x == 0) (void)xb_add(&bar[XB_XCNT(b.x)], 1u);
    return b;
}
__device__ __forceinline__ void xcd_barrier_complete(unsigned* bar, unsigned x, unsigned& nloc, unsigned& nx) {
    const unsigned G = gridDim.x * gridDim.y * gridDim.z;
    unsigned sum, cnt, mine, sp = 0u;
    for (;;) {
        sum = 0u; cnt = 0u; mine = 0u;
#pragma unroll
        for (unsigned j = 0; j < 16; ++j) { const unsigned c = xb_ld(&bar[XB_XCNT(j)]); sum += c; cnt += (c > 0u) ? 1u : 0u; mine = (j == x) ? c : mine; }
        if (sum == G) break;
        __builtin_amdgcn_s_sleep(1);
        if ((++sp & 255u) == 0u) { if (xb_ld(&bar[XB_TMO])) break; if (sp > XB_SPIN_CAP) { atomicAdd(&bar[XB_TMO], 1u); break; } }
    }
    nloc = mine > 0u ? mine : 1u; nx = cnt > 0u ? cnt : 1u;
}

__device__ __forceinline__ void xcd_barrier(const XcdBarrier& b) {
    asm volatile("s_waitcnt vmcnt(0)" ::: "memory");
    __syncthreads();
    if (threadIdx.x == 0) {
        unsigned* bar = b.bar;
        __builtin_amdgcn_s_waitcnt(0);
        unsigned nloc = b.st[0], nx = b.st[1];
        if (nloc == 0u) { xcd_barrier_complete(bar, b.x, nloc, nx); b.st[0] = nloc; b.st[1] = nx; }
        const unsigned old = xb_add(&bar[XB_XSUB(b.x)], 1u);
        const unsigned gen = old / nloc;
        if (old + 1u == (gen + 1u) * nloc) {
            __builtin_amdgcn_fence(__ATOMIC_RELEASE, "agent");
            asm volatile("s_waitcnt vmcnt(0)" ::: "memory");
            const unsigned og = xb_add(&bar[XB_TOP], 1u);
            const unsigned tg = og / nx;
            if (og + 1u == (tg + 1u) * nx) xb_add(&bar[XB_TOPGEN], 1u);
            else XB_SPIN(xb_ld(&bar[XB_TOPGEN]) == tg, bar);
            __builtin_amdgcn_fence(__ATOMIC_ACQUIRE, "agent");
            xb_add(&bar[XB_XGEN(b.x)], 1u);
            asm volatile("s_waitcnt vmcnt(0)" ::: "memory");
        } else {
            XB_SPIN(xb_ld(&bar[XB_XGEN(b.x)]) == gen, bar);
            __builtin_amdgcn_fence(__ATOMIC_ACQUIRE, "agent");
            asm volatile("s_waitcnt vmcnt(0)" ::: "memory");
        }
    }
    __syncthreads();
}

constexpr int NWAVES = 8;
constexpr int D = 1024, NB = 16, SEQ = 2048, T = NB * SEQ, CTXL = 256, TC = NB * CTXL;
constexpr int QW = 512, KVW = 128, HYW = 512, INW = 4352, NE = 32, DFF = 1024;
constexpr float LN_EPS = 1e-5f;
constexpr float DN_ALPHA = 1.189207115002721f;
constexpr float LOG2E = 1.4426950408889634f;
constexpr float C2Q = 0.125f * LOG2E;
constexpr int NPH = 10;
#ifndef MK_N_LAUNCHES
#define MK_N_LAUNCHES 1
#endif
constexpr int N_LAUNCHES = MK_N_LAUNCHES;

constexpr size_t MiB = 1u << 20;
constexpr size_t WS_CTL = 0, CTL_ZERO_BYTES = 128 * 1024;
constexpr size_t WS_MODP = 1 * MiB;
constexpr size_t WS_MODF = 8 * MiB;
constexpr size_t WS_ROPE = 9 * MiB;
constexpr size_t WS_ASG = 10 * MiB;
constexpr size_t WS_GW = 10 * MiB + 512 * 1024;
constexpr size_t WS_TOK = 11 * MiB;
constexpr size_t WS_G = 16 * MiB;
constexpr size_t WS_WB = 24 * MiB;
constexpr size_t WS_WO = 26 * MiB;
constexpr size_t WS_WIN = 28 * MiB;
constexpr size_t WS_W1 = 40 * MiB;
constexpr size_t WS_W2 = 168 * MiB;
constexpr size_t WS_V1 = 232 * MiB;
constexpr size_t WS_HM = 360 * MiB;
constexpr size_t WS_HX = 424 * MiB;
constexpr size_t WS_Q = 496 * MiB;
constexpr size_t WS_K = 528 * MiB;
constexpr size_t WS_VT = 536 * MiB;
constexpr size_t WS_KC = 544 * MiB;
constexpr size_t WS_VTC = 545 * MiB;
constexpr size_t WS_UT = 546 * MiB;
constexpr size_t WS_GATE = 642 * MiB;
constexpr size_t WS_ATT = 770 * MiB;
constexpr size_t WS_HYT = 898 * MiB;
constexpr size_t WS_MM = 834 * MiB;
constexpr size_t WS_ACT = 424 * MiB;
constexpr size_t WS_YB = 696 * MiB;
constexpr size_t WS_END = 1024 * MiB;
static_assert(WS_ACT + (size_t)139264 * 2048 <= WS_YB && WS_YB + (size_t)139264 * 2048 <= WS_END && WS_MM + (size_t)T * 2048 <= WS_END, "d_ws map");
constexpr int CW_TMO = 0, CW_CODE = 1, CW_BAR = 4096, CW_CNT = 16384, CW_MOD = 16384 + 64;
static_assert((CW_MOD + 1) * 4 <= (int)CTL_ZERO_BYTES && (CW_BAR + 3456) <= CW_CNT, "control words inside the per-call memset");

constexpr int RING_BYTES = 131072;
constexpr int LDSCTL_OFF = 151552;
constexpr int MISC_OFF = LDSCTL_OFF + 320;
constexpr int TP_OFF = LDSCTL_OFF + 1024;
constexpr int LDS_BYTES = 155648;

typedef float f32x16 __attribute__((ext_vector_type(16)));
typedef float f32x2 __attribute__((ext_vector_type(2)));
typedef unsigned u32x2 __attribute__((ext_vector_type(2)));

struct Frame {
    unsigned long long pt0, ptacc;
    LAS unsigned char* lds;
    volatile LAS unsigned* MISC;
    gu32* ctl;
    int tid, lane, wave, vcu, G;
    const GAS float *x, *c, *ctx, *c_ctx, *w_mod, *b_mod, *w_in, *sink, *cw, *cb, *fw1, *fb1, *fw2, *fb2, *fw3, *skip, *w_ba, *w_bh, *w_out, *ln1g, *ln1b, *rw, *rb, *ew1, *eb1, *ew2, *eb2, *ln2g, *ln2b;
    GAS float* out;
    GAS float *modP, *modF, *rope, *gw; GAS bf16* V1;
    GAS int *asg, *tok;
    GAS bf16 *G_, *WB, *WO, *WIN, *W1, *W2, *HM, *HX, *Q, *K, *VT, *KC, *VTC, *UT, *GATE, *ATT, *MM, *ACT, *YB, *HYT;
};

template <int CTRL> __device__ __forceinline__ float dpp_f(float v) { return __builtin_bit_cast(float, __builtin_amdgcn_update_dpp(0, __builtin_bit_cast(int, v), CTRL, 0xF, 0xF, true)); }
__device__ __forceinline__ float wave_sum(float v) {
    v += dpp_f<0xB1>(v); v += dpp_f<0x4E>(v); v += dpp_f<0x141>(v); v += dpp_f<0x140>(v);
    { const unsigned u = __builtin_bit_cast(unsigned, v); auto r = __builtin_amdgcn_permlane16_swap(u, u, false, false); v = __builtin_bit_cast(float, (unsigned)r[0]) + __builtin_bit_cast(float, (unsigned)r[1]); }
    { const unsigned u = __builtin_bit_cast(unsigned, v); auto r = __builtin_amdgcn_permlane32_swap(u, u, false, false); v = __builtin_bit_cast(float, (unsigned)r[0]) + __builtin_bit_cast(float, (unsigned)r[1]); }
    return v;
}
__device__ __forceinline__ float wave_max(float v) {
    v = fmaxf(v, dpp_f<0xB1>(v)); v = fmaxf(v, dpp_f<0x4E>(v)); v = fmaxf(v, dpp_f<0x141>(v)); v = fmaxf(v, dpp_f<0x140>(v));
    { const unsigned u = __builtin_bit_cast(unsigned, v); auto r = __builtin_amdgcn_permlane16_swap(u, u, false, false); v = fmaxf(__builtin_bit_cast(float, (unsigned)r[0]), __builtin_bit_cast(float, (unsigned)r[1])); }
    { const unsigned u = __builtin_bit_cast(unsigned, v); auto r = __builtin_amdgcn_permlane32_swap(u, u, false, false); v = fmaxf(__builtin_bit_cast(float, (unsigned)r[0]), __builtin_bit_cast(float, (unsigned)r[1])); }
    return v;
}
__device__ __forceinline__ float bf2f(unsigned short h) { return __builtin_bit_cast(float, (unsigned)h << 16); }
__device__ __forceinline__ float bflo(unsigned w) { return __builtin_bit_cast(float, w << 16); }
__device__ __forceinline__ float bfhi(unsigned w) { return __builtin_bit_cast(float, w & 0xffff0000u); }
__device__ __forceinline__ float sigmoidf_(float x) { return __builtin_amdgcn_rcpf(1.f + __builtin_amdgcn_exp2f(-LOG2E * x)); }
__device__ __forceinline__ unsigned pk4_fp8(float a, float b, float c, float d) { int w = 0; w = __builtin_amdgcn_cvt_pk_fp8_f32(a, b, w, false); w = __builtin_amdgcn_cvt_pk_fp8_f32(c, d, w, true); return (unsigned)w; }

__device__ __forceinline__ void p0_mod_block(Frame& F, int cb) {
    const int lane = F.lane, w = F.wave;
    LAS float* scr = (LAS float*)(F.lds + w * 16384);
    LAS float* part = (LAS float*)(F.lds + 8704);
    float xs[17][2];
#pragma unroll
    for (int r = 0; r < 17; ++r) { const GAS float* src = r < 16 ? F.c + r * D : F.c_ctx; xs[r][0] = src[128 * w + lane]; xs[r][1] = src[128 * w + 64 + lane]; }
#pragma unroll
    for (int r = 0; r < 17; ++r) { scr[r * 128 + lane] = xs[r][0] / (1.f + __expf(-xs[r][0])); scr[r * 128 + 64 + lane] = xs[r][1] / (1.f + __expf(-xs[r][1])); }
    LDS_WAIT(); asm volatile("" ::: "memory");
    float acc[17];
#pragma unroll
    for (int r = 0; r < 17; ++r) acc[r] = 0.f;
    const GAS float* wp = F.w_mod + (size_t)(128 * w) * 6144 + 64 * cb + lane;
#pragma unroll 1
    for (int k0 = 0; k0 < 128; k0 += 64) { float wv[64];
#pragma unroll
        for (int k = 0; k < 64; ++k) wv[k] = wp[(size_t)(k0 + k) * 6144];
#pragma unroll
        for (int k = 0; k < 64; ++k) {
#pragma unroll
            for (int r = 0; r < 17; ++r) acc[r] += scr[r * 128 + k0 + k] * wv[k]; } }
#pragma unroll
    for (int r = 0; r < 17; ++r) part[w * 4096 + r * 64 + lane] = acc[r];
    __syncthreads();
    for (int i = F.tid; i < 17 * 64; i += NWAVES * 64) { const int r = i >> 6, c = i & 63; float sum = F.b_mod[64 * cb + c];
#pragma unroll
        for (int ww = 0; ww < 8; ++ww) sum += part[ww * 4096 + r * 64 + c];
        F.modF[r * 6144 + 64 * cb + c] = sum; }
    asm volatile("s_waitcnt vmcnt(0)" ::: "memory"); __syncthreads();
    if (F.tid == 0) { __builtin_amdgcn_fence(__ATOMIC_RELEASE, "agent"); asm volatile("s_waitcnt vmcnt(0)" ::: "memory"); __hip_atomic_fetch_add(F.ctl + CW_MOD, 1u, RLX_AGENT); }
    __syncthreads();
}
__device__ __forceinline__ void p0_filt_item(Frame& F, LAS float* scr, int g, int cb) {
    int lane = F.lane; asm volatile("" : "+v"(lane));
    LAS float* zf = scr; LAS float* h1 = scr + 8 * 36; LAS float* h2 = h1 + 8 * 64;
#pragma unroll
    for (int p = 0; p < 8; ++p) { const int j = 8 * g + p; const float om = (6.283185307179586f * (float)j) / 2048.f;
        if (lane < 16) { const float fk = 1e-4f + (float)lane * ((15.f - 1e-4f) / 15.f); zf[p * 36 + 1 + lane] = cosf(fk * om); }
        else if (lane < 32) { const float fk = 1e-4f + (float)(lane - 16) * ((15.f - 1e-4f) / 15.f); zf[p * 36 + 17 + (lane - 16)] = -sinf(fk * om); }
        else if (lane == 32) zf[p * 36] = (float)j / 2047.f; }
    LDS_WAIT(); asm volatile("" ::: "memory");
    {
        float w1c[33], w2c[64];
#pragma unroll
        for (int i = 0; i < 33; ++i) w1c[i] = F.fw1[i * 64 + lane];
#pragma unroll
        for (int i = 0; i < 64; ++i) w2c[i] = F.fw2[i * 64 + lane];
        const float bb1 = F.fb1[lane], bb2 = F.fb2[lane];
#pragma unroll
        for (int p = 0; p < 8; ++p) { float a = bb1;
#pragma unroll
            for (int i = 0; i < 33; ++i) a += zf[p * 36 + i] * w1c[i];
            h1[p * 64 + lane] = sinf(a); }
        LDS_WAIT(); asm volatile("" ::: "memory");
#pragma unroll
        for (int p = 0; p < 8; ++p) { float a = bb2;
#pragma unroll
            for (int i = 0; i < 64; ++i) a += h1[p * 64 + i] * w2c[i];
            h2[p * 64 + lane] = sinf(a); }
        LDS_WAIT(); asm volatile("" ::: "memory");
    }
    float o[8][4];
#pragma unroll
    for (int p = 0; p < 8; ++p)
#pragma unroll
        for (int q = 0; q < 4; ++q) o[p][q] = 0.f;
    const GAS float* w3 = F.fw3 + 256 * cb + lane;
#pragma unroll 1
    for (int i0 = 0; i0 < 64; i0 += 16) { float w[16][4];
#pragma unroll
        for (int i = 0; i < 16; ++i)
#pragma unroll
            for (int q = 0; q < 4; ++q) w[i][q] = w3[(size_t)(i0 + i) * 2048 + 64 * q];
#pragma unroll
        for (int i = 0; i < 16; ++i)
#pragma unroll
            for (int p = 0; p < 8; ++p) { const float hv = h2[p * 64 + i0 + i];
#pragma unroll
                for (int q = 0; q < 4; ++q) o[p][q] += hv * w[i][q]; } }
#pragma unroll
    for (int q = 0; q < 4; ++q) { const int col = 256 * cb + 64 * q + lane, oo = col >> 10, dir = (col >> 9) & 1, ch = col & 511;
        const float delta = 15.350567286626973f - (float)ch * (12.280453829301578f / 511.f);
        GAS bf16* gp = F.G_ + (size_t)(oo * 512 + ch) * 4096;
#pragma unroll
        for (int p = 0; p < 8; ++p) { const int j = 8 * g + p; const float val = o[p][q] * __expf(-((float)j / 2047.f) * delta);
            const int idx = dir ? 2048 + j : 2048 - j; if (!(dir && j == 0)) gp[idx] = (bf16)f2bf(val); }
        if (g == 0 && dir == 0) gp[0] = 0; }
    LDS_WAIT(); asm volatile("" ::: "memory");
}
constexpr int IT_IN = 16 * 136, IT_B = 8 * 32, IT_O = 16 * 32, IT_W1 = 32 * 16 * 64, IT_W2 = 32 * 16 * 32, NTR = IT_IN + 2 * IT_B + IT_O + IT_W1 + IT_W2;
struct TrItem { const GAS float* W; GAS bf16* WT; int N, Kp, drow, k0, n0, f8; };
__device__ __forceinline__ TrItem tr_decode(Frame& F, int r) {
    TrItem t; t.f8 = 0;
    if (r < IT_IN) { t.W = F.w_in; t.N = INW; t.WT = F.WIN; t.Kp = 1024; t.k0 = 64 * (r / 136); t.n0 = 32 * (r % 136); t.drow = t.n0; }
    else if ((r -= IT_IN) < IT_B) { t.W = F.w_ba; t.N = 1024; t.WT = F.WB; t.Kp = 512; t.k0 = 64 * (r / 32); t.n0 = 32 * (r % 32); t.drow = t.n0; }
    else if ((r -= IT_B) < IT_B) { t.W = F.w_bh; t.N = 1024; t.WT = F.WB + 1024 * 512; t.Kp = 512; t.k0 = 64 * (r / 32); t.n0 = 32 * (r % 32); t.drow = t.n0; }
    else if ((r -= IT_B) < IT_O) { t.W = F.w_out; t.N = 1024; t.WT = F.WO; t.Kp = 1024; t.k0 = 64 * (r / 32); t.n0 = 32 * (r % 32); t.drow = t.n0; }
    else if ((r -= IT_O) < IT_W1) { const int e = r >> 10, q = r & 1023; t.W = F.ew1 + (size_t)e * 1024 * 2048; t.N = 2048; t.WT = (GAS bf16*)((GAS unsigned char*)F.W1 + (size_t)e * 2048 * 1024); t.Kp = 1024; t.f8 = 1; t.k0 = 64 * (q >> 6); t.n0 = 32 * (q & 63);
        t.drow = t.n0 < 1024 ? (t.n0 >> 7) * 256 + (t.n0 & 127) : ((t.n0 - 1024) >> 7) * 256 + 128 + ((t.n0 - 1024) & 127); }
    else { r -= IT_W1; const int e = r >> 9, q = r & 511; t.W = F.ew2 + (size_t)e * 1024 * 1024; t.N = 1024; t.WT = (GAS bf16*)((GAS unsigned char*)F.W2 + (size_t)e * 1024 * 1024); t.Kp = 1024; t.f8 = 1; t.k0 = 64 * (q >> 5); t.n0 = 32 * (q & 31); t.drow = t.n0; }
    return t;
}
__device__ __forceinline__ void tr_load(const TrItem& t, int lane, f32x4 (&buf)[8]) {
    const GAS float* wp = t.W + (size_t)(t.k0 + (lane >> 3)) * t.N + t.n0 + 4 * (lane & 7);
#pragma unroll
    for (int i = 0; i < 8; ++i) buf[i] = __builtin_nontemporal_load((const GAS f32x4*)(wp + (size_t)(8 * i) * t.N));
}
__device__ __forceinline__ void tr_store(const TrItem& t, const f32x4 (&buf)[8], LAS float* scr, int lane) {
    const int kk = lane >> 3, c4 = lane & 7;
#pragma unroll
    for (int i = 0; i < 8; ++i) { LAS float* d = scr + (8 * i + kk) * 33 + 4 * c4; d[0] = buf[i][0]; d[1] = buf[i][1]; d[2] = buf[i][2]; d[3] = buf[i][3]; }
    LDS_WAIT(); asm volatile("" ::: "memory");
    const int c = lane & 7;
#pragma unroll
    for (int j = 0; j < 4; ++j) { const int n = (lane >> 3) + 8 * j; const LAS float* sp = scr + (8 * c) * 33 + n;
        if (t.f8) { u32x2 o; o.x = pk4_fp8(sp[0 * 33] * 256.f, sp[1 * 33] * 256.f, sp[2 * 33] * 256.f, sp[3 * 33] * 256.f); o.y = pk4_fp8(sp[4 * 33] * 256.f, sp[5 * 33] * 256.f, sp[6 * 33] * 256.f, sp[7 * 33] * 256.f);
            *(GAS u32x2*)((GAS unsigned char*)t.WT + (size_t)(t.drow + n) * t.Kp + t.k0 + 8 * c) = o; }
        else { v4u o; o.x = pk2(sp[0 * 33], sp[1 * 33]); o.y = pk2(sp[2 * 33], sp[3 * 33]); o.z = pk2(sp[4 * 33], sp[5 * 33]); o.w = pk2(sp[6 * 33], sp[7 * 33]);
            *(GAS v4u*)(t.WT + (size_t)(t.drow + n) * t.Kp + t.k0 + 8 * c) = o; } }
    LDS_WAIT(); asm volatile("" ::: "memory");
}
__device__ __forceinline__ void p1_rows(Frame& F);
__device__ __forceinline__ void p0_prologue(Frame& F) {
    LAS float* scr = (LAS float*)(F.lds + F.wave * 16384);
    const int gw = F.vcu * NWAVES + F.wave, NGW = F.G * NWAVES, lane = F.lane;
    constexpr int IT_FILT = 2048, IT_ROPE = 1, NSPEC = IT_FILT + IT_ROPE;
    if ((int)blockIdx.x < 96) p0_mod_block(F, (int)blockIdx.x);
    const bool spec_first = (F.wave & 1) != 0;
#define P0_SPECIAL() do { for (int it = gw; it < NSPEC; it += NGW) { int r = it; \
        if (r < IT_FILT) { p0_filt_item(F, scr, r >> 3, r & 7); continue; } \
        _Pragma("unroll 4") for (int i = 0; i < 16; ++i) { const int idx = lane * 16 + i, pos = idx >> 4, f = idx & 15; const float inv = exp2f(-(float)f * (13.287712379549449f / 16.f)); const float ang = (float)pos * inv; \
            F.rope[idx] = cosf(ang); F.rope[1024 + idx] = sinf(ang); } } } while (0)
    if (spec_first) P0_SPECIAL();
    if (gw < NTR) {
        int it = gw;
        TrItem c0 = tr_decode(F, it); f32x4 b0[8]; tr_load(c0, lane, b0);
        int i1 = it + NGW; bool h1 = i1 < NTR; TrItem c1 = tr_decode(F, h1 ? i1 : it); f32x4 b1[8]; tr_load(c1, lane, b1);
        for (;;) {
            const int i2 = i1 + NGW; const bool h2 = h1 && i2 < NTR;
            TrItem c2 = tr_decode(F, h2 ? i2 : it); f32x4 b2[8]; tr_load(c2, lane, b2);
            tr_store(c0, b0, scr, lane);
            if (!h1) break;
            c0 = c1; c1 = c2; it = i1; i1 = i2; h1 = h2;
#pragma unroll
            for (int i = 0; i < 8; ++i) { b0[i] = b1[i]; b1[i] = b2[i]; }
        }
    }
    if (!spec_first) P0_SPECIAL();
#undef P0_SPECIAL
    __syncthreads();
    if (F.wave == 0) { unsigned sp = 0;
        while ((unsigned)__builtin_amdgcn_readfirstlane(__hip_atomic_load(F.ctl + CW_MOD, RLX_AGENT)) < 96u) { __builtin_amdgcn_s_sleep(2); if (++sp > (1u << 22)) { if (F.lane == 0) __hip_atomic_store(F.ctl + CW_TMO, 1u, RLX_AGENT); break; } }
        __builtin_amdgcn_fence(__ATOMIC_ACQUIRE, "agent"); asm volatile("s_waitcnt vmcnt(0)" ::: "memory"); }
    __syncthreads();
    p1_rows(F);
}

template <int NR>
__device__ __forceinline__ void ln_mod_rows(const GAS float* const (&src)[NR], GAS bf16* const (&dst)[NR], const LAS float* const (&tS)[NR], const LAS float* const (&tB)[NR], int lane) {
    f32x4 v[NR][4]; float s[NR], s2[NR];
#pragma unroll
    for (int r = 0; r < NR; ++r) { const GAS f32x4* xr = (const GAS f32x4*)src[r] + lane;
#pragma unroll
        for (int j = 0; j < 4; ++j) v[r][j] = __builtin_nontemporal_load(xr + 64 * j); }
#pragma unroll
    for (int r = 0; r < NR; ++r) { s[r] = 0.f;
#pragma unroll
        for (int j = 0; j < 4; ++j) s[r] += (v[r][j].x + v[r][j].y) + (v[r][j].z + v[r][j].w); }
#pragma unroll
    for (int r = 0; r < NR; ++r) s[r] = wave_sum(s[r]) * (1.f / D);
#pragma unroll
    for (int r = 0; r < NR; ++r) { s2[r] = 0.f;
#pragma unroll
        for (int j = 0; j < 4; ++j) { v[r][j] = v[r][j] - s[r]; s2[r] += (v[r][j].x * v[r][j].x + v[r][j].y * v[r][j].y) + (v[r][j].z * v[r][j].z + v[r][j].w * v[r][j].w); } }
#pragma unroll
    for (int r = 0; r < NR; ++r) s2[r] = 1.f / sqrtf(wave_sum(s2[r]) * (1.f / D) + LN_EPS);
#pragma unroll
    for (int r = 0; r < NR; ++r)
#pragma unroll
        for (int j = 0; j < 4; ++j) { const int col = 4 * lane + 256 * j; const f32x4 sc = *(const LAS f32x4*)(tS[r] + col), sh = *(const LAS f32x4*)(tB[r] + col);
            const f32x4 o = v[r][j] * s2[r] * sc + sh; u32x2 w; w.x = pk2(o.x, o.y); w.y = pk2(o.z, o.w); *(GAS u32x2*)(dst[r] + col) = w; }
}
__device__ __forceinline__ void p1_rows(Frame& F) {
    LAS float* tA = (LAS float*)F.lds;
    for (int chunk = blockIdx.x; chunk < 256; chunk += F.G) {
        const int b = chunk >> 4;
        for (int i = F.tid; i < 4096; i += NWAVES * 64) { const int which = i >> 10, col = i & 1023, r = which < 2 ? b : 16, n = ((which & 1) ? 0 : 1024) + col;
            const float s = F.modF[r * 6144 + n]; tA[i] = (which & 1) ? s : 1.f + s; }
        __syncthreads();
#pragma unroll 1
        for (int g = 0; g < 6; ++g) {
            const GAS float* src[3]; GAS bf16* dst[3]; const LAS float* tS[3]; const LAS float* tB[3];
#pragma unroll
            for (int r = 0; r < 3; ++r) { const int rr = 3 * g + r;
                if (rr < 16) { const int row = chunk * 128 + F.wave * 16 + rr; src[r] = F.x + (size_t)row * D; dst[r] = F.HX + (size_t)row * D; tS[r] = tA; tB[r] = tA + 1024; }
                else { const int cr = chunk * 16 + F.wave * 2 + (rr - 16); src[r] = F.ctx + (size_t)cr * D; dst[r] = F.HX + (size_t)(T + cr) * D; tS[r] = tA + 2048; tB[r] = tA + 3072; } }
            ln_mod_rows<3>(src, dst, tS, tB, F.lane);
        }
        __syncthreads();
    }
}

using pg8::Unit; using pg8::f32x4; using pg8::cvt_pk_bf16;
struct SchedInProj {
    pg8::StaticOrder so; int G, c;
    __device__ __forceinline__ bool next(int i, Unit& u) const { const long L = (long)i * G + c; if (L < 1408) { so.next(i, u); if (u.pn >= 3) u.pn += 6; return true; } if (L < 1424) { u.pm = 128 + (int)(L - 1408); u.pn = 2; return true; } return false; }
    __device__ __forceinline__ void a_ready(const Unit&) const {}
};
struct SchedUhy {
    pg8::StaticOrder so;
    __device__ __forceinline__ bool next(int i, Unit& u) const { if (!so.next(i, u)) return false; u.pn += 3; return true; }
    __device__ __forceinline__ void a_ready(const Unit&) const {}
};
struct SchedPair {
    pg8::StaticOrder so;
    __device__ __forceinline__ bool next(int i, Unit& u) const { if (!so.next(i >> 1, u)) return false; if (i & 1) { u.pm += 128; u.pn += 4; } return true; }
    __device__ __forceinline__ void a_ready(const Unit&) const {}
};
struct SchedPlain { pg8::StaticOrder so;
    __device__ __forceinline__ bool next(int i, Unit& u) const { return so.next(i, u); }
    __device__ __forceinline__ void a_ready(const Unit&) const {}
};
struct SchedMoe {
    const LAS int* tp; const GAS int* tok; int nNl, G, c;
    __device__ __forceinline__ bool next(int i, Unit& u) const {
        pg8::StaticOrder so; so.init(__builtin_amdgcn_readfirstlane(tp[32]), nNl, G, c); if (!so.next(i, u)) return false;
        int e = 0;
        for (int k = 1; k < 32; ++k) e += (u.pm >= tp[k]) ? 1 : 0;
        u.pm = __builtin_amdgcn_readfirstlane(u.pm); u.pn = __builtin_amdgcn_readfirstlane(u.pn + e * nNl); return true; }
    __device__ __forceinline__ int rowoff(const Unit& u, int r) const { const int e = u.pn / nNl; int pos = (u.pm - tp[e]) * 256 + r; pos = pos < tp[33 + e] ? pos : 0; return tok[e * 32768 + pos]; }
    __device__ __forceinline__ void a_ready(const Unit&) const {}
};

struct EpiInProj {
    static constexpr bool PERM = true; static constexpr float S8 = 1.f;
    GAS bf16 *Q, *K, *VT, *KC, *VTC, *GATE; const GAS float* rope;
    __device__ __forceinline__ void operator()(const f32x4 (&acc)[2][2][4][2], const Unit& u, int wr, int wc, int fr, int fq) const {
        const int pn = u.pn; const bool isctx = u.pm >= 128;
#pragma unroll
        for (int ai = 0; ai < 2; ++ai)
#pragma unroll
            for (int m = 0; m < 4; ++m) {
                const int row = u.pm * 256 + ai * 128 + wr * 64 + m * 16 + fr;
                if (pn >= 9) {
#pragma unroll
                    for (int bj = 0; bj < 2; ++bj) { const int col = (pn - 9) * 256 + bj * 128 + wc * 32 + 8 * fq; const f32x4 v0 = acc[ai][bj][m][0] * S8, v1 = acc[ai][bj][m][1] * S8; v4u w;
                        w.x = cvt_pk_bf16(sigmoidf_(v0[0]), sigmoidf_(v0[1])); w.y = cvt_pk_bf16(sigmoidf_(v0[2]), sigmoidf_(v0[3])); w.z = cvt_pk_bf16(sigmoidf_(v1[0]), sigmoidf_(v1[1])); w.w = cvt_pk_bf16(sigmoidf_(v1[2]), sigmoidf_(v1[3]));
                        *(GAS v4u*)(GATE + (size_t)row * 2048 + col) = w; }
                } else {
                    const int t = row & 2047;
                    const int pos = (wc & 1) ? (t & 63) : (t >> 6); const int f0 = 8 * (fq & 1); const bool hihalf = (fq >> 1) != 0;
#pragma unroll
                    for (int bj = 0; bj < 2; ++bj) {
                        if (pn == 2 && bj == 1) {
                            const int kvh = wc >> 1, d0 = (wc & 1) * 32 + 8 * fq;
                            GAS bf16* vp = isctx ? VTC + ((size_t)(((row - T) >> 8) * 2 + kvh) * 64 + d0) * 256 + ((row - T) & 255)
                                             : VT + ((size_t)((row >> 11) * 2 + kvh) * 64 + d0) * 2048 + t;
                            const int pitch = isctx ? 256 : 2048;
#pragma unroll
                            for (int n = 0; n < 2; ++n)
#pragma unroll
                                for (int j = 0; j < 4; ++j) vp[(size_t)(4 * n + j) * pitch] = (bf16)f2bf(acc[ai][bj][m][n][j] * S8);
                        } else {
                            f32x4 r[2];
#pragma unroll
                            for (int n = 0; n < 2; ++n) { const f32x4 own = acc[ai][bj][m][n] * S8; f32x4 oth;
#pragma unroll
                                for (int j = 0; j < 4; ++j) oth[j] = __shfl_xor(own[j], 32);
                                const f32x4 cs = *(const GAS f32x4*)(rope + pos * 16 + f0 + 4 * n), sn = *(const GAS f32x4*)(rope + 1024 + pos * 16 + f0 + 4 * n);
                                r[n] = hihalf ? own * cs + oth * sn : own * cs - oth * sn;
                                if (isctx) r[n] = own; }
                            if (pn < 2) { r[0] = r[0] * C2Q; r[1] = r[1] * C2Q; }
                            v4u w; w.x = cvt_pk_bf16(r[0][0], r[0][1]); w.y = cvt_pk_bf16(r[0][2], r[0][3]); w.z = cvt_pk_bf16(r[1][0], r[1][1]); w.w = cvt_pk_bf16(r[1][2], r[1][3]);
                            GAS bf16* dst = pn < 2 ? Q + (size_t)row * QW + pn * 256 + bj * 128 + wc * 32 + 8 * fq
                                               : (isctx ? KC + (size_t)(row - T) * KVW + wc * 32 + 8 * fq : K + (size_t)row * KVW + wc * 32 + 8 * fq);
                            *(GAS v4u*)dst = w;
                        }
                    }
                }
            }
    }
};
struct EpiUT {
    static constexpr bool PERM = true, TR = true;
    GAS bf16* UT;
    __device__ __forceinline__ void operator()(const f32x4 (&acc)[2][2][4][2], const Unit& u, int wr, int wc, int fr, int fq) const {
#pragma unroll
        for (int ai = 0; ai < 2; ++ai)
#pragma unroll
            for (int bj = 0; bj < 2; ++bj)
#pragma unroll
                for (int n = 0; n < 2; ++n) { const int ch = (u.pn - 3) * 256 + bj * 128 + wc * 32 + 8 * (fr >> 2) + 4 * n + (fr & 3);
#pragma unroll
                    for (int mp = 0; mp < 2; ++mp) { unsigned wx[2], wy[2];
#pragma unroll
                        for (int q = 0; q < 2; ++q) { const f32x4 v = acc[ai][bj][2 * mp + q][n]; wx[q] = cvt_pk_bf16(v[0], v[1]); wy[q] = cvt_pk_bf16(v[2], v[3]); }
                        auto rx = __builtin_amdgcn_permlane16_swap(wx[0], wx[1], false, false); auto ry = __builtin_amdgcn_permlane16_swap(wy[0], wy[1], false, false);
                        const v4u w = {(unsigned)rx[0], (unsigned)ry[0], (unsigned)rx[1], (unsigned)ry[1]};
                        const int row = u.pm * 256 + ai * 128 + wr * 64 + 16 * (2 * mp + (fq & 1)) + 4 * (fq & 2);
                        *(GAS v4u*)(UT + (size_t)ch * T + row) = w; } }
    }
};
struct EpiMerge {
    static constexpr bool PERM = true;
    const GAS bf16* GATE; GAS bf16* MM;
    __device__ __forceinline__ void operator()(const f32x4 (&acc)[2][2][4][2], const Unit& u, int wr, int wc, int fr, int fq) const {
        const int which = u.pn >> 2, pnl = u.pn & 3, pml = u.pm & 127;
#pragma unroll
        for (int ai = 0; ai < 2; ++ai) {
            v4u g[4][2], p[4][2];
#pragma unroll
            for (int m = 0; m < 4; ++m)
#pragma unroll
                for (int bj = 0; bj < 2; ++bj) { const int row = pml * 256 + ai * 128 + wr * 64 + m * 16 + fr, col = pnl * 256 + bj * 128 + wc * 32 + 8 * fq;
                    g[m][bj] = *(const GAS v4u*)(GATE + (size_t)row * 2048 + which * 1024 + col); p[m][bj] = (v4u){0u, 0u, 0u, 0u}; }
            if (which) {
#pragma unroll
                for (int m = 0; m < 4; ++m)
#pragma unroll
                    for (int bj = 0; bj < 2; ++bj) { const int row = pml * 256 + ai * 128 + wr * 64 + m * 16 + fr, col = pnl * 256 + bj * 128 + wc * 32 + 8 * fq; p[m][bj] = *(const GAS v4u*)(MM + (size_t)row * 1024 + col); } }
#pragma unroll
            for (int m = 0; m < 4; ++m)
#pragma unroll
                for (int bj = 0; bj < 2; ++bj) { const int row = pml * 256 + ai * 128 + wr * 64 + m * 16 + fr, col = pnl * 256 + bj * 128 + wc * 32 + 8 * fq;
                    const v4u gg = g[m][bj], pp = p[m][bj]; const f32x4 v0 = acc[ai][bj][m][0], v1 = acc[ai][bj][m][1];
                    const float o0 = bflo(gg.x) * v0[0] + bflo(pp.x), o1 = bfhi(gg.x) * v0[1] + bfhi(pp.x), o2 = bflo(gg.y) * v0[2] + bflo(pp.y), o3 = bfhi(gg.y) * v0[3] + bfhi(pp.y);
                    const float o4 = bflo(gg.z) * v1[0] + bflo(pp.z), o5 = bfhi(gg.z) * v1[1] + bfhi(pp.z), o6 = bflo(gg.w) * v1[2] + bflo(pp.w), o7 = bfhi(gg.w) * v1[3] + bfhi(pp.w);
                    v4u w; w.x = cvt_pk_bf16(o0, o1); w.y = cvt_pk_bf16(o2, o3); w.z = cvt_pk_bf16(o4, o5); w.w = cvt_pk_bf16(o6, o7);
                    *(GAS v4u*)(MM + (size_t)row * 1024 + col) = w; }
        }
    }
};
struct EpiV1 {
    static constexpr bool PERM = false;
    const GAS float* x; const GAS float* modF; GAS bf16* V1;
    __device__ __forceinline__ void operator()(const f32x4 (&acc)[2][2][4][2], const Unit& u, int wr, int wc, int fr, int fq) const {
        const int col0 = u.pn * 256 + wc * 32 + 4 * fq; const int b = u.pm >> 3;
        f32x4 g1[2][2];
#pragma unroll
        for (int bj = 0; bj < 2; ++bj)
#pragma unroll
            for (int n = 0; n < 2; ++n) g1[bj][n] = *(const GAS f32x4*)(modF + b * 6144 + 2048 + col0 + bj * 128 + n * 16);
#pragma unroll
        for (int ai = 0; ai < 2; ++ai) {
            f32x4 xv[4][2][2];
#pragma unroll
            for (int m = 0; m < 4; ++m) { const size_t off = (size_t)(u.pm * 256 + ai * 128 + wr * 64 + m * 16 + fr) * D + col0;
#pragma unroll
                for (int bj = 0; bj < 2; ++bj)
#pragma unroll
                    for (int n = 0; n < 2; ++n) xv[m][bj][n] = *(const GAS f32x4*)(x + off + bj * 128 + n * 16); }
#pragma unroll
            for (int m = 0; m < 4; ++m) { const size_t off = (size_t)(u.pm * 256 + ai * 128 + wr * 64 + m * 16 + fr) * D + col0;
#pragma unroll
                for (int bj = 0; bj < 2; ++bj)
#pragma unroll
                    for (int n = 0; n < 2; ++n) { const f32x4 r = xv[m][bj][n] * DN_ALPHA + g1[bj][n] * acc[ai][bj][m][n]; u32x2 w; w.x = cvt_pk_bf16(r[0], r[1]); w.y = cvt_pk_bf16(r[2], r[3]); *(GAS u32x2*)(V1 + off + bj * 128 + n * 16) = w; } }
        }
    }
};
struct EpiAct {
    static constexpr bool PERM = true;
    const GAS float* b1; GAS bf16* ACT;
    __device__ __forceinline__ void operator()(const f32x4 (&acc)[2][2][4][2], const Unit& u, int wr, int wc, int fr, int fq) const {
        const int e = u.pn >> 3, pnl = u.pn & 7, colo = pnl * 128 + wc * 32 + 8 * fq;
        f32x4 bg[2], bl[2];
#pragma unroll
        for (int n = 0; n < 2; ++n) { bg[n] = *(const GAS f32x4*)(b1 + e * 2048 + colo + 4 * n); bl[n] = *(const GAS f32x4*)(b1 + e * 2048 + 1024 + colo + 4 * n); }
#pragma unroll
        for (int ai = 0; ai < 2; ++ai)
#pragma unroll
            for (int mp = 0; mp < 2; ++mp) { unsigned wx[2], wy[2];
#pragma unroll
                for (int q = 0; q < 2; ++q) { const int m = 2 * mp + q; float o[8];
#pragma unroll
                    for (int n = 0; n < 2; ++n)
#pragma unroll
                        for (int j = 0; j < 4; ++j) { float gl = acc[ai][0][m][n][j] * (1.f / 256.f) + bg[n][j], li = acc[ai][1][m][n][j] * (1.f / 256.f) + bl[n][j];
                            gl = fminf(gl, 7.f); li = fminf(fmaxf(li, -7.f), 7.f); o[4 * n + j] = gl * sigmoidf_(1.702f * gl) * (li + 1.f); }
                    wx[q] = pk4_fp8(o[0], o[1], o[2], o[3]); wy[q] = pk4_fp8(o[4], o[5], o[6], o[7]); }
                auto rx = __builtin_amdgcn_permlane16_swap(wx[0], wx[1], false, false); auto ry = __builtin_amdgcn_permlane16_swap(wy[0], wy[1], false, false);
                const v4u w = {(unsigned)rx[0], (unsigned)ry[0], (unsigned)rx[1], (unsigned)ry[1]};
                const int row = u.pm * 256 + ai * 128 + wr * 64 + (2 * mp + (fq & 1)) * 16 + fr;
                *(GAS v4u*)((GAS unsigned char*)ACT + (size_t)row * 1024 + colo - 8 * (fq & 1)) = w; }
    }
};
#ifndef ABL_EPI
#define ABL_EPI 0
#endif
struct EpiYb {
    static constexpr bool PERM = true;
    const GAS float* b2; GAS bf16* YB; int abl = 0;
    __device__ __forceinline__ void operator()(const f32x4 (&acc)[2][2][4][2], const Unit& u, int wr, int wc, int fr, int fq) const {
        const int e = u.pn >> 2, pnl = u.pn & 3;
#pragma unroll
        for (int bj = 0; bj < 2; ++bj) { const int col = pnl * 256 + bj * 128 + wc * 32 + 8 * fq;
            const f32x4 b0 = *(const GAS f32x4*)(b2 + e * 1024 + col), b1v = *(const GAS f32x4*)(b2 + e * 1024 + col + 4);
#pragma unroll
            for (int ai = 0; ai < 2; ++ai)
#pragma unroll
                for (int mp = 0; mp < 2; ++mp) { unsigned wx[2], wy[2];
#pragma unroll
                    for (int q = 0; q < 2; ++q) { const int m = 2 * mp + q; const f32x4 v0 = acc[ai][bj][m][0] * (1.f / 256.f) + b0, v1 = acc[ai][bj][m][1] * (1.f / 256.f) + b1v;
                        wx[q] = pk4_fp8(v0[0], v0[1], v0[2], v0[3]); wy[q] = pk4_fp8(v1[0], v1[1], v1[2], v1[3]); }
                    auto rx = __builtin_amdgcn_permlane16_swap(wx[0], wx[1], false, false); auto ry = __builtin_amdgcn_permlane16_swap(wy[0], wy[1], false, false);
                    const v4u w = {(unsigned)rx[0], (unsigned)ry[0], (unsigned)rx[1], (unsigned)ry[1]};
                    const int row = u.pm * 256 + ai * 128 + wr * 64 + (2 * mp + (fq & 1)) * 16 + fr;
                    *(GAS v4u*)((GAS unsigned char*)YB + (size_t)row * 1024 + col - 8 * (fq & 1)) = w; } }
    }
};
struct EpiYbW {
    static constexpr bool PERM = true, WIDE = true;
    const GAS float* b2; GAS bf16* YB; int abl = 0;
    __device__ __forceinline__ void operator()(const f32x4 (&acc)[2][2][4][2], const Unit& u, int wr, int wc, int fr, int fq) const {
        const int e = u.pn >> 2, pnl = u.pn & 3;
#pragma unroll
        for (int bj = 0; bj < 2; ++bj) { const int col = pnl * 256 + wc * 64 + bj * 32 + 8 * fq;
            f32x4 b0 = {0.f, 0.f, 0.f, 0.f}, b1v = {0.f, 0.f, 0.f, 0.f}; if (abl != 2) { b0 = *(const GAS f32x4*)(b2 + e * 1024 + col); b1v = *(const GAS f32x4*)(b2 + e * 1024 + col + 4); }
#pragma unroll
            for (int ai = 0; ai < 2; ++ai)
#pragma unroll
                for (int m = 0; m < 4; ++m) { const int row = u.pm * 256 + ai * 128 + wr * 64 + m * 16 + fr; const f32x4 v0 = acc[ai][bj][m][0] * (1.f / 256.f) + b0, v1 = acc[ai][bj][m][1] * (1.f / 256.f) + b1v;
                    u32x2 w; w.x = pk4_fp8(v0[0], v0[1], v0[2], v0[3]); w.y = pk4_fp8(v1[0], v1[1], v1[2], v1[3]);
                    if (abl != 1) *(GAS u32x2*)((GAS unsigned char*)YB + (size_t)row * 1024 + col) = w; else asm volatile("" :: "v"(w)); } }
    }
};

struct EpiYbX {
    static constexpr bool PERM = true;
    const GAS float* b2; GAS bf16* YB; int abl = 0;
    __device__ __forceinline__ void operator()(const f32x4 (&acc)[2][2][4][2], const Unit& u, int wr, int wc, int fr, int fq) const {
        const int e = u.pn >> 2, pnl = u.pn & 3;
#pragma unroll
        for (int bj = 0; bj < 2; ++bj) { const int col = pnl * 256 + bj * 128 + wc * 32 + 8 * fq;
            const f32x4 b0 = *(const GAS f32x4*)(b2 + e * 1024 + col), b1v = *(const GAS f32x4*)(b2 + e * 1024 + col + 4);
#pragma unroll
            for (int ai = 0; ai < 2; ++ai)
#pragma unroll
                for (int mp = 0; mp < 2; ++mp) { unsigned wx[2], wy[2];
#pragma unroll
                    for (int q = 0; q < 2; ++q) { const int m = 2 * mp + q; const f32x4 v0 = acc[ai][bj][m][0] * (1.f / 256.f) + b0, v1 = acc[ai][bj][m][1] * (1.f / 256.f) + b1v;
                        wx[q] = pk4_fp8(v0[0], v0[1], v0[2], v0[3]); wy[q] = pk4_fp8(v1[0], v1[1], v1[2], v1[3]); }
                    auto rx = __builtin_amdgcn_permlane16_swap(wx[0], wx[1], false, false); auto ry = __builtin_amdgcn_permlane16_swap(wy[0], wy[1], false, false);
                    const v4u o = {(unsigned)rx[0], (unsigned)ry[0], (unsigned)rx[1], (unsigned)ry[1]};
                    const int row = u.pm * 256 + ai * 128 + wr * 64 + (2 * mp + (fq & 1)) * 16 + fr;
                    *(GAS v4u*)((GAS unsigned char*)YB + (size_t)row * 1024 + col - 8 * (fq & 1)) = o; } }
    }
};


#define HPT_B(k) do { if (PROBE_SPIN == (k)) F.pt0 = rt(); } while (0)
#define HPT_E(k) do { if (PROBE_SPIN == (k)) F.ptacc += rt() - F.pt0; } while (0)
__device__ __forceinline__ int crow(int r, int hi) { return (r & 3) + 8 * (r >> 2) + 4 * hi; }
__device__ __forceinline__ void attn_step(const bool MASK, const LAS unsigned char* Kl, const LAS unsigned char* Vl, const int pitchV, const int kvoff, const bf16x8 (&qf)[2][4],
                                          float (&mrun)[2], float (&lrun)[2], f32x16 (&o)[2][2], const int r32, const int hi, const int dq0) {
    bf16x8 kf[4], vf[2][2];
#pragma unroll
    for (int ks = 0; ks < 4; ++ks) kf[ks] = *(const LAS bf16x8*)(Kl + (kvoff + r32) * 144 + ks * 32 + hi * 16);
#pragma unroll
    for (int dt = 0; dt < 2; ++dt)
#pragma unroll
        for (int s2 = 0; s2 < 2; ++s2) vf[dt][s2] = *(const LAS bf16x8*)(Vl + (32 * dt + r32) * pitchV + (kvoff + 16 * s2) * 2 + hi * 16);
#pragma unroll
    for (int qt = 0; qt < 2; ++qt) {
        f32x16 s = {0.f, 0.f, 0.f, 0.f, 0.f, 0.f, 0.f, 0.f, 0.f, 0.f, 0.f, 0.f, 0.f, 0.f, 0.f, 0.f};
#pragma unroll
        for (int ks = 0; ks < 4; ++ks) s = __builtin_amdgcn_mfma_f32_32x32x16_bf16(kf[ks], qf[qt][ks], s, 0, 0, 0);
        if (MASK) {
#pragma unroll
            for (int r = 0; r < 16; ++r) { const int dd = dq0 - 32 * qt + crow(r, hi); if (dd > 128 || dd < -128) s[r] = -INFINITY; }
        }
        float mx = fmaxf(fmaxf(s[0], s[1]), s[2]);
#pragma unroll
        for (int r = 3; r < 15; r += 2) mx = fmaxf(fmaxf(mx, s[r]), s[r + 1]);
        mx = fmaxf(mx, s[15]);
        { const unsigned u = __builtin_bit_cast(unsigned, mx); auto rr = __builtin_amdgcn_permlane32_swap(u, u, false, false); mx = fmaxf(__builtin_bit_cast(float, (unsigned)rr[0]), __builtin_bit_cast(float, (unsigned)rr[1])); }
        if (__any(mx > mrun[qt])) {
            const float mn = fmaxf(mrun[qt], mx), f = __builtin_amdgcn_exp2f(mrun[qt] - mn); mrun[qt] = mn; lrun[qt] *= f;
#pragma unroll
            for (int dt = 0; dt < 2; ++dt) o[qt][dt] = o[qt][dt] * f;
        }
        const float mn = mrun[qt];
        float ps = 0.f;
#pragma unroll
        for (int r = 0; r < 16; ++r) { const float p = __builtin_amdgcn_exp2f(s[r] - mn); s[r] = p; ps += p; }
        lrun[qt] += ps;
        bf16x8 pb[2];
#pragma unroll
        for (int s2 = 0; s2 < 2; ++s2) { v4u w; w.x = cvt_pk_bf16(s[8 * s2 + 0], s[8 * s2 + 1]); w.y = cvt_pk_bf16(s[8 * s2 + 2], s[8 * s2 + 3]); w.z = cvt_pk_bf16(s[8 * s2 + 4], s[8 * s2 + 5]); w.w = cvt_pk_bf16(s[8 * s2 + 6], s[8 * s2 + 7]);
            pb[s2] = __builtin_bit_cast(bf16x8, w); }
#pragma unroll
        for (int dt = 0; dt < 2; ++dt)
#pragma unroll
            for (int s2 = 0; s2 < 2; ++s2) o[qt][dt] = __builtin_amdgcn_mfma_f32_32x32x16_bf16(vf[dt][s2], pb[s2], o[qt][dt], 0, 0, 0);
    }
}
__device__ __forceinline__ void attn_unit(Frame& F, int b, int kvh, int qb) {
    LAS unsigned char* lds = F.lds;
    const int tid = F.tid, lane = F.lane, w = F.wave, r32 = lane & 31, hi = lane >> 5;
    const int h = kvh * 4 + (w >> 1), s0 = qb * 128, q0 = s0 + 64 * (w & 1);
    bf16x8 qf[2][4];
#pragma unroll
    for (int qt = 0; qt < 2; ++qt)
#pragma unroll
        for (int ks = 0; ks < 4; ++ks) qf[qt][ks] = *(const GAS bf16x8*)(F.Q + (size_t)(b * SEQ + q0 + 32 * qt + r32) * QW + h * 64 + 16 * ks + 8 * hi);
    float mrun[2] = {-INFINITY, -INFINITY}, lrun[2] = {0.f, 0.f};
    f32x16 o[2][2];
#pragma unroll
    for (int qt = 0; qt < 2; ++qt)
#pragma unroll
        for (int dt = 0; dt < 2; ++dt)
#pragma unroll
            for (int r = 0; r < 16; ++r) o[qt][dt][r] = 0.f;
    {
        HPT_B(30);
        LAS unsigned char* Kl = lds; LAS unsigned char* Vl = lds + 36864;
        v4u rk[4], rv[4];
#pragma unroll
        for (int i = 0; i < 4; ++i) { const int idx = tid + 512 * i; rk[i] = *(const GAS v4u*)(F.KC + (size_t)(b * CTXL + (idx >> 3)) * KVW + kvh * 64 + (idx & 7) * 8);
            rv[i] = *(const GAS v4u*)(F.VTC + (size_t)((b * 2 + kvh) * 64 + (idx >> 5)) * CTXL + (idx & 31) * 8); }
#pragma unroll
        for (int i = 0; i < 4; ++i) { const int idx = tid + 512 * i; *(LAS v4u*)(Kl + (idx >> 3) * 144 + (idx & 7) * 16) = rk[i]; { const int ch = idx & 31; LAS unsigned char* vd = Vl + (idx >> 5) * 528 + (ch >> 1) * 32 + (ch & 1) * 8; *(LAS u32x2*)vd = (u32x2){rv[i].x, rv[i].y}; *(LAS u32x2*)(vd + 16) = (u32x2){rv[i].z, rv[i].w}; } }
        __syncthreads(); HPT_E(30); HPT_B(31);
        for (int st = 0; st < 8; ++st) attn_step(false, Kl, Vl, 528, 32 * st, qf, mrun, lrun, o, r32, hi, 0);
        __syncthreads(); HPT_E(31);
    }
    {
        LAS unsigned char* Kl = lds; LAS unsigned char* Vl = lds + 55296; const int kbase = s0 - 128;
        HPT_B(32);
        v4u rk[6], rv[6];
#pragma unroll
        for (int i = 0; i < 6; ++i) { const int idx = tid + 512 * i; { const int row = idx >> 3, ch = idx & 7; int kp = kbase + row; kp = kp < 0 ? 0 : (kp >= SEQ ? SEQ - 1 : kp); rk[i] = *(const GAS v4u*)(F.K + (size_t)(b * SEQ + kp) * KVW + kvh * 64 + ch * 8); }
            { const int row = idx / 48, ch = idx % 48; int kp = kbase + 8 * ch; kp = kp < 0 ? 0 : (kp >= SEQ ? SEQ - 8 : kp); rv[i] = *(const GAS v4u*)(F.VT + (size_t)((b * 2 + kvh) * 64 + row) * SEQ + kp); } }
#pragma unroll
        for (int i = 0; i < 6; ++i) { const int idx = tid + 512 * i; *(LAS v4u*)(Kl + (idx >> 3) * 144 + (idx & 7) * 16) = rk[i]; { const int ch = idx % 48; LAS unsigned char* vd = Vl + (idx / 48) * 784 + (ch >> 1) * 32 + (ch & 1) * 8; *(LAS u32x2*)vd = (u32x2){rv[i].x, rv[i].y}; *(LAS u32x2*)(vd + 16) = (u32x2){rv[i].z, rv[i].w}; } }
        __syncthreads(); HPT_E(32); HPT_B(33);
        for (int st = 0; st < 10; ++st) { const int kp0 = q0 - 128 + 32 * st; if (kp0 < 0 || kp0 >= SEQ) continue;
            attn_step(st < 2 || st >= 8, Kl, Vl, 784, kp0 - kbase, qf, mrun, lrun, o, r32, hi, kp0 - q0 - r32); }
        __syncthreads();
    }
    HPT_E(33);
    const float sk = F.sink[h] * LOG2E;
#pragma unroll
    for (int qt = 0; qt < 2; ++qt) { float l = lrun[qt] + __shfl_xor(lrun[qt], 32); l += __builtin_amdgcn_exp2f(sk - mrun[qt]); const float inv = 1.f / l;
        GAS bf16* op = F.ATT + (size_t)(b * SEQ + q0 + 32 * qt + r32) * QW + h * 64;
#pragma unroll
        for (int dt = 0; dt < 2; ++dt)
#pragma unroll
            for (int rg = 0; rg < 4; ++rg) { u32x2 wv; wv.x = cvt_pk_bf16(o[qt][dt][4 * rg] * inv, o[qt][dt][4 * rg + 1] * inv); wv.y = cvt_pk_bf16(o[qt][dt][4 * rg + 2] * inv, o[qt][dt][4 * rg + 3] * inv);
                *(GAS u32x2*)(op + 32 * dt + 8 * rg + 4 * hi) = wv; } }
}

constexpr int HZ_PITCH = 4112, HG_OFF = 16 * HZ_PITCH  , HG_PITCH = 8224;
__device__ __forceinline__ void hy_load_filter(LAS unsigned char* GC, const GAS bf16* G, int tid) {
    const GAS v4u* gp = (const GAS v4u*)G;
    const v4u a = gp[tid]; v4u b = {0u, 0u, 0u, 0u}; if (tid < 511) b = gp[tid + 1];
    const unsigned w[8] = {a.x, a.y, a.z, a.w, b.x, b.y, b.z, b.w};
#pragma unroll
    for (int rho = 0; rho < 8; ++rho) { v4u o; unsigned t[4];
#pragma unroll
        for (int dd = 0; dd < 4; ++dd) { const int base = (rho >> 1) + dd; t[dd] = (rho & 1) ? __builtin_amdgcn_alignbit(w[base + 1 > 7 ? 7 : base + 1], w[base], 16) : w[base]; }
        o.x = t[0]; o.y = t[1]; o.z = t[2]; o.w = t[3];
        *(LAS v4u*)(GC + rho * HG_PITCH + tid * 16) = o; }
}
__device__ __forceinline__ f32x4 hy_short4(const GAS bf16* up, int t, float w0, float w1, float w2, float bs) {
    const u32x2 v = *(const GAS u32x2*)(up + t);
    const float u0 = bflo(v.x), u1 = bfhi(v.x), u2 = bflo(v.y), u3 = bfhi(v.y);
    const float um = t > 0 ? bf2f(up[t - 1]) : 0.f, up4 = t + 4 < SEQ ? bf2f(up[t + 4]) : 0.f;
    f32x4 r; r[0] = bs + w0 * um + w1 * u0 + w2 * u1; r[1] = bs + w0 * u0 + w1 * u1 + w2 * u2; r[2] = bs + w0 * u1 + w1 * u2 + w2 * u3; r[3] = bs + w0 * u2 + w1 * u3 + w2 * up4; return r;
}
__device__ __forceinline__ void hy_conv(const LAS unsigned char* Z, const LAS unsigned char* GC, int T0, int fr, int fq, f32x4 (&acc)[16]) {
    const int rho = (8 - (fr & 7)) & 7;
    const LAS unsigned char* gb = GC + rho * HG_PITCH + (2048 - fr + 8 * fq - rho - T0) * 2;
    const LAS unsigned char* zb = Z + fr * HZ_PITCH + fq * 16;
    bf16x8 W[16], Bf, nA0, nA1, nB;
#pragma unroll
    for (int m = 0; m < 16; ++m) { W[m] = *(const LAS bf16x8*)(gb + (-16 * m) * 2); acc[m] = (f32x4){0.f, 0.f, 0.f, 0.f}; }
    Bf = *(const LAS bf16x8*)zb;
    for (int jj = 0; jj < 8; ++jj) {
#pragma unroll
        for (int ji = 0; ji < 8; ++ji) {
            const int j = 8 * jj + ji, jn = j + 1 < 64 ? j + 1 : 63;
            nA0 = *(const LAS bf16x8*)(gb + (32 * jn) * 2); nA1 = *(const LAS bf16x8*)(gb + (32 * jn - 16) * 2); nB = *(const LAS bf16x8*)(zb + 64 * jn);
            __builtin_amdgcn_sched_barrier(0);
#pragma unroll
            for (int m = 0; m < 16; ++m) acc[m] = __builtin_amdgcn_mfma_f32_16x16x32_bf16(W[(m - 2 * ji) & 15], Bf, acc[m], 0, 0, 0);
            W[(-2 * (ji + 1)) & 15] = nA0; W[(1 - 2 * (ji + 1)) & 15] = nA1; Bf = nB;
        }
    }
}
__device__ __forceinline__ void hyena_channel(Frame& F, int c) {
    LAS unsigned char* Z = F.lds; LAS unsigned char* GC = F.lds + HG_OFF;
    const int tid = F.tid, lane = F.lane, fr = lane & 15, fq = lane >> 4, T0 = 256 * F.wave;
    HPT_B(13);
    { const int cv = 1024 + c; const float w0 = F.cw[cv], w1 = F.cw[1536 + cv], w2 = F.cw[3072 + cv], bs = F.cb[cv];
#pragma unroll 1
      for (int i0 = 0; i0 < 8; i0 += 4) {
      v4u raw[4]; unsigned short hm1[4], hp8[4];
#pragma unroll
      for (int i = 0; i < 4; ++i) { const int chunk = tid + 512 * (i0 + i), b = chunk >> 8, tc = (chunk & 255) * 8; const GAS bf16* up = F.UT + (size_t)cv * T + b * SEQ;
          raw[i] = *(const GAS v4u*)(up + tc); hm1[i] = tc > 0 ? up[tc - 1] : (unsigned short)0; hp8[i] = tc + 8 < SEQ ? up[tc + 8] : (unsigned short)0; }
#pragma unroll
      for (int i = 0; i < 4; ++i) { const int chunk = tid + 512 * (i0 + i), b = chunk >> 8, tc = (chunk & 255) * 8;
          float u[10]; u[0] = bf2f(hm1[i]); u[1] = bflo(raw[i].x); u[2] = bfhi(raw[i].x); u[3] = bflo(raw[i].y); u[4] = bfhi(raw[i].y); u[5] = bflo(raw[i].z); u[6] = bfhi(raw[i].z); u[7] = bflo(raw[i].w); u[8] = bfhi(raw[i].w); u[9] = bf2f(hp8[i]);
          float r[8];
#pragma unroll
          for (int k = 0; k < 8; ++k) r[k] = bs + w0 * u[k] + w1 * u[k + 1] + w2 * u[k + 2];
          v4u o; o.x = pk2(r[0], r[1]); o.y = pk2(r[2], r[3]); o.z = pk2(r[4], r[5]); o.w = pk2(r[6], r[7]);
          *(LAS v4u*)(Z + b * HZ_PITCH + tc * 2) = o; } } }
    hy_load_filter(GC, F.G_ + (size_t)c * 4096, tid);
    __syncthreads(); HPT_E(13);
    f32x4 acc[16];
    HPT_B(11); hy_conv(Z, GC, T0, fr, fq, acc); HPT_E(11);
    HPT_B(14);
    { const float w0 = F.cw[c], w1 = F.cw[1536 + c], w2 = F.cw[3072 + c], bs = F.cb[c], sk = F.skip[c]; const GAS bf16* up = F.UT + (size_t)c * T + fr * SEQ;
#pragma unroll
      for (int m = 0; m < 16; ++m) { int t = T0 + 16 * m + 4 * fq; asm volatile("" : "+v"(t)); const u32x2 zo = *(const LAS u32x2*)(Z + fr * HZ_PITCH + t * 2); const f32x4 xs = hy_short4(up, t, w0, w1, w2, bs);
          acc[m][0] = xs[0] * (acc[m][0] + sk * bflo(zo.x)); acc[m][1] = xs[1] * (acc[m][1] + sk * bfhi(zo.x)); acc[m][2] = xs[2] * (acc[m][2] + sk * bflo(zo.y)); acc[m][3] = xs[3] * (acc[m][3] + sk * bfhi(zo.y)); } }
    HPT_E(14); HPT_B(15);
    __syncthreads();
#pragma unroll
    for (int m = 0; m < 16; ++m) { const int t = T0 + 16 * m + 4 * fq; u32x2 wv; wv.x = pk2(acc[m][0], acc[m][1]); wv.y = pk2(acc[m][2], acc[m][3]); *(LAS u32x2*)(Z + fr * HZ_PITCH + t * 2) = wv; }
    hy_load_filter(GC, F.G_ + (size_t)(512 + c) * 4096, tid);
    __syncthreads(); HPT_E(15);
    HPT_B(11); hy_conv(Z, GC, T0, fr, fq, acc); HPT_E(11);
    HPT_B(12);
    { const int cx = 512 + c; const float w0 = F.cw[cx], w1 = F.cw[1536 + cx], w2 = F.cw[3072 + cx], bs = F.cb[cx], sk = F.skip[512 + c]; const GAS bf16* up = F.UT + (size_t)cx * T + fr * SEQ;
      GAS bf16* hp = F.HYT + (size_t)c * T + fr * SEQ;
#pragma unroll
      for (int m = 0; m < 16; ++m) { int t = T0 + 16 * m + 4 * fq; asm volatile("" : "+v"(t)); const u32x2 zo = *(const LAS u32x2*)(Z + fr * HZ_PITCH + t * 2); const f32x4 xs = hy_short4(up, t, w0, w1, w2, bs);
          u32x2 wv; wv.x = pk2(xs[0] * (acc[m][0] + sk * bflo(zo.x)), xs[1] * (acc[m][1] + sk * bfhi(zo.x))); wv.y = pk2(xs[2] * (acc[m][2] + sk * bflo(zo.y)), xs[3] * (acc[m][3] + sk * bfhi(zo.y)));
          *(GAS u32x2*)(hp + t) = wv; } }
    __syncthreads();
    HPT_E(12);
}

__device__ __forceinline__ void hyt_transpose(Frame& F) {
    LAS unsigned short* scr = (LAS unsigned short*)(F.lds + F.wave * 16384);
    const int gw = F.vcu * NWAVES + F.wave, NGW = F.G * NWAVES, lane = F.lane, tcx = lane & 7, r8 = lane >> 3;
    GAS bf16* HY = F.ATT + (size_t)T * QW;
    for (int it = gw; it < 4096; it += NGW) {
        const int cb = it & 7, tb = it >> 3;
        v4u raw[8];
#pragma unroll
        for (int i = 0; i < 8; ++i) raw[i] = *(const GAS v4u*)(F.HYT + (size_t)(64 * cb + r8 + 8 * i) * T + 64 * tb + 8 * tcx);
#pragma unroll
        for (int i = 0; i < 8; ++i) { const int ch = r8 + 8 * i; LAS unsigned short* d = scr + (8 * tcx) * 66 + ch;
            d[0 * 66] = (unsigned short)raw[i].x; d[1 * 66] = (unsigned short)(raw[i].x >> 16); d[2 * 66] = (unsigned short)raw[i].y; d[3 * 66] = (unsigned short)(raw[i].y >> 16);
            d[4 * 66] = (unsigned short)raw[i].z; d[5 * 66] = (unsigned short)(raw[i].z >> 16); d[6 * 66] = (unsigned short)raw[i].w; d[7 * 66] = (unsigned short)(raw[i].w >> 16); }
        LDS_WAIT(); asm volatile("" ::: "memory");
#pragma unroll
        for (int i = 0; i < 8; ++i) { const int t = r8 + 8 * i; const LAS unsigned* sp = (const LAS unsigned*)(scr + t * 66 + 8 * tcx);
            v4u o; o.x = sp[0]; o.y = sp[1]; o.z = sp[2]; o.w = sp[3];
            *(GAS v4u*)(HY + (size_t)(64 * tb + t) * HYW + 64 * cb + 8 * tcx) = o; }
        LDS_WAIT(); asm volatile("" ::: "memory");
    }
}

__device__ __forceinline__ void load_row16(const GAS bf16* base, int row, int lane, f32x4 (&v)[4]) {
    const GAS u32x2* vr = (const GAS u32x2*)(base + (size_t)row * D) + lane;
    u32x2 t[4];
#pragma unroll
    for (int j = 0; j < 4; ++j) t[j] = vr[64 * j];
#pragma unroll
    for (int j = 0; j < 4; ++j) v[j] = (f32x4){bflo(t[j].x), bfhi(t[j].x), bflo(t[j].y), bfhi(t[j].y)};
}
__device__ __forceinline__ void ln_inplace(f32x4 (&v)[4]) {
    float s = 0.f;
#pragma unroll
    for (int j = 0; j < 4; ++j) s += (v[j].x + v[j].y) + (v[j].z + v[j].w);
    const float mean = wave_sum(s) * (1.f / D); float s2 = 0.f;
#pragma unroll
    for (int j = 0; j < 4; ++j) { v[j] = v[j] - mean; s2 += (v[j].x * v[j].x + v[j].y * v[j].y) + (v[j].z * v[j].z + v[j].w * v[j].w); }
    const float rstd = 1.f / sqrtf(wave_sum(s2) * (1.f / D) + LN_EPS);
#pragma unroll
    for (int j = 0; j < 4; ++j) v[j] = v[j] * rstd;
}
typedef _Float16 f16x8 __attribute__((ext_vector_type(8)));
typedef _Float16 f16x4 __attribute__((ext_vector_type(4)));
__device__ __forceinline__ void ln_inplace4(f32x4 (&v)[4][4]) {
    float s[4], q[4];
#pragma unroll
    for (int r = 0; r < 4; ++r) { s[r] = 0.f;
#pragma unroll
        for (int j = 0; j < 4; ++j) s[r] += (v[r][j].x + v[r][j].y) + (v[r][j].z + v[r][j].w); }
#pragma unroll
    for (int r = 0; r < 4; ++r) s[r] = wave_sum(s[r]) * (1.f / D);
#pragma unroll
    for (int r = 0; r < 4; ++r) { q[r] = 0.f;
#pragma unroll
        for (int j = 0; j < 4; ++j) { v[r][j] = v[r][j] - s[r]; q[r] += (v[r][j].x * v[r][j].x + v[r][j].y * v[r][j].y) + (v[r][j].z * v[r][j].z + v[r][j].w * v[r][j].w); } }
#pragma unroll
    for (int r = 0; r < 4; ++r) q[r] = 1.f / sqrtf(wave_sum(q[r]) * (1.f / D) + LN_EPS);
#pragma unroll
    for (int r = 0; r < 4; ++r)
#pragma unroll
        for (int j = 0; j < 4; ++j) v[r][j] = v[r][j] * q[r];
}
__device__ __forceinline__ void p6_route(Frame& F) {
    constexpr int RP = 2064;
    LAS unsigned char* W16 = F.lds;
    LAS unsigned char* HT = F.lds + 32 * RP;
    LAS float* LG = (LAS float*)(F.lds + 64 * RP);
    LAS int* rec = (LAS int*)(F.lds + 64 * RP + 8192);
    LAS float* recg = (LAS float*)(F.lds + 64 * RP + 8192 + 2048);
    LAS int* lcnt = (LAS int*)(F.lds + 64 * RP + 8192 + 4096);
    LAS int* lbase = lcnt + 32;
    const int tid = F.tid, lane = F.lane, w = F.wave, fr = lane & 15, fq = lane >> 4;
    for (int i = tid; i < 32768; i += NWAVES * 64) { const int k = i >> 5, e = i & 31; *(LAS _Float16*)(W16 + e * RP + k * 2) = (_Float16)F.rw[i]; }
    if (tid < 32) lcnt[tid] = 0;
    __syncthreads();
    const float rbias = F.rb[lane & 31];
    const int mt = w & 1, nt = (w >> 1) & 1, kh = w >> 2;
    for (int chunk = blockIdx.x; chunk < 256; chunk += F.G) {
        const int b = chunk >> 4;
#pragma unroll 1
        for (int grp = 0; grp < 4; ++grp) {
            const int rg0 = chunk * 128 + grp * 32;
            {
                f32x4 v[4][4];
#pragma unroll
                for (int rr = 0; rr < 4; ++rr) load_row16(F.V1, rg0 + 4 * w + rr, lane, v[rr]);
                int lo = 4 * lane; asm volatile("" : "+v"(lo));
                ln_inplace4(v);
#pragma unroll
                for (int rr = 0; rr < 4; ++rr)
#pragma unroll
                    for (int j = 0; j < 4; ++j) v[rr][j] = v[rr][j] * *(const GAS f32x4*)(F.ln1g + lo + 256 * j) + *(const GAS f32x4*)(F.ln1b + lo + 256 * j);
                ln_inplace4(v);
#pragma unroll
                for (int rr = 0; rr < 4; ++rr) { const int rl = 4 * w + rr;
#pragma unroll
                    for (int j = 0; j < 4; ++j) { v[rr][j] = v[rr][j] * (*(const GAS f32x4*)(F.modF + b * 6144 + 4096 + lo + 256 * j) + 1.f) + *(const GAS f32x4*)(F.modF + b * 6144 + 3072 + lo + 256 * j);
                        *(GAS unsigned*)((GAS unsigned char*)F.HM + (size_t)(rg0 + rl) * D + 4 * lane + 256 * j) = pk4_fp8(v[rr][j].x, v[rr][j].y, v[rr][j].z, v[rr][j].w);
                        const f16x4 hv = {(_Float16)v[rr][j].x, (_Float16)v[rr][j].y, (_Float16)v[rr][j].z, (_Float16)v[rr][j].w};
                        *(LAS f16x4*)(HT + rl * RP + (4 * lane + 256 * j) * 2) = hv; } }
            }
            __syncthreads();
            {
                f32x4 acc = {0.f, 0.f, 0.f, 0.f};
                const LAS unsigned char* wp = W16 + (16 * nt + fr) * RP + (512 * kh + 8 * fq) * 2; const LAS unsigned char* hp = HT + (16 * mt + fr) * RP + (512 * kh + 8 * fq) * 2;
#pragma unroll 4
                for (int s2 = 0; s2 < 16; ++s2) acc = __builtin_amdgcn_mfma_f32_16x16x32_f16(*(const LAS f16x8*)(wp + 64 * s2), *(const LAS f16x8*)(hp + 64 * s2), acc, 0, 0, 0);
#pragma unroll
                for (int k = 0; k < 4; ++k) LG[(kh * 32 + 16 * mt + fr) * 32 + 16 * nt + 4 * fq + k] = acc[k];
            }
            __syncthreads();
#pragma unroll 1
            for (int i = 0; i < 4; ++i) { const int rl = 4 * w + i;
                float cur = LG[rl * 32 + (lane & 31)] + LG[(32 + rl) * 32 + (lane & 31)] + rbias;
                float tv[4]; int te[4];
#pragma unroll
                for (int k = 0; k < 4; ++k) { const float mx = wave_max(cur);
                    const unsigned long long mask = __ballot(cur == mx); const int src = __ffsll((long long)mask) - 1; te[k] = src & 31; tv[k] = mx; if ((lane & 31) == te[k]) cur = -INFINITY; }
                const float p1 = __expf(tv[1] - tv[0]), p2 = __expf(tv[2] - tv[0]), p3 = __expf(tv[3] - tv[0]), inv = 1.f / (1.f + p1 + p2 + p3);
                if (lane < 4) { const int es = lane == 0 ? te[0] : lane == 1 ? te[1] : lane == 2 ? te[2] : te[3]; const float gs = (lane == 0 ? 1.f : lane == 1 ? p1 : lane == 2 ? p2 : p3) * inv;
                    const int rc = grp * 32 + rl;
                    const int rank = __hip_atomic_fetch_add(lcnt + es, 1, __ATOMIC_RELAXED, __HIP_MEMORY_SCOPE_WORKGROUP);
                    rec[rc * 4 + lane] = es | (rank << 5); recg[rc * 4 + lane] = gs; }
            }
            __syncthreads();
        }
        if (tid < 32) { gu32* cp = F.ctl; asm volatile("" : "+s"(cp)); const int cnt = lcnt[tid]; lbase[tid] = cnt ? (int)__hip_atomic_fetch_add(cp + CW_CNT + tid, (unsigned)cnt, RLX_AGENT) : 0; }
        __syncthreads();
        { const int r = rec[tid], e = r & 31, pos = lbase[e] + (r >> 5), row = chunk * 128 + (tid >> 2);
          F.tok[e * 32768 + pos] = row; F.asg[row * 4 + (tid & 3)] = e * 32768 + pos; F.gw[row * 4 + (tid & 3)] = recg[tid]; }
        __syncthreads();
        if (tid < 32) lcnt[tid] = 0;
        __syncthreads();
    }
}
__device__ __forceinline__ void moe_tables(Frame& F) {
    LAS int* tp = (LAS int*)(F.lds + TP_OFF);
    if (F.tid < 32) { gu32* cp = F.ctl; asm volatile("" : "+s"(cp)); const int cnt = (int)__hip_atomic_load(cp + CW_CNT + F.tid, RLX_AGENT);
        tp[33 + F.tid] = cnt; tp[65 + F.tid] = (cnt + 255) >> 8; }
    __syncthreads();
    if (F.tid < 33) { int a = 0;
        for (int e = 0; e < 32; ++e) a += (e < F.tid) ? tp[65 + e] : 0;
        tp[F.tid] = a; }
    __syncthreads();
}

typedef int i32x4 __attribute__((ext_vector_type(4)));
__device__ __forceinline__ void p9_final(Frame& F) {
    const LAS int* tp = (const LAS int*)(F.lds + TP_OFF);
    const int lane = F.lane;
    f32x4 g1v[4], b1v[4], g2v[4], b2v[4];
#pragma unroll
    for (int j = 0; j < 4; ++j) { const int col = 4 * lane + 256 * j; g1v[j] = *(const GAS f32x4*)(F.ln1g + col); b1v[j] = *(const GAS f32x4*)(F.ln1b + col); g2v[j] = *(const GAS f32x4*)(F.ln2g + col); b2v[j] = *(const GAS f32x4*)(F.ln2b + col); }
    for (int chunk = blockIdx.x; chunk < 256; chunk += F.G) {
        const int b = chunk >> 4, row0 = chunk * 128 + F.wave * 16;
        f32x4 gm[4];
#pragma unroll
        for (int j = 0; j < 4; ++j) gm[j] = *(const GAS f32x4*)(F.modF + b * 6144 + 5120 + 4 * lane + 256 * j);
        f32x4 v[4]; i32x4 a = *(const GAS i32x4*)(F.asg + row0 * 4); f32x4 g = *(const GAS f32x4*)(F.gw + row0 * 4);
        load_row16(F.V1, row0, lane, v);
        for (int it = 0; it < 16; ++it) {
            const int row = row0 + it, rn = it < 15 ? row + 1 : row;
            unsigned y[4][4];
#pragma unroll
            for (int k = 0; k < 4; ++k) { const int e = a[k] >> 15, pos = a[k] & 32767; const GAS unsigned char* yp = (const GAS unsigned char*)F.YB + (size_t)(256 * tp[e] + pos) * D + 4 * lane;
#pragma unroll
                for (int j = 0; j < 4; ++j) y[k][j] = __builtin_nontemporal_load((const GAS unsigned*)(yp + 256 * j)); }
            f32x4 nv[4]; load_row16(F.V1, rn, lane, nv);
            const i32x4 na = *(const GAS i32x4*)(F.asg + rn * 4); const f32x4 ng = *(const GAS f32x4*)(F.gw + rn * 4);
            ln_inplace(v);
#pragma unroll
            for (int j = 0; j < 4; ++j) { f32x4 f = {0.f, 0.f, 0.f, 0.f};
#pragma unroll
                for (int k = 0; k < 4; ++k) { const f32x2 lo = __builtin_amdgcn_cvt_pk_f32_fp8((int)y[k][j], false), hi = __builtin_amdgcn_cvt_pk_f32_fp8((int)y[k][j], true); f[0] += g[k] * lo[0]; f[1] += g[k] * lo[1]; f[2] += g[k] * hi[0]; f[3] += g[k] * hi[1]; }
                v[j] = (v[j] * g1v[j] + b1v[j]) * DN_ALPHA + gm[j] * f; }
            ln_inplace(v);
#pragma unroll
            for (int j = 0; j < 4; ++j) __builtin_nontemporal_store(v[j] * g2v[j] + b2v[j], (GAS f32x4*)(F.out + (size_t)row * D + 4 * lane + 256 * j));
#pragma unroll
            for (int j = 0; j < 4; ++j) v[j] = nv[j];
            a = na; g = ng;
        }
    }
}

struct Args { const float* in[29]; float* out; unsigned char* ws; int ph_lo, ph_hi; };
__global__ void __launch_bounds__(NWAVES * 64, 2) mk_fwd(Args args) {
    extern __shared__ __attribute__((aligned(16))) unsigned char lds[];
    Frame F;
    F.lds = (LAS unsigned char*)lds;
    F.MISC = (volatile LAS unsigned*)(F.lds + MISC_OFF);
    F.tid = threadIdx.x; F.lane = F.tid & 63; F.wave = __builtin_amdgcn_readfirstlane(F.tid >> 6);
    F.G = gridDim.x; { const int bx = blockIdx.x; F.vcu = (F.G % 8 == 0) ? (bx % 8) * (F.G / 8) + bx / 8 : bx; }
    unsigned char* ws = args.ws;
    F.ctl = (gu32*)(ws + WS_CTL);
    F.x = (const GAS float*)args.in[0]; F.c = (const GAS float*)args.in[1]; F.ctx = (const GAS float*)args.in[2]; F.c_ctx = (const GAS float*)args.in[3]; F.w_mod = (const GAS float*)args.in[4]; F.b_mod = (const GAS float*)args.in[5]; F.w_in = (const GAS float*)args.in[6]; F.sink = (const GAS float*)args.in[7];
    F.cw = (const GAS float*)args.in[8]; F.cb = (const GAS float*)args.in[9]; F.fw1 = (const GAS float*)args.in[10]; F.fb1 = (const GAS float*)args.in[11]; F.fw2 = (const GAS float*)args.in[12]; F.fb2 = (const GAS float*)args.in[13]; F.fw3 = (const GAS float*)args.in[14]; F.skip = (const GAS float*)args.in[15];
    F.w_ba = (const GAS float*)args.in[16]; F.w_bh = (const GAS float*)args.in[17]; F.w_out = (const GAS float*)args.in[18]; F.ln1g = (const GAS float*)args.in[19]; F.ln1b = (const GAS float*)args.in[20]; F.rw = (const GAS float*)args.in[21]; F.rb = (const GAS float*)args.in[22];
    F.ew1 = (const GAS float*)args.in[23]; F.eb1 = (const GAS float*)args.in[24]; F.ew2 = (const GAS float*)args.in[25]; F.eb2 = (const GAS float*)args.in[26]; F.ln2g = (const GAS float*)args.in[27]; F.ln2b = (const GAS float*)args.in[28]; F.out = (GAS float*)args.out;
    F.modP = (GAS float*)(ws + WS_MODP); F.modF = (GAS float*)(ws + WS_MODF); F.rope = (GAS float*)(ws + WS_ROPE); F.gw = (GAS float*)(ws + WS_GW); F.V1 = (GAS bf16*)(ws + WS_V1);
    F.asg = (GAS int*)(ws + WS_ASG); F.tok = (GAS int*)(ws + WS_TOK);
    F.G_ = (GAS bf16*)(ws + WS_G); F.WB = (GAS bf16*)(ws + WS_WB); F.WO = (GAS bf16*)(ws + WS_WO); F.WIN = (GAS bf16*)(ws + WS_WIN); F.W1 = (GAS bf16*)(ws + WS_W1); F.W2 = (GAS bf16*)(ws + WS_W2);
    F.HM = (GAS bf16*)(ws + WS_HM); F.HX = (GAS bf16*)(ws + WS_HX); F.Q = (GAS bf16*)(ws + WS_Q); F.K = (GAS bf16*)(ws + WS_K); F.VT = (GAS bf16*)(ws + WS_VT); F.KC = (GAS bf16*)(ws + WS_KC); F.VTC = (GAS bf16*)(ws + WS_VTC);
    F.UT = (GAS bf16*)(ws + WS_UT); F.GATE = (GAS bf16*)(ws + WS_GATE); F.ATT = (GAS bf16*)(ws + WS_ATT); F.MM = (GAS bf16*)(ws + WS_MM); F.ACT = (GAS bf16*)(ws + WS_ACT); F.YB = (GAS bf16*)(ws + WS_YB); F.HYT = (GAS bf16*)(ws + WS_HYT);
    for (int u = F.tid; u < (LDS_BYTES - LDSCTL_OFF) / 4; u += NWAVES * 64) ((LAS unsigned*)(F.lds + LDSCTL_OFF))[u] = 0u;
    __syncthreads();
    XcdBarrier bar; bar.bar = (unsigned*)(F.ctl + CW_BAR); bar.x = 0; bar.st = nullptr;
    if (N_LAUNCHES == 1) bar = xcd_barrier_post((unsigned*)(F.ctl + CW_BAR), F.MISC + 8);
#define GRID_BAR() do { if (N_LAUNCHES == 1) { if (PROBE_SPIN == 20 || PROBE_SPIN == 21 + nbar_) pt0_ = rt(); xcd_barrier(bar); if (PROBE_SPIN == 20 || PROBE_SPIN == 21 + nbar_) ptacc_ += rt() - pt0_; ++nbar_; } } while (0)
    const int lo = args.ph_lo, hi = args.ph_hi;
#ifndef PHMASK
#define PHMASK 0x3ff
#endif
#define IN(k) (((PHMASK >> (k)) & 1) && lo <= (k) && (k) < hi)
#define BOTH(k) (IN(k) && IN((k) + 1))
#define FRESH() do { F.lane = pg8::lane_id_v(); F.tid = F.wave * 64 + F.lane; } while (0)
    const int bx = (int)blockIdx.x;
    unsigned long long pt0_ = 0, ptacc_ = 0; F.pt0 = 0; F.ptacc = 0; int nbar_ = 0;
#define PT_BEGIN(k) do { if (PROBE_SPIN == (k)) pt0_ = rt(); } while (0)
#define PT_END(k) do { if (PROBE_SPIN == (k)) ptacc_ += rt() - pt0_; } while (0)

    if (IN(0)) { FRESH(); PT_BEGIN(0); p0_prologue(F); if (IN(2)) GRID_BAR(); PT_END(0); }
    if (IN(2)) { FRESH();
        pg8::Gemm g{(const bf16*)F.HX, (const bf16*)F.WIN, 1024, F.wave}; PT_BEGIN(2);
        { SchedUhy S; S.so.init(128, 6, F.G, bx); EpiUT E{F.UT}; pg8::gemm_phase<EpiUT, SchedUhy, true, false>(F.lds, g, S, E); }
        FRESH();
        { SchedInProj S; S.so.init(128, 11, F.G, bx); S.G = F.G; S.c = bx; EpiInProj E{F.Q, F.K, F.VT, F.KC, F.VTC, F.GATE, F.rope};
          pg8::gemm_phase<EpiInProj, SchedInProj, true, false>(F.lds, g, S, E); }
        if (BOTH(2)) GRID_BAR(); PT_END(2);
    }
    if (IN(3)) { FRESH();
        PT_BEGIN(3); for (int u = bx; u < 512; u += F.G) attn_unit(F, u >> 5, (u >> 4) & 1, u & 15); PT_END(3);
        FRESH(); PT_BEGIN(10); for (int ch = F.vcu; ch < 512; ch += F.G) hyena_channel(F, ch);
        if (BOTH(3)) GRID_BAR(); PT_END(10);
    }
    if (IN(4)) { FRESH();
        PT_BEGIN(4); hyt_transpose(F); GRID_BAR(); PT_END(4);
        pg8::Gemm g{(const bf16*)F.ATT, (const bf16*)F.WB, 512, F.wave}; SchedPair S; S.so.init(128, 4, F.G, bx);
        EpiMerge E{F.GATE, F.MM};
        PT_BEGIN(17); pg8::gemm_phase<EpiMerge, SchedPair, true, false>(F.lds, g, S, E);
        if (BOTH(4)) GRID_BAR(); PT_END(17);
    }
    if (IN(5)) { FRESH();
        pg8::Gemm g{(const bf16*)F.MM, (const bf16*)F.WO, 1024, F.wave}; SchedPlain S; S.so.init(128, 4, F.G, bx);
        EpiV1 E{F.x, F.modF, F.V1};
        PT_BEGIN(5); pg8::gemm_phase<EpiV1, SchedPlain, true, false>(F.lds, g, S, E);
        if (BOTH(5)) GRID_BAR(); PT_END(5);
    }
    if (IN(6)) { FRESH(); PT_BEGIN(6); p6_route(F); if (BOTH(6)) GRID_BAR(); PT_END(6); }
    if (IN(7)) { FRESH();
        moe_tables(F);
        pg8::Gemm g{(const bf16*)F.HM, (const bf16*)F.W1, 512, F.wave}; SchedMoe S{(const LAS int*)(F.lds + TP_OFF), F.tok, 8, F.G, bx};
        EpiAct E{F.eb1, F.ACT};
        PT_BEGIN(7); pg8::gemm_phase<EpiAct, SchedMoe, true, true, true>(F.lds, g, S, E);
        if (BOTH(7)) GRID_BAR(); PT_END(7);
    }
    if (IN(8)) { FRESH();
        moe_tables(F);
        pg8::Gemm g{(const bf16*)F.ACT, (const bf16*)F.W2, 512, F.wave}; SchedMoe S{(const LAS int*)(F.lds + TP_OFF), F.tok, 4, F.G, bx};
        EpiYb E{F.eb2, F.YB};
        PT_BEGIN(8); pg8::gemm_phase<EpiYb, SchedMoe, true, false, true>(F.lds, g, S, E);
        if (BOTH(8)) GRID_BAR(); PT_END(8);
    }
    if (IN(9)) { FRESH(); PT_BEGIN(9); moe_tables(F); p9_final(F); PT_END(9); }
#ifdef ABL_VAR
    if (IN(9)) { GRID_BAR(); FRESH();
#ifdef ABL_STAGGER
        { const unsigned long long t0s = rt(), dl = (unsigned long long)((bx >> 3) & 3) * ABL_STAGGER; while (rt() - t0s < dl) __builtin_amdgcn_s_sleep(4); }
#endif
        pg8::Gemm g{(const bf16*)F.ACT, (const bf16*)F.W2, 512, F.wave}; SchedMoe S{(const LAS int*)(F.lds + TP_OFF), F.tok, 4, F.G, bx};
#if defined(ABL_X16)
        EpiYbX E{F.eb2, F.YB, ABL_EPI};
        pg8::gemm_phase<EpiYbX, SchedMoe, true, false, true, ABL_VAR>(F.lds, g, S, E); }
#elif defined(ABL_WIDE)
        EpiYbW E{F.eb2, F.YB, ABL_EPI};
        pg8::gemm_phase<EpiYbW, SchedMoe, true, false, true, ABL_VAR>(F.lds, g, S, E); }
#else
        EpiYb E{F.eb2, F.YB, ABL_EPI};
        pg8::gemm_phase<EpiYb, SchedMoe, true, false, true, ABL_VAR>(F.lds, g, S, E); }
#endif
#endif
    if (PROBE_SPIN >= 0 && bx == 0) { const unsigned long long t0_ = rt(); const unsigned long long gacc_ = (PROBE_SPIN == 18 || PROBE_SPIN == 19) ? *(volatile LAS unsigned long long*)(F.lds + 153600) : 0ull; while (rt() - t0_ < ptacc_ + F.ptacc + gacc_) __builtin_amdgcn_s_sleep(8); }
#undef IN
#undef BOTH
#undef GRID_BAR
}

extern "C" void kernel_launch(void* const* d_in, const int* in_sizes, int n_in, void* d_out, int out_size, void* d_ws, size_t ws_size, hipStream_t stream) {
    static int grid = 0;
    if (grid == 0) {
        if (n_in != 29 || in_sizes[0] != T * D || out_size != T * D || ws_size < WS_END) { fprintf(stderr, "kernel_launch: unexpected shapes (n_in %d, in0 %d, out %d, ws %zu); nothing launched\n", n_in, n_in > 0 ? in_sizes[0] : -1, out_size, ws_size); grid = -1; return; }
        int dev = 0, cus = 0, per_cu = 0;
        if (hipGetDevice(&dev) != hipSuccess || hipDeviceGetAttribute(&cus, hipDeviceAttributeMultiprocessorCount, dev) != hipSuccess) { grid = -1; return; }
        if (hipFuncSetAttribute((const void*)mk_fwd, hipFuncAttributeMaxDynamicSharedMemorySize, LDS_BYTES) != hipSuccess) { fprintf(stderr, "kernel_launch: hipFuncSetAttribute failed\n"); grid = -1; return; }
        if (hipOccupancyMaxActiveBlocksPerMultiprocessor(&per_cu, (const void*)mk_fwd, NWAVES * 64, LDS_BYTES) != hipSuccess || per_cu < 1) { fprintf(stderr, "kernel_launch: occupancy query reports %d workgroups per CU\n", per_cu); }
        (void)hipGetLastError();
        grid = cus < 256 ? cus : 256;
    }
    if (grid < 0) return;
    if (hipMemsetAsync((char*)d_ws + WS_CTL, 0, CTL_ZERO_BYTES, stream) != hipSuccess) return;
    Args a{};
    for (int i = 0; i < 29; ++i) a.in[i] = (const float*)d_in[i];
    a.out = (float*)d_out; a.ws = (unsigned char*)d_ws;
    if (N_LAUNCHES == 1) { a.ph_lo = 0; a.ph_hi = NPH; hipLaunchKernelGGL(mk_fwd, dim3(grid), dim3(NWAVES * 64), LDS_BYTES, stream, a); }
    else for (int p = 0; p < NPH; ++p) { a.ph_lo = p; a.ph_hi = p + 1; hipLaunchKernelGGL(mk_fwd, dim3(grid), dim3(NWAVES * 64), LDS_BYTES, stream, a); }
}
```

```cpp
#include <hip/hip_runtime.h>
#include <cstdio>
#include <cstdint>
#include <cmath>
namespace pg8 {
#define PG8_LAS __attribute__((address_space(3)))
typedef unsigned short bf16_t;
typedef short bf16x8 __attribute__((ext_vector_type(8)));
typedef float f32x4 __attribute__((ext_vector_type(4)));
typedef unsigned u32x4 __attribute__((ext_vector_type(4)));
constexpr int BM = 256, BK = 64, HALF = 128, HTB = HALF * BK * 2  , STAGE_BYTES = 8 * HTB, NXCD = 8, WGM = 8;

__host__ __device__ __forceinline__ int lds_byte(int r, int c) { const int st = (r >> 4) * 2 + (c >> 5), rr = r & 15, cc = c & 31, ob = rr * 64 + cc * 2; return st * 1024 + (ob ^ (((ob >> 9) & 1) << 5)); }
__host__ __device__ __forceinline__ void stage_rc(int b, int& R, int& C) { const int st = b / 1024, sb = b % 1024, swz = sb ^ (((sb >> 9) & 1) << 5); R = (st >> 1) * 16 + swz / 64; C = (st & 1) * 32 + (swz % 64) / 2; }
__host__ __device__ __forceinline__ int perm32(int rho) { const int n = rho >> 4, i = rho & 15; return 8 * (i >> 2) + 4 * n + (i & 3); }

struct Unit { int pm, pn; };
struct Gemm { const bf16_t* A; const bf16_t* Bt; int K; int wave; };

struct StaticOrder {
    int nM, nN, nwg, G, c, wgm = WGM;
    __host__ __device__ void init(int nM_, int nN_, int G_, int c_) { nM = nM_; nN = nN_; nwg = nM * nN; G = G_; c = c_; }
    __host__ __device__ bool next(int i, Unit& u) const {
        const long L = (long)i * G + c; if (L >= nwg) return false;
        int wgid = (int)L; { const int q = nwg / NXCD, r = nwg % NXCD, xcd = wgid % NXCD, off = wgid / NXCD; wgid = (xcd < r ? xcd * (q + 1) : r * (q + 1) + (xcd - r) * q) + off; }
        const int nig = wgm * nN, gid = wgid / nig, fm = gid * wgm, gsz = (nM - fm) < wgm ? (nM - fm) : wgm;
        u.pm = fm + ((wgid % nig) % gsz); u.pn = (wgid % nig) / gsz; return true;
    }
};

typedef float f32x2_cv __attribute__((ext_vector_type(2))); typedef __bf16 bf16x2_cv __attribute__((ext_vector_type(2)));
__device__ __forceinline__ unsigned cvt_pk_bf16(float lo, float hi) { const f32x2_cv v = {lo, hi}; const bf16x2_cv b = __builtin_convertvector(v, bf16x2_cv); return __builtin_bit_cast(unsigned, b); }

__device__ __forceinline__ int lane_id_v() { int l; asm volatile("v_mbcnt_lo_u32_b32 %0, -1, 0\n\tv_mbcnt_hi_u32_b32 %0, -1, %0" : "=v"(l)); return l; }
typedef int i32x4_t __attribute__((ext_vector_type(4)));
typedef int i32x8_t __attribute__((ext_vector_type(8)));
__device__ __forceinline__ i32x8_t cat8(bf16x8 lo, bf16x8 hi) { const i32x4_t a = __builtin_bit_cast(i32x4_t, lo), b = __builtin_bit_cast(i32x4_t, hi); return __builtin_shufflevector(a, b, 0, 1, 2, 3, 4, 5, 6, 7); }
#ifndef PROBE_SPIN
#define PROBE_SPIN -1
#endif
#define PG8_PT_B(k) do { if (PROBE_SPIN == (k) && FP8 && !GATHER && tid == 0) pt_t0 = __builtin_amdgcn_s_memrealtime(); } while (0)
#define PG8_PT_E(k) do { if (PROBE_SPIN == (k) && FP8 && !GATHER && tid == 0) *(volatile PG8_LAS unsigned long long*)(lds + 153600) += __builtin_amdgcn_s_memrealtime() - pt_t0; } while (0)
template <class E, class = void> struct epi_wide { static constexpr bool value = false; };
template <class E> struct epi_wide<E, decltype((void)E::WIDE)> { static constexpr bool value = E::WIDE; };
template <class E, class = void> struct epi_wide16 { static constexpr bool value = false; };
template <class E> struct epi_wide16<E, decltype((void)E::WIDE16)> { static constexpr bool value = E::WIDE16; };
__host__ __device__ __forceinline__ int perm16(int rho) { const int n = rho >> 4, i = rho & 15; return 16 * (i >> 2) + 4 * n + (i & 3); }
template <class E, class = void> struct epi_init { static constexpr bool value = false; };
template <class E> struct epi_init<E, decltype((void)E::INIT)> { static constexpr bool value = E::INIT; };
template <class E, class = void> struct epi_tr { static constexpr bool value = false; };
template <class E> struct epi_tr<E, decltype((void)E::TR)> { static constexpr bool value = E::TR; };
template <class Epi, class Sched, bool ALIGN_EPI, bool GATHER, bool FP8 = false, int VAR = 0>
__device__ __forceinline__ void gemm_phase(PG8_LAS unsigned char* lds, const Gemm g, const Sched& S, const Epi& E) {
    const int wid = g.wave, lane = lane_id_v(), tid = wid * 64 + lane, wr = wid >> 2, wc = wid & 3, fr = lane & 15, fq = lane >> 4;
    const int K = g.K, nt = K / BK;
    unsigned voffA[2], voffB[2]; int gR[2]; unsigned gC[2];
    constexpr bool WIDE = epi_wide<Epi>::value, TR = epi_tr<Epi>::value, INIT = epi_init<Epi>::value;
#pragma unroll
    for (int i = 0; i < 2; ++i) { int R, C; stage_rc(tid * 16 + i * 8192, R, C); const int Rb = epi_wide16<Epi>::value ? (64 * (R >> 5) + perm16(R & 31)) : WIDE ? (64 * (R >> 5) + perm32(R & 31)) : (Epi::PERM ? ((R & ~31) + perm32(R & 31)) : R);
        voffA[i] = (unsigned)(R * K + C) * 2u; voffB[i] = (unsigned)(Rb * K + C) * 2u; gR[i] = R; gC[i] = (unsigned)C * 2u; }
    const size_t kstep = (size_t)(BK * 2);
    const size_t hstep = (size_t)HALF * K * 2;
    const size_t tstep = 2 * hstep;
    const size_t r64 = (size_t)64 * K * 2;
    const size_t hstepB = epi_wide16<Epi>::value ? (size_t)8 * K * 2 : WIDE ? (size_t)32 * K * 2 : hstep, r64B = (WIDE || epi_wide16<Epi>::value) ? (size_t)128 * K * 2 : r64;
    const unsigned ldsw = (unsigned)wid * 1024u;
    const int aoff = lds_byte(wr * 64 + fr, fq * 8), boff = lds_byte(wc * 32 + fr, fq * 8);
#define PG8_SA(b, h) (((b) * 2 + (h)) * HTB)
#define PG8_SB(b, h) ((4 + (b) * 2 + (h)) * HTB)
#define PG8_STAGE(bufoff, gbase, voff) do { if constexpr (VAR != 2 && VAR != 5 && VAR != 6) _Pragma("unroll") for (int _i = 0; _i < 2; ++_i) { unsigned v_ = (voff)[0]; if constexpr (FP8) asm volatile("" : "+v"(v_)); \
        __builtin_amdgcn_global_load_lds((const unsigned*)((const char*)(gbase) + (size_t)_i * r64 + v_), (PG8_LAS unsigned*)(lds + (bufoff) + ldsw + _i * 8192), 16, 0, 0); } } while (0)
#define PG8_STAGE_B(bufoff, gbase) do { if constexpr (VAR != 2 && VAR != 5 && VAR != 6) _Pragma("unroll") for (int _i = 0; _i < 2; ++_i) { unsigned v_ = voffB[0]; if constexpr (FP8) asm volatile("" : "+v"(v_)); \
        __builtin_amdgcn_global_load_lds((const unsigned*)((const char*)(gbase) + (size_t)_i * r64B + v_), (PG8_LAS unsigned*)(lds + (bufoff) + ldsw + _i * 8192), 16, 0, 0); } } while (0)
#define PG8_STAGE_G(bufoff, gbase, pk) do { if constexpr (VAR != 2) _Pragma("unroll") for (int _i = 0; _i < 2; ++_i) { unsigned p_ = (pk); asm volatile("" : "+v"(p_));   \
        __builtin_amdgcn_global_load_lds((const unsigned*)((const char*)(gbase) + (((p_ >> (16 * _i)) & 0xffffu) * (unsigned)(K * 2) + gC[0])), (PG8_LAS unsigned*)(lds + (bufoff) + ldsw + _i * 8192), 16, 0, 0); } } while (0)
#define PG8_STAGE_A(b, h, kp, VS) do { if constexpr (GATHER) { PG8_STAGE_G(PG8_SA(b, h), (kp), VS[h]); } else { PG8_STAGE(PG8_SA(b, h), (kp) + (size_t)(h) * hstep, voffA); } } while (0)
#define PG8_LDA(dst, b, h) do { if constexpr (VAR != 1 && VAR != 5 && VAR != 6) _Pragma("unroll") for (int m = 0; m < 4; ++m) { if constexpr (FP8) { dst##8[m] = __builtin_shufflevector(*(const PG8_LAS i32x4_t*)(lds + PG8_SA(b, h) + aoff + m * 2048), *(const PG8_LAS i32x4_t*)(lds + PG8_SA(b, h) + aoff + m * 2048 + 1024), 0, 1, 2, 3, 4, 5, 6, 7); } \
        else { _Pragma("unroll") for (int k = 0; k < 2; ++k) dst[m][k] = *(const PG8_LAS bf16x8*)(lds + PG8_SA(b, h) + aoff + m * 2048 + k * 1024); } } } while (0)
#define PG8_LDB(dst, b, h) do { if constexpr (VAR != 1 && VAR != 5 && VAR != 6) _Pragma("unroll") for (int n = 0; n < 2; ++n) { if constexpr (FP8) { dst##8[n] = __builtin_shufflevector(*(const PG8_LAS i32x4_t*)(lds + PG8_SB(b, h) + boff + n * 2048), *(const PG8_LAS i32x4_t*)(lds + PG8_SB(b, h) + boff + n * 2048 + 1024), 0, 1, 2, 3, 4, 5, 6, 7); } \
        else { _Pragma("unroll") for (int k = 0; k < 2; ++k) dst[n][k] = *(const PG8_LAS bf16x8*)(lds + PG8_SB(b, h) + boff + n * 2048 + k * 1024); } } } while (0)
#define PG8_MMA(ai, bj, At, Bt) do { if constexpr (VAR != 4) __builtin_amdgcn_s_setprio(1); if constexpr (VAR == 3 || VAR == 5 || VAR == 6) { _Pragma("unroll") for (int m_ = 0; m_ < 4; ++m_) { if constexpr (FP8) asm volatile("" :: "v"(At##8[m_])); } _Pragma("unroll") for (int n_ = 0; n_ < 2; ++n_) { if constexpr (FP8) asm volatile("" :: "v"(Bt##8[n_])); } } if constexpr (VAR != 3 && VAR != 5 && VAR != 6) _Pragma("unroll") for (int m = 0; m < 4; ++m) _Pragma("unroll") for (int n = 0; n < 2; ++n) { \
        if constexpr (FP8 && TR) { acc[ai][bj][m][n] = __builtin_amdgcn_mfma_scale_f32_16x16x128_f8f6f4(At##8[m], Bt##8[n], acc[ai][bj][m][n], 0, 0, 0, 0, 0, 0); } \
        else if constexpr (FP8) { acc[ai][bj][m][n] = __builtin_amdgcn_mfma_scale_f32_16x16x128_f8f6f4(Bt##8[n], At##8[m], acc[ai][bj][m][n], 0, 0, 0, 0, 0, 0); } \
        else if constexpr (TR) { _Pragma("unroll") for (int k = 0; k < 2; ++k) acc[ai][bj][m][n] = __builtin_amdgcn_mfma_f32_16x16x32_bf16(At[m][k], Bt[n][k], acc[ai][bj][m][n], 0, 0, 0); } \
        else { _Pragma("unroll") for (int k = 0; k < 2; ++k) acc[ai][bj][m][n] = __builtin_amdgcn_mfma_f32_16x16x32_bf16(Bt[n][k], At[m][k], acc[ai][bj][m][n], 0, 0, 0); } } if constexpr (VAR != 4) __builtin_amdgcn_s_setprio(0); } while (0)
#define PG8_WAIT_V(n) asm volatile("s_waitcnt vmcnt(" #n ")" ::: "memory")
#define PG8_WAIT_V8_SKIPPABLE do { if (!(VAR == 10 && ui > 0 && t == 0)) asm volatile("s_waitcnt vmcnt(8)" ::: "memory"); } while (0)
#define PG8_WAIT_L(n) asm volatile("s_waitcnt lgkmcnt(" #n ")" ::: "memory")
#define PG8_BAR do { if constexpr (VAR != 6) __builtin_amdgcn_s_barrier(); } while (0)
#define PG8_SCHED __builtin_amdgcn_sched_barrier(0)
    unsigned long long pt_t0 = 0;
    Unit cur, nxt; int ui = 0;
    if (!S.next(0, cur)) return;
    f32x4 acc[2][2][4][2];
#pragma unroll
    for (int a = 0; a < 2; ++a)
#pragma unroll
        for (int b = 0; b < 2; ++b)
#pragma unroll
            for (int m = 0; m < 4; ++m)
#pragma unroll
                for (int n = 0; n < 2; ++n) acc[a][b][m][n] = (f32x4){0.f, 0.f, 0.f, 0.f};
    if constexpr (INIT) { const int l_ = lane_id_v(); E.init(acc, cur, wc, l_ >> 4); }
    bf16x8 At[4][2] = {}, B0[2][2] = {}, B1[2][2] = {}; i32x8_t At8[4] = {}, B08[2] = {}, B18[2] = {};
    unsigned vAc[2];
    const char* cA = GATHER ? (const char*)g.A : (const char*)g.A + (size_t)cur.pm * tstep; const char* cB = (const char*)g.Bt + (size_t)cur.pn * tstep;
    if constexpr (GATHER) {
#pragma unroll
        for (int h = 0; h < 2; ++h) vAc[h] = (unsigned)S.rowoff(cur, h * HALF + gR[0]) | ((unsigned)S.rowoff(cur, h * HALF + gR[0] + 64) << 16);
    }
    PG8_STAGE_B(PG8_SB(0, 0), cB); PG8_STAGE_B(PG8_SB(0, 1), cB + hstepB); PG8_STAGE_A(0, 0, cA, vAc); PG8_STAGE_A(0, 1, cA, vAc);
    if (wr == 1) PG8_BAR;
    PG8_WAIT_V(2); PG8_BAR;
    PG8_STAGE_B(PG8_SB(1, 0), cB + kstep); PG8_STAGE_A(1, 0, cA + kstep, vAc); PG8_STAGE_B(PG8_SB(1, 1), cB + hstepB + kstep);
    PG8_WAIT_V(6); PG8_BAR;
    for (;;) {
        const bool has_next = S.next(ui + 1, nxt);
        const char* nA = GATHER ? cA : (has_next ? (const char*)g.A + (size_t)nxt.pm * tstep : cA); const char* nB = has_next ? (const char*)g.Bt + (size_t)nxt.pn * tstep : cB;
        int gr0 = 0, gr1 = 0, gr2 = 0, gr3 = 0;
        if constexpr (GATHER) {
            const int t_ = wid * 64 + lane_id_v(); int R_, C_; stage_rc(t_ * 16, R_, C_);
            if (has_next) { gr0 = S.rowoff(nxt, R_); gr1 = S.rowoff(nxt, R_ + 64); gr2 = S.rowoff(nxt, HALF + R_); gr3 = S.rowoff(nxt, HALF + R_ + 64); }
        }
#pragma unroll 1
        for (int t = 0; t < nt; t += 2) {
            const bool last = (t == nt - 2);
            const char* a1 = cA + (size_t)(t + 1) * kstep;
            const char* a2 = last ? nA : cA + (size_t)(t + 2) * kstep; const char* b2 = last ? nB : cB + (size_t)(t + 2) * kstep;
            const char* a3 = a2 + kstep; const char* b3 = b2 + kstep;
            PG8_LDB(B0, 0, 0); PG8_LDB(B1, 0, 1); PG8_SCHED; PG8_LDA(At, 0, 0); PG8_STAGE_A(1, 1, a1, vAc);
            if constexpr (GATHER) { if (last && has_next) { vAc[0] = (unsigned)gr0 | ((unsigned)gr1 << 16); vAc[1] = (unsigned)gr2 | ((unsigned)gr3 << 16); } }
            PG8_WAIT_V8_SKIPPABLE; PG8_WAIT_L(0); PG8_BAR; PG8_MMA(0, 0, At, B0); PG8_MMA(0, 1, At, B1); PG8_BAR; PG8_SCHED;
            PG8_LDA(At, 0, 1); PG8_STAGE_B(PG8_SB(0, 0), b2); PG8_STAGE_B(PG8_SB(0, 1), b2 + hstepB); PG8_STAGE_A(0, 0, a2, vAc);
            PG8_WAIT_V8_SKIPPABLE; PG8_WAIT_L(0); PG8_BAR; PG8_MMA(1, 0, At, B0); PG8_MMA(1, 1, At, B1); PG8_BAR; PG8_SCHED;
            PG8_LDB(B0, 1, 0); PG8_LDB(B1, 1, 1); PG8_SCHED; PG8_LDA(At, 1, 0); PG8_STAGE_A(0, 1, a2, vAc);
            PG8_WAIT_V8_SKIPPABLE; PG8_WAIT_L(0); PG8_BAR; PG8_MMA(0, 0, At, B0); PG8_MMA(0, 1, At, B1); PG8_BAR; PG8_SCHED;
            PG8_LDA(At, 1, 1); PG8_STAGE_B(PG8_SB(1, 0), b3); PG8_STAGE_B(PG8_SB(1, 1), b3 + hstepB); PG8_STAGE_A(1, 0, a3, vAc);
            PG8_WAIT_V(8); PG8_WAIT_L(0); PG8_BAR; PG8_MMA(1, 0, At, B0); PG8_MMA(1, 1, At, B1); PG8_BAR; PG8_SCHED;
        }
        PG8_PT_B(18);
        if constexpr (ALIGN_EPI) { if (wr == 0) PG8_BAR; }
        bool keep = false;
        PG8_PT_B(19); if constexpr (INIT) { const int l_ = lane_id_v(); keep = E.run(acc, cur, has_next ? nxt : cur, wr, wc, l_ & 15, l_ >> 4); } else if constexpr (VAR != 7) { const int l_ = lane_id_v(); E(acc, cur, wr, wc, l_ & 15, l_ >> 4); } else { asm volatile("" :: "v"(acc[0][0][0][0]), "v"(acc[1][1][3][1])); } PG8_PT_E(19);
        if (!has_next) break;
        if (!keep) {
#pragma unroll
        for (int a = 0; a < 2; ++a)
#pragma unroll
            for (int b = 0; b < 2; ++b)
#pragma unroll
                for (int m = 0; m < 4; ++m)
#pragma unroll
                    for (int n = 0; n < 2; ++n) acc[a][b][m][n] = (f32x4){0.f, 0.f, 0.f, 0.f};
        }
        cur = nxt; cA = nA; cB = nB; ++ui;
        if constexpr (ALIGN_EPI) { if (wr == 1) PG8_BAR; }
        PG8_PT_E(18);
    }
    PG8_WAIT_V(0);
    if constexpr (!ALIGN_EPI) { if (wr == 0) PG8_BAR; }
    PG8_BAR;
#undef PG8_SA
#undef PG8_SB
#undef PG8_STAGE
#undef PG8_STAGE_A
#undef PG8_STAGE_B
#undef PG8_STAGE_G
#undef PG8_LDA
#undef PG8_LDB
#undef PG8_MMA
#undef PG8_WAIT_V
#undef PG8_WAIT_V8_SKIPPABLE
#undef PG8_WAIT_L
#undef PG8_BAR
#undef PG8_SCHED
}
}
#define GAS __attribute__((address_space(1)))
#define LAS __attribute__((address_space(3)))
typedef unsigned short bf16;
typedef unsigned v4u __attribute__((ext_vector_type(4)));
typedef float f32x4 __attribute__((ext_vector_type(4)));
typedef short bf16x8 __attribute__((ext_vector_type(8)));
typedef GAS unsigned gu32;
typedef GAS unsigned long long gu64;
#define RLX_AGENT __ATOMIC_RELAXED, __HIP_MEMORY_SCOPE_AGENT
#define LDS_WAIT() asm volatile("s_waitcnt lgkmcnt(0)" ::: "memory")
#define VM_WAIT() asm volatile("s_waitcnt vmcnt(0)" ::: "memory")
__device__ __forceinline__ unsigned long long rt() { return __builtin_amdgcn_s_memrealtime(); }
__device__ __forceinline__ unsigned f2bf(float f) { unsigned u = __builtin_bit_cast(unsigned, f); return (u + 0x7fffu + ((u >> 16) & 1u)) >> 16; }
__device__ __forceinline__ unsigned pk2(float lo, float hi) { return f2bf(lo) | (f2bf(hi) << 16); }

#define XB_TMO      128
#define XB_XCNT(j)  (256  + 64 * (j))
#define XB_XSUB(j)  (1280 + 64 * (j))
#define XB_XGEN(j)  (2304 + 64 * (j))
#define XB_TOP      3328
#define XB_TOPGEN   3392
#define XCD_BAR_WORDS 3456
#define XB_SPIN_CAP (1u << 18)

__device__ __forceinline__ unsigned xb_ld(unsigned* p)              { return __hip_atomic_load(p, __ATOMIC_RELAXED, __HIP_MEMORY_SCOPE_AGENT); }
__device__ __forceinline__ unsigned xb_add(unsigned* p, unsigned v) { return __hip_atomic_fetch_add(p, v, __ATOMIC_RELAXED, __HIP_MEMORY_SCOPE_AGENT); }
__device__ __forceinline__ unsigned xb_xcc_id() { return (unsigned)__builtin_amdgcn_s_getreg((3 << 11) | 20) & 0xFu; }
#define XB_SPIN(cond, bar) do { unsigned _sp = 0; while (cond) { __builtin_amdgcn_s_sleep(1); \
    if ((++_sp & 255u) == 0u) { if (xb_ld(&(bar)[XB_TMO])) break; if (_sp > XB_SPIN_CAP) { atomicAdd(&(bar)[XB_TMO], 1u); break; } } } } while (0)

struct XcdBarrier {
    unsigned* bar; unsigned x;
    volatile LAS unsigned* st;
};

__device__ __forceinline__ XcdBarrier xcd_barrier_post(unsigned* bar, volatile LAS unsigned* st) {
    XcdBarrier b; b.bar = bar; b.x = xb_xcc_id(); b.st = st;
    if (threadIdx.x == 0) (void)xb_add(&bar[XB_XCNT(b.x)], 1u);
    return b;
}
__device__ __forceinline__ void xcd_barrier_complete(unsigned* bar, unsigned x, unsigned& nloc, unsigned& nx) {
    const unsigned G = gridDim.x * gridDim.y * gridDim.z;
    unsigned sum, cnt, mine, sp = 0u;
    for (;;) {
        sum = 0u; cnt = 0u; mine = 0u;
#pragma unroll
        for (unsigned j = 0; j < 16; ++j) { const unsigned c = xb_ld(&bar[XB_XCNT(j)]); sum += c; cnt += (c > 0u) ? 1u : 0u; mine = (j == x) ? c : mine; }
        if (sum == G) break;
        __builtin_amdgcn_s_sleep(1);
        if ((++sp & 255u) == 0u) { if (xb_ld(&bar[XB_TMO])) break; if (sp > XB_SPIN_CAP) { atomicAdd(&bar[XB_TMO], 1u); break; } }
    }
    nloc = mine > 0u ? mine : 1u; nx = cnt > 0u ? cnt : 1u;
}

__device__ __forceinline__ void xcd_barrier(const XcdBarrier& b) {
    asm volatile("s_waitcnt vmcnt(0)" ::: "memory");
    __syncthreads();
    if (threadIdx.x == 0) {
        unsigned* bar = b.bar;
        __builtin_amdgcn_s_waitcnt(0);
        unsigned nloc = b.st[0], nx = b.st[1];
        if (nloc == 0u) { xcd_barrier_complete(bar, b.x, nloc, nx); b.st[0] = nloc; b.st[1] = nx; }
        const unsigned old = xb_add(&bar[XB_XSUB(b.x)], 1u);
        const unsigned gen = old / nloc;
        if (old + 1u == (gen + 1u) * nloc) {
            __builtin_amdgcn_fence(__ATOMIC_RELEASE, "agent");
            asm volatile("s_waitcnt vmcnt(0)" ::: "memory");
            const unsigned og = xb_add(&bar[XB_TOP], 1u);
            const unsigned tg = og / nx;
            if (og + 1u == (tg + 1u) * nx) xb_add(&bar[XB_TOPGEN], 1u);
            else XB_SPIN(xb_ld(&bar[XB_TOPGEN]) == tg, bar);
            __builtin_amdgcn_fence(__ATOMIC_ACQUIRE, "agent");
            xb_add(&bar[XB_XGEN(b.x)], 1u);
            asm volatile("s_waitcnt vmcnt(0)" ::: "memory");
        } else {
            XB_SPIN(xb_ld(&bar[XB_XGEN(b.x)]) == gen, bar);
            __builtin_amdgcn_fence(__ATOMIC_ACQUIRE, "agent");
            asm volatile("s_waitcnt vmcnt(0)" ::: "memory");
        }
    }
    __syncthreads();
}

constexpr int NWAVES = 8;
constexpr int D = 1024, NB = 16, SEQ = 2048, T = NB * SEQ, CTXL = 256, TC = NB * CTXL;
constexpr int QW = 512, KVW = 128, HYW = 512, INW = 4352, NE = 32, DFF = 1024;
constexpr float LN_EPS = 1e-5f;
constexpr float DN_ALPHA = 1.189207115002721f;
constexpr float LOG2E = 1.4426950408889634f;
constexpr float C2Q = 0.125f * LOG2E;
constexpr int NPH = 10;
#ifndef MK_N_LAUNCHES
#define MK_N_LAUNCHES 1
#endif
constexpr int N_LAUNCHES = MK_N_LAUNCHES;

constexpr size_t MiB = 1u << 20;
constexpr size_t WS_CTL = 0, CTL_ZERO_BYTES = 128 * 1024;
constexpr size_t WS_MODP = 1 * MiB;
constexpr size_t WS_MODF = 8 * MiB;
constexpr size_t WS_ROPE = 9 * MiB;
constexpr size_t WS_ASG = 10 * MiB;
constexpr size_t WS_GW = 10 * MiB + 512 * 1024;
constexpr size_t WS_TOK = 11 * MiB;
constexpr size_t WS_G = 16 * MiB;
constexpr size_t WS_WB = 24 * MiB;
constexpr size_t WS_WO = 26 * MiB;
constexpr size_t WS_WIN = 28 * MiB;
constexpr size_t WS_W1 = 40 * MiB;
constexpr size_t WS_W2 = 168 * MiB;
constexpr size_t WS_V1 = 232 * MiB;
constexpr size_t WS_HM = 360 * MiB;
constexpr size_t WS_HX = 424 * MiB;
constexpr size_t WS_Q = 496 * MiB;
constexpr size_t WS_K = 528 * MiB;
constexpr size_t WS_VT = 536 * MiB;
constexpr size_t WS_KC = 544 * MiB;
constexpr size_t WS_VTC = 545 * MiB;
constexpr size_t WS_UT = 546 * MiB;
constexpr size_t WS_GATE = 642 * MiB;
constexpr size_t WS_ATT = 770 * MiB;
constexpr size_t WS_HYT = 898 * MiB;
constexpr size_t WS_MM = 834 * MiB;
constexpr size_t WS_ACT = 424 * MiB;
constexpr size_t WS_YB = 696 * MiB;
constexpr size_t WS_HX8 = 930 * MiB;
constexpr size_t WS_END = 1024 * MiB;
static_assert(WS_ACT + (size_t)139264 * 2048 <= WS_YB && WS_YB + (size_t)139264 * 2048 <= WS_END && WS_MM + (size_t)T * 2048 <= WS_END, "d_ws map");
constexpr int CW_TMO = 0, CW_CODE = 1, CW_BAR = 4096, CW_CNT = 16384, CW_MOD = 16384 + 64;
static_assert((CW_MOD + 1) * 4 <= (int)CTL_ZERO_BYTES && (CW_BAR + 3456) <= CW_CNT, "control words inside the per-call memset");

constexpr int RING_BYTES = 131072;
constexpr int LDSCTL_OFF = 151552;
constexpr int MISC_OFF = LDSCTL_OFF + 320;
constexpr int TP_OFF = LDSCTL_OFF + 1024;
constexpr int LDS_BYTES = 155648;

typedef float f32x16 __attribute__((ext_vector_type(16)));
typedef float f32x2 __attribute__((ext_vector_type(2)));
typedef unsigned u32x2 __attribute__((ext_vector_type(2)));

struct Frame {
    unsigned long long pt0, ptacc;
    LAS unsigned char* lds;
    volatile LAS unsigned* MISC;
    gu32* ctl;
    int tid, lane, wave, vcu, G;
    const GAS float *x, *c, *ctx, *c_ctx, *w_mod, *b_mod, *w_in, *sink, *cw, *cb, *fw1, *fb1, *fw2, *fb2, *fw3, *skip, *w_ba, *w_bh, *w_out, *ln1g, *ln1b, *rw, *rb, *ew1, *eb1, *ew2, *eb2, *ln2g, *ln2b;
    GAS float* out;
    GAS float *modP, *modF, *rope, *gw; GAS bf16* V1;
    GAS int *asg, *tok;
    GAS unsigned char *HX8, *WIN8, *WIN8U, *WIN8Q;
    GAS bf16 *G_, *WB, *WO, *WIN, *W1, *W2, *HM, *HX, *Q, *K, *VT, *KC, *VTC, *UT, *GATE, *ATT, *MM, *ACT, *YB, *HYT;
};

template <int CTRL> __device__ __forceinline__ float dpp_f(float v) { return __builtin_bit_cast(float, __builtin_amdgcn_update_dpp(0, __builtin_bit_cast(int, v), CTRL, 0xF, 0xF, true)); }
__device__ __forceinline__ float wave_sum(float v) {
    v += dpp_f<0xB1>(v); v += dpp_f<0x4E>(v); v += dpp_f<0x141>(v); v += dpp_f<0x140>(v);
    { const unsigned u = __builtin_bit_cast(unsigned, v); auto r = __builtin_amdgcn_permlane16_swap(u, u, false, false); v = __builtin_bit_cast(float, (unsigned)r[0]) + __builtin_bit_cast(float, (unsigned)r[1]); }
    { const unsigned u = __builtin_bit_cast(unsigned, v); auto r = __builtin_amdgcn_permlane32_swap(u, u, false, false); v = __builtin_bit_cast(float, (unsigned)r[0]) + __builtin_bit_cast(float, (unsigned)r[1]); }
    return v;
}
__device__ __forceinline__ float wave_max(float v) {
    v = fmaxf(v, dpp_f<0xB1>(v)); v = fmaxf(v, dpp_f<0x4E>(v)); v = fmaxf(v, dpp_f<0x141>(v)); v = fmaxf(v, dpp_f<0x140>(v));
    { const unsigned u = __builtin_bit_cast(unsigned, v); auto r = __builtin_amdgcn_permlane16_swap(u, u, false, false); v = fmaxf(__builtin_bit_cast(float, (unsigned)r[0]), __builtin_bit_cast(float, (unsigned)r[1])); }
    { const unsigned u = __builtin_bit_cast(unsigned, v); auto r = __builtin_amdgcn_permlane32_swap(u, u, false, false); v = fmaxf(__builtin_bit_cast(float, (unsigned)r[0]), __builtin_bit_cast(float, (unsigned)r[1])); }
    return v;
}
__device__ __forceinline__ float bf2f(unsigned short h) { return __builtin_bit_cast(float, (unsigned)h << 16); }
__device__ __forceinline__ float bflo(unsigned w) { return __builtin_bit_cast(float, w << 16); }
__device__ __forceinline__ float bfhi(unsigned w) { return __builtin_bit_cast(float, w & 0xffff0000u); }
__device__ __forceinline__ float sigmoidf_(float x) { return __builtin_amdgcn_rcpf(1.f + __builtin_amdgcn_exp2f(-LOG2E * x)); }
__device__ __forceinline__ unsigned pk4_fp8(float a, float b, float c, float d) { int w = 0; w = __builtin_amdgcn_cvt_pk_fp8_f32(a, b, w, false); w = __builtin_amdgcn_cvt_pk_fp8_f32(c, d, w, true); return (unsigned)w; }

typedef float f32x2_t __attribute__((ext_vector_type(2)));
#define HPT_B(k) do { if (PROBE_SPIN == (k)) F.pt0 = rt(); } while (0)
#define HPT_E(k) do { if (PROBE_SPIN == (k)) F.ptacc += rt() - F.pt0; } while (0)
__device__ __forceinline__ void p0_mod_block(Frame& F, int cb) {
    const int lane = F.lane, w = F.wave;
    LAS float* scr = (LAS float*)(F.lds + w * 16384);
    LAS float* part = (LAS float*)(F.lds + 10240);
    float xs[17][2];
#pragma unroll
    for (int r = 0; r < 17; ++r) { const GAS float* src = r < 16 ? F.c + r * D : F.c_ctx; xs[r][0] = src[128 * w + lane]; xs[r][1] = src[128 * w + 64 + lane]; }
#pragma unroll
    for (int r = 0; r < 17; ++r) { scr[lane * 20 + r] = xs[r][0] / (1.f + __expf(-xs[r][0])); scr[(64 + lane) * 20 + r] = xs[r][1] / (1.f + __expf(-xs[r][1])); }
    LDS_WAIT(); asm volatile("" ::: "memory");
    f32x2_t acc2[8]; float acc16 = 0.f;
#pragma unroll
    for (int p = 0; p < 8; ++p) acc2[p] = (f32x2_t){0.f, 0.f};
    const GAS float* wp = F.w_mod + (size_t)(128 * w) * 6144 + 64 * cb + lane;
#pragma unroll 1
    for (int k0 = 0; k0 < 128; k0 += 64) { float wv[64];
#pragma unroll
        for (int k = 0; k < 64; ++k) wv[k] = wp[(size_t)(k0 + k) * 6144];
#pragma unroll
        for (int k = 0; k < 64; ++k) { const LAS float* sp = scr + (k0 + k) * 20;
            const pg8::f32x4 s0 = *(const LAS pg8::f32x4*)sp, s1 = *(const LAS pg8::f32x4*)(sp + 4), s2 = *(const LAS pg8::f32x4*)(sp + 8), s3 = *(const LAS pg8::f32x4*)(sp + 12); const float s16 = sp[16];
            const f32x2_t wk = {wv[k], wv[k]};
            acc2[0] += (f32x2_t){s0[0], s0[1]} * wk; acc2[1] += (f32x2_t){s0[2], s0[3]} * wk; acc2[2] += (f32x2_t){s1[0], s1[1]} * wk; acc2[3] += (f32x2_t){s1[2], s1[3]} * wk;
            acc2[4] += (f32x2_t){s2[0], s2[1]} * wk; acc2[5] += (f32x2_t){s2[2], s2[3]} * wk; acc2[6] += (f32x2_t){s3[0], s3[1]} * wk; acc2[7] += (f32x2_t){s3[2], s3[3]} * wk;
            acc16 += s16 * wv[k]; } }
    float acc[17];
#pragma unroll
    for (int p = 0; p < 8; ++p) { acc[2 * p] = acc2[p][0]; acc[2 * p + 1] = acc2[p][1]; }
    acc[16] = acc16;
#pragma unroll
    for (int r = 0; r < 17; ++r) part[w * 4096 + r * 64 + lane] = acc[r];
    __syncthreads();
    for (int i = F.tid; i < 17 * 64; i += NWAVES * 64) { const int r = i >> 6, c = i & 63; float sum = F.b_mod[64 * cb + c];
#pragma unroll
        for (int ww = 0; ww < 8; ++ww) sum += part[ww * 4096 + r * 64 + c];
        F.modF[r * 6144 + 64 * cb + c] = sum; }
    asm volatile("s_waitcnt vmcnt(0)" ::: "memory"); __syncthreads();
    if (F.tid == 0) { __builtin_amdgcn_fence(__ATOMIC_RELEASE, "agent"); asm volatile("s_waitcnt vmcnt(0)" ::: "memory"); __hip_atomic_fetch_add(F.ctl + CW_MOD, 1u, RLX_AGENT); }
    __syncthreads();
}
__device__ __forceinline__ void p0_filt_item(Frame& F, LAS float* scr, int g, int cb) {
    int lane = F.lane; asm volatile("" : "+v"(lane));
    LAS float* zf = scr; LAS float* h1 = scr + 8 * 36; LAS float* h2 = h1 + 8 * 64;
#pragma unroll
    for (int p = 0; p < 8; ++p) { const int j = 8 * g + p; const float om = (6.283185307179586f * (float)j) / 2048.f;
        if (lane < 16) { const float fk = 1e-4f + (float)lane * ((15.f - 1e-4f) / 15.f); zf[p * 36 + 1 + lane] = cosf(fk * om); }
        else if (lane < 32) { const float fk = 1e-4f + (float)(lane - 16) * ((15.f - 1e-4f) / 15.f); zf[p * 36 + 17 + (lane - 16)] = -sinf(fk * om); }
        else if (lane == 32) zf[p * 36] = (float)j / 2047.f; }
    LDS_WAIT(); asm volatile("" ::: "memory");
    {
        float w1c[33], w2c[64];
#pragma unroll
        for (int i = 0; i < 33; ++i) w1c[i] = F.fw1[i * 64 + lane];
#pragma unroll
        for (int i = 0; i < 64; ++i) w2c[i] = F.fw2[i * 64 + lane];
        const float bb1 = F.fb1[lane], bb2 = F.fb2[lane];
#pragma unroll
        for (int p = 0; p < 8; ++p) { float a = bb1;
#pragma unroll
            for (int i = 0; i < 33; ++i) a += zf[p * 36 + i] * w1c[i];
            h1[p * 64 + lane] = sinf(a); }
        LDS_WAIT(); asm volatile("" ::: "memory");
#pragma unroll
        for (int p = 0; p < 8; ++p) { float a = bb2;
#pragma unroll
            for (int i = 0; i < 64; ++i) a += h1[p * 64 + i] * w2c[i];
            h2[p * 64 + lane] = sinf(a); }
        LDS_WAIT(); asm volatile("" ::: "memory");
    }
    float o[8][4];
#pragma unroll
    for (int p = 0; p < 8; ++p)
#pragma unroll
        for (int q = 0; q < 4; ++q) o[p][q] = 0.f;
    const GAS float* w3 = F.fw3 + 256 * cb + lane;
#pragma unroll 2
    for (int i0 = 0; i0 < 64; i0 += 16) { float w[16][4];
#pragma unroll
        for (int i = 0; i < 16; ++i)
#pragma unroll
            for (int q = 0; q < 4; ++q) w[i][q] = w3[(size_t)(i0 + i) * 2048 + 64 * q];
#pragma unroll
        for (int i = 0; i < 16; ++i)
#pragma unroll
            for (int p = 0; p < 8; ++p) { const float hv = h2[p * 64 + i0 + i];
#pragma unroll
                for (int q = 0; q < 4; ++q) o[p][q] += hv * w[i][q]; } }
#pragma unroll
    for (int q = 0; q < 4; ++q) { const int col = 256 * cb + 64 * q + lane, oo = col >> 10, dir = (col >> 9) & 1, ch = col & 511;
        const float delta = 15.350567286626973f - (float)ch * (12.280453829301578f / 511.f);
        GAS bf16* gp = F.G_ + (size_t)(oo * 512 + ch) * 4096;
#pragma unroll
        for (int p = 0; p < 8; ++p) { const int j = 8 * g + p; const float val = o[p][q] * __expf(-((float)j / 2047.f) * delta);
            const int idx = dir ? 2048 + j : 2048 - j; if (!(dir && j == 0)) gp[idx] = (bf16)f2bf(val); }
        if (g == 0 && dir == 0) gp[0] = 0; }
    LDS_WAIT(); asm volatile("" ::: "memory");
}
#ifndef P0_NB
#define P0_NB 21
#endif
#ifndef M8
#define M8 1
#endif
#ifndef Q8
#define Q8 1
#endif
#ifndef U8
#define U8 0
#endif
constexpr int IT_IN = 16 * 136, IT_B = 8 * 32, IT_O = 16 * 32, IT_W1 = 32 * 16 * 64, IT_W2 = 32 * 16 * 32, NTR = IT_IN + 2 * IT_B + IT_O + IT_W1 + IT_W2;
struct TrItem { const GAS float* W; GAS bf16* WT; int N, Kp, drow, k0, n0, f8; };
__device__ __forceinline__ TrItem tr_decode(Frame& F, int r) {
    TrItem t; t.f8 = 0;
    if (r < IT_IN) { t.W = F.w_in; t.N = INW; t.WT = F.WIN; t.Kp = 1024; t.k0 = 64 * (r / 136); t.n0 = 32 * (r % 136); t.drow = t.n0;
        if (Q8 && t.n0 < 768) { t.f8 = 1; t.WT = (GAS bf16*)F.WIN8Q; }
        if (U8 && t.n0 >= 768 && t.n0 < 2304) { t.drow = t.n0 - 768; t.f8 = 1; t.WT = (GAS bf16*)F.WIN8U; }
        if (t.n0 >= 2304) { const int g = t.n0 - 2304, h = g & 1023; t.drow = (h >> 7) * 256 + (g >> 10) * 128 + (h & 127); t.f8 = 1; t.WT = (GAS bf16*)F.WIN8; } }
    else if ((r -= IT_IN) < IT_B) { t.W = F.w_ba; t.N = 1024; t.WT = F.WB; t.Kp = 512; t.k0 = 64 * (r / 32); t.n0 = 32 * (r % 32); t.drow = t.n0; t.f8 = M8; }
    else if ((r -= IT_B) < IT_B) { t.W = F.w_bh; t.N = 1024; t.WT = M8 ? (GAS bf16*)((GAS unsigned char*)F.WB + 1024 * 512) : F.WB + 1024 * 512; t.Kp = 512; t.k0 = 64 * (r / 32); t.n0 = 32 * (r % 32); t.drow = t.n0; t.f8 = M8; }
    else if ((r -= IT_B) < IT_O) { t.W = F.w_out; t.N = 1024; t.WT = F.WO; t.Kp = 1024; t.k0 = 64 * (r / 32); t.n0 = 32 * (r % 32); t.drow = t.n0; }
    else if ((r -= IT_O) < IT_W1) { const int e = r >> 10, q = r & 1023; t.W = F.ew1 + (size_t)e * 1024 * 2048; t.N = 2048; t.WT = (GAS bf16*)((GAS unsigned char*)F.W1 + (size_t)e * 2048 * 1024); t.Kp = 1024; t.f8 = 1; t.k0 = 64 * (q >> 6); t.n0 = 32 * (q & 63);
        t.drow = t.n0 < 1024 ? (t.n0 >> 7) * 256 + (t.n0 & 127) : ((t.n0 - 1024) >> 7) * 256 + 128 + ((t.n0 - 1024) & 127); }
    else { r -= IT_W1; const int e = r >> 9, q = r & 511; t.W = F.ew2 + (size_t)e * 1024 * 1024; t.N = 1024; t.WT = (GAS bf16*)((GAS unsigned char*)F.W2 + (size_t)e * 1024 * 1024); t.Kp = 1024; t.f8 = 1; t.k0 = 64 * (q >> 5); t.n0 = 32 * (q & 31); t.drow = t.n0; }
    return t;
}
__device__ __forceinline__ void tr_load(const TrItem& t, int lane, f32x4 (&buf)[8]) {
    const GAS float* wp = t.W + (size_t)(t.k0 + (lane >> 3)) * t.N + t.n0 + 4 * (lane & 7);
#pragma unroll
    for (int i = 0; i < 8; ++i) buf[i] = __builtin_nontemporal_load((const GAS f32x4*)(wp + (size_t)(8 * i) * t.N));
}
__device__ __forceinline__ void tr_store(const TrItem& t, const f32x4 (&buf)[8], LAS float* scr, int lane) {
    const int kk = lane >> 3, c4 = lane & 7;
#pragma unroll
    for (int i = 0; i < 8; ++i) { LAS float* d = scr + (8 * i + kk) * 33 + 4 * c4; d[0] = buf[i][0]; d[1] = buf[i][1]; d[2] = buf[i][2]; d[3] = buf[i][3]; }
    LDS_WAIT(); asm volatile("" ::: "memory");
    const int c = lane & 7;
#pragma unroll
    for (int j = 0; j < 4; ++j) { const int n = (lane >> 3) + 8 * j; const LAS float* sp = scr + (8 * c) * 33 + n;
        if (t.f8) { u32x2 o; o.x = pk4_fp8(sp[0 * 33] * 256.f, sp[1 * 33] * 256.f, sp[2 * 33] * 256.f, sp[3 * 33] * 256.f); o.y = pk4_fp8(sp[4 * 33] * 256.f, sp[5 * 33] * 256.f, sp[6 * 33] * 256.f, sp[7 * 33] * 256.f);
            *(GAS u32x2*)((GAS unsigned char*)t.WT + (size_t)(t.drow + n) * t.Kp + t.k0 + 8 * c) = o; }
        else { v4u o; o.x = pk2(sp[0 * 33], sp[1 * 33]); o.y = pk2(sp[2 * 33], sp[3 * 33]); o.z = pk2(sp[4 * 33], sp[5 * 33]); o.w = pk2(sp[6 * 33], sp[7 * 33]);
            *(GAS v4u*)(t.WT + (size_t)(t.drow + n) * t.Kp + t.k0 + 8 * c) = o; } }
    LDS_WAIT(); asm volatile("" ::: "memory");
}
__device__ __forceinline__ void p1_rows(Frame& F);
__device__ __forceinline__ void p0_prologue(Frame& F) {
    LAS float* scr = (LAS float*)(F.lds + F.wave * 16384);
    const int gw = F.vcu * NWAVES + F.wave, NGW = F.G * NWAVES, lane = F.lane;
    constexpr int IT_FILT = 2048, IT_ROPE = 1, NSPEC = IT_FILT + IT_ROPE;
    HPT_B(60); if ((int)blockIdx.x < 96) p0_mod_block(F, (int)blockIdx.x); HPT_E(60);
    const bool spec_first = (F.wave & 4) != 0;
#define P0_SPECIAL() do { for (int it = gw; it < NSPEC; it += NGW) { int r = it; \
        if (r < IT_FILT) { p0_filt_item(F, scr, r >> 3, r & 7); continue; } \
        _Pragma("unroll 4") for (int i = 0; i < 16; ++i) { const int idx = lane * 16 + i, pos = idx >> 4, f = idx & 15; const float inv = exp2f(-(float)f * (13.287712379549449f / 16.f)); const float ang = (float)pos * inv; \
            F.rope[idx] = cosf(ang); F.rope[1024 + idx] = sinf(ang); } } } while (0)
    HPT_B(61); if (spec_first) P0_SPECIAL(); HPT_E(61);
    HPT_B(62);
    {
        const bool xtra = (int)blockIdx.x >= 96; const int gwx = ((int)blockIdx.x - 96) * NWAVES + F.wave, NX = (F.G - 96) * NWAVES;
#define P0_ITEM(k) ((k) < P0_NB ? gw + (k) * NGW : (xtra ? P0_NB * NGW + gwx + ((k) - P0_NB) * NX : NTR))
        TrItem cq[5]; bool hv[5]; f32x4 bq[5][8];
#pragma unroll
        for (int d = 0; d < 5; ++d) { cq[d] = tr_decode(F, gw); hv[d] = false;
#pragma unroll
            for (int i = 0; i < 8; ++i) bq[d][i] = (f32x4){0.f, 0.f, 0.f, 0.f}; }
#pragma unroll
        for (int d = 0; d < 4; ++d) { const int itd = P0_ITEM(d); hv[d] = itd < NTR && (d == 0 || hv[d - 1]); if (hv[d]) { cq[d] = tr_decode(F, itd); tr_load(cq[d], lane, bq[d]); } }
        int kk = 0;
        while (hv[0]) {
            const int inew = hv[3] ? P0_ITEM(kk + 4) : NTR; hv[4] = inew < NTR; if (hv[4]) { cq[4] = tr_decode(F, inew); tr_load(cq[4], lane, bq[4]); }
            tr_store(cq[0], bq[0], scr, lane);
#pragma unroll
            for (int d = 0; d < 4; ++d) { cq[d] = cq[d + 1]; hv[d] = hv[d + 1];
#pragma unroll
                for (int i = 0; i < 8; ++i) bq[d][i] = bq[d + 1][i]; }
            ++kk;
        }
#undef P0_ITEM
    }
    HPT_E(62);
    HPT_B(61); if (!spec_first) P0_SPECIAL(); HPT_E(61);
    HPT_B(63);
#undef P0_SPECIAL
    __syncthreads();
    if (F.wave == 0) { unsigned sp = 0;
        while ((unsigned)__builtin_amdgcn_readfirstlane(__hip_atomic_load(F.ctl + CW_MOD, RLX_AGENT)) < 96u) { __builtin_amdgcn_s_sleep(2); if (++sp > (1u << 22)) { if (F.lane == 0) __hip_atomic_store(F.ctl + CW_TMO, 1u, RLX_AGENT); break; } }
        __builtin_amdgcn_fence(__ATOMIC_ACQUIRE, "agent"); asm volatile("s_waitcnt vmcnt(0)" ::: "memory"); }
    __syncthreads(); HPT_E(63);
    HPT_B(64); p1_rows(F); HPT_E(64);
}

template <int NR>
__device__ __forceinline__ void ln_mod_rows(const GAS float* const (&src)[NR], GAS bf16* const (&dst)[NR], GAS unsigned char* const (&dst8)[NR], const LAS float* const (&tS)[NR], const LAS float* const (&tB)[NR], int lane) {
    f32x4 v[NR][4]; float s[NR], s2[NR];
#pragma unroll
    for (int r = 0; r < NR; ++r) { const GAS f32x4* xr = (const GAS f32x4*)src[r] + 2 * lane;
#pragma unroll
        for (int j = 0; j < 4; ++j) v[r][j] = __builtin_nontemporal_load(xr + 128 * (j >> 1) + (j & 1)); }
#pragma unroll
    for (int r = 0; r < NR; ++r) { s[r] = 0.f;
#pragma unroll
        for (int j = 0; j < 4; ++j) s[r] += (v[r][j].x + v[r][j].y) + (v[r][j].z + v[r][j].w); }
#pragma unroll
    for (int r = 0; r < NR; ++r) s[r] = wave_sum(s[r]) * (1.f / D);
#pragma unroll
    for (int r = 0; r < NR; ++r) { s2[r] = 0.f;
#pragma unroll
        for (int j = 0; j < 4; ++j) { v[r][j] = v[r][j] - s[r]; s2[r] += (v[r][j].x * v[r][j].x + v[r][j].y * v[r][j].y) + (v[r][j].z * v[r][j].z + v[r][j].w * v[r][j].w); } }
#pragma unroll
    for (int r = 0; r < NR; ++r) s2[r] = 1.f / sqrtf(wave_sum(s2[r]) * (1.f / D) + LN_EPS);
#pragma unroll
    for (int r = 0; r < NR; ++r)
#pragma unroll
        for (int p = 0; p < 2; ++p) { const int col = 8 * lane + 512 * p;
            const f32x4 o0 = v[r][2 * p] * s2[r] * *(const LAS f32x4*)(tS[r] + col) + *(const LAS f32x4*)(tB[r] + col), o1 = v[r][2 * p + 1] * s2[r] * *(const LAS f32x4*)(tS[r] + col + 4) + *(const LAS f32x4*)(tB[r] + col + 4);
            v4u w; w.x = pk2(o0.x, o0.y); w.y = pk2(o0.z, o0.w); w.z = pk2(o1.x, o1.y); w.w = pk2(o1.z, o1.w); *(GAS v4u*)(dst[r] + col) = w;
            u32x2 w8; w8.x = pk4_fp8(o0.x, o0.y, o0.z, o0.w); w8.y = pk4_fp8(o1.x, o1.y, o1.z, o1.w); *(GAS u32x2*)(dst8[r] + col) = w8; }
}
__device__ __forceinline__ void p1_rows(Frame& F) {
    LAS float* tA = (LAS float*)F.lds;
    for (int chunk = blockIdx.x; chunk < 256; chunk += F.G) {
        const int b = chunk >> 4;
        for (int i = F.tid; i < 4096; i += NWAVES * 64) { const int which = i >> 10, col = i & 1023, r = which < 2 ? b : 16, n = ((which & 1) ? 0 : 1024) + col;
            const float s = F.modF[r * 6144 + n]; tA[i] = (which & 1) ? s : 1.f + s; }
        __syncthreads();
#pragma unroll 1
        for (int g = 0; g < 6; ++g) {
            const GAS float* src[3]; GAS bf16* dst[3]; GAS unsigned char* dst8[3]; const LAS float* tS[3]; const LAS float* tB[3];
#pragma unroll
            for (int r = 0; r < 3; ++r) { const int rr = 3 * g + r;
                if (rr < 16) { const int row = chunk * 128 + F.wave * 16 + rr; src[r] = F.x + (size_t)row * D; dst[r] = F.HX + (size_t)row * D; dst8[r] = F.HX8 + (size_t)row * D; tS[r] = tA; tB[r] = tA + 1024; }
                else { const int cr = chunk * 16 + F.wave * 2 + (rr - 16); src[r] = F.ctx + (size_t)cr * D; dst[r] = F.HX + (size_t)(T + cr) * D; dst8[r] = F.HX8 + (size_t)(T + cr) * D; tS[r] = tA + 2048; tB[r] = tA + 3072; } }
            ln_mod_rows<3>(src, dst, dst8, tS, tB, F.lane);
        }
        __syncthreads();
    }
}

using pg8::Unit; using pg8::f32x4; using pg8::cvt_pk_bf16;
struct SchedInProj {
    pg8::StaticOrder so; int G, c;
    __device__ __forceinline__ bool next(int i, Unit& u) const { const long L = (long)i * G + c; if (L < 384) return so.next(i, u); if (L < 400) { u.pm = 128 + (int)(L - 384); u.pn = 2; return true; } return false; }
    __device__ __forceinline__ void a_ready(const Unit&) const {}
};
struct SchedUhy {
    pg8::StaticOrder so;
    __device__ __forceinline__ bool next(int i, Unit& u) const { if (!so.next(i, u)) return false; u.pn += 3; return true; }
    __device__ __forceinline__ void a_ready(const Unit&) const {}
};
struct SchedPair {
    pg8::StaticOrder so;
    __device__ __forceinline__ bool next(int i, Unit& u) const { if (!so.next(i >> 1, u)) return false; if (i & 1) { u.pm += 128; u.pn += 4; } return true; }
    __device__ __forceinline__ void a_ready(const Unit&) const {}
};
struct SchedPlain { pg8::StaticOrder so;
    __device__ __forceinline__ bool next(int i, Unit& u) const { return so.next(i, u); }
    __device__ __forceinline__ void a_ready(const Unit&) const {}
};
struct SchedMoe {
    const LAS int* tp; const GAS int* tok; int nNl, G, c;
    __device__ __forceinline__ bool next(int i, Unit& u) const {
        pg8::StaticOrder so; so.init(__builtin_amdgcn_readfirstlane(tp[32]), nNl, G, c); if (!so.next(i, u)) return false;
        int e = 0;
        for (int k = 1; k < 32; ++k) e += (u.pm >= tp[k]) ? 1 : 0;
        u.pm = __builtin_amdgcn_readfirstlane(u.pm); u.pn = __builtin_amdgcn_readfirstlane(u.pn + e * nNl); return true; }
    __device__ __forceinline__ int rowoff(const Unit& u, int r) const { const int e = u.pn / nNl; int pos = (u.pm - tp[e]) * 256 + r; pos = pos < tp[33 + e] ? pos : 0; return tok[e * 32768 + pos]; }
    __device__ __forceinline__ void a_ready(const Unit&) const {}
};

struct EpiInProj {
    static constexpr bool PERM = true; static constexpr float S8 = Q8 ? 1.f / 256.f : 1.f;
    GAS bf16 *Q, *K, *VT, *KC, *VTC; const GAS float* rope;
    __device__ __forceinline__ void operator()(const f32x4 (&acc)[2][2][4][2], const Unit& u, int wr, int wc, int fr, int fq) const {
        const int pn = u.pn; const bool isctx = u.pm >= 128;
#pragma unroll
        for (int ai = 0; ai < 2; ++ai)
#pragma unroll
            for (int m = 0; m < 4; ++m) {
                const int row = u.pm * 256 + ai * 128 + wr * 64 + m * 16 + fr;
                {
                    const int t = row & 2047;
                    const int pos = (wc & 1) ? (t & 63) : (t >> 6); const int f0 = 8 * (fq & 1); const bool hihalf = (fq >> 1) != 0;
#pragma unroll
                    for (int bj = 0; bj < 2; ++bj) {
                        if (pn == 2 && bj == 1) {
                            const int kvh = wc >> 1, d0 = (wc & 1) * 32 + 8 * fq;
                            GAS bf16* vp = isctx ? VTC + ((size_t)(((row - T) >> 8) * 2 + kvh) * 64 + d0) * 256 + ((row - T) & 255)
                                             : VT + ((size_t)((row >> 11) * 2 + kvh) * 64 + d0) * 2048 + t;
                            const int pitch = isctx ? 256 : 2048;
#pragma unroll
                            for (int n = 0; n < 2; ++n)
#pragma unroll
                                for (int j = 0; j < 4; ++j) vp[(size_t)(4 * n + j) * pitch] = (bf16)f2bf(acc[ai][bj][m][n][j] * S8);
                        } else {
                            f32x4 r[2];
#pragma unroll
                            for (int n = 0; n < 2; ++n) { const f32x4 own = acc[ai][bj][m][n] * S8; f32x4 oth;
#pragma unroll
                                for (int j = 0; j < 4; ++j) oth[j] = __shfl_xor(own[j], 32);
                                const f32x4 cs = *(const GAS f32x4*)(rope + pos * 16 + f0 + 4 * n), sn = *(const GAS f32x4*)(rope + 1024 + pos * 16 + f0 + 4 * n);
                                r[n] = hihalf ? own * cs + oth * sn : own * cs - oth * sn;
                                if (isctx) r[n] = own; }
                            if (pn < 2) { r[0] = r[0] * C2Q; r[1] = r[1] * C2Q; }
                            v4u w; w.x = cvt_pk_bf16(r[0][0], r[0][1]); w.y = cvt_pk_bf16(r[0][2], r[0][3]); w.z = cvt_pk_bf16(r[1][0], r[1][1]); w.w = cvt_pk_bf16(r[1][2], r[1][3]);
                            GAS bf16* dst = pn < 2 ? Q + (size_t)row * QW + pn * 256 + bj * 128 + wc * 32 + 8 * fq
                                               : (isctx ? KC + (size_t)(row - T) * KVW + wc * 32 + 8 * fq : K + (size_t)row * KVW + wc * 32 + 8 * fq);
                            *(GAS v4u*)dst = w;
                        }
                    }
                }
            }
    }
};
struct EpiGate8 {
    static constexpr bool PERM = true;
    GAS bf16* GATE;
    __device__ __forceinline__ void operator()(const f32x4 (&acc)[2][2][4][2], const Unit& u, int wr, int wc, int fr, int fq) const {
        const int col = u.pn * 128 + wc * 32 + 8 * fq;
#pragma unroll
        for (int ai = 0; ai < 2; ++ai)
#pragma unroll
            for (int m = 0; m < 4; ++m) { const int row = u.pm * 256 + ai * 128 + wr * 64 + m * 16 + fr; float rr[8], hh[8];
#pragma unroll
                for (int n = 0; n < 2; ++n)
#pragma unroll
                    for (int j = 0; j < 4; ++j) { const float ea = __builtin_amdgcn_exp2f(acc[ai][0][m][n][j] * (-LOG2E / 256.f)), eh = fminf(__builtin_amdgcn_exp2f(acc[ai][1][m][n][j] * (-LOG2E / 256.f)), 1e30f);
                        const float dh = 1.f + eh; hh[4 * n + j] = __builtin_amdgcn_rcpf(dh); rr[4 * n + j] = dh * __builtin_amdgcn_rcpf(1.f + ea); }
                v4u w; w.x = cvt_pk_bf16(rr[0], rr[1]); w.y = cvt_pk_bf16(rr[2], rr[3]); w.z = cvt_pk_bf16(rr[4], rr[5]); w.w = cvt_pk_bf16(rr[6], rr[7]);
                *(GAS v4u*)(GATE + (size_t)row * 2048 + col) = w;
                w.x = cvt_pk_bf16(hh[0], hh[1]); w.y = cvt_pk_bf16(hh[2], hh[3]); w.z = cvt_pk_bf16(hh[4], hh[5]); w.w = cvt_pk_bf16(hh[6], hh[7]);
                *(GAS v4u*)(GATE + (size_t)row * 2048 + 1024 + col) = w; }
    }
};
struct EpiUT {
    static constexpr bool PERM = true, TR = true;
    GAS bf16* UT; float sc; int pn0;
    __device__ __forceinline__ void operator()(const f32x4 (&acc)[2][2][4][2], const Unit& u, int wr, int wc, int fr, int fq) const {
#pragma unroll
        for (int ai = 0; ai < 2; ++ai)
#pragma unroll
            for (int bj = 0; bj < 2; ++bj)
#pragma unroll
                for (int n = 0; n < 2; ++n) { const int ch = (u.pn - pn0) * 256 + bj * 128 + wc * 32 + 8 * (fr >> 2) + 4 * n + (fr & 3);
#pragma unroll
                    for (int mp = 0; mp < 2; ++mp) { unsigned wx[2], wy[2];
#pragma unroll
                        for (int q = 0; q < 2; ++q) { const f32x4 v = acc[ai][bj][2 * mp + q][n] * sc; wx[q] = cvt_pk_bf16(v[0], v[1]); wy[q] = cvt_pk_bf16(v[2], v[3]); }
                        auto rx = __builtin_amdgcn_permlane16_swap(wx[0], wx[1], false, false); auto ry = __builtin_amdgcn_permlane16_swap(wy[0], wy[1], false, false);
                        const v4u w = {(unsigned)rx[0], (unsigned)ry[0], (unsigned)rx[1], (unsigned)ry[1]};
                        const int row = u.pm * 256 + ai * 128 + wr * 64 + 16 * (2 * mp + (fq & 1)) + 4 * (fq & 2);
                        *(GAS v4u*)(UT + (size_t)ch * T + row) = w; } }
    }
};
struct EpiMerge {
    static constexpr bool PERM = true, INIT = true;
    const GAS bf16* GATE; GAS bf16* MM;
    __device__ __forceinline__ void init(f32x4 (&acc)[2][2][4][2], const Unit&, int, int) const {}
    __device__ __forceinline__ bool run(f32x4 (&acc)[2][2][4][2], const Unit& u, const Unit&, int wr, int wc, int fr, int fq) const {
        const int which = u.pn >> 2, pnl = u.pn & 3, pml = u.pm & 127;
#pragma unroll
        for (int ai = 0; ai < 2; ++ai) {
            v4u g[4][2];
#pragma unroll
            for (int m = 0; m < 4; ++m)
#pragma unroll
                for (int bj = 0; bj < 2; ++bj) { const int row = pml * 256 + ai * 128 + wr * 64 + m * 16 + fr, col = pnl * 256 + bj * 128 + wc * 32 + 8 * fq;
                    g[m][bj] = *(const GAS v4u*)(GATE + (size_t)row * 2048 + which * 1024 + col); }
            if (which == 0) {
#pragma unroll
                for (int m = 0; m < 4; ++m)
#pragma unroll
                    for (int bj = 0; bj < 2; ++bj) { const v4u gg = g[m][bj];
                        acc[ai][bj][m][0] *= (f32x4){bflo(gg.x), bfhi(gg.x), bflo(gg.y), bfhi(gg.y)}; acc[ai][bj][m][1] *= (f32x4){bflo(gg.z), bfhi(gg.z), bflo(gg.w), bfhi(gg.w)}; }
            } else {
#pragma unroll
                for (int m = 0; m < 4; ++m)
#pragma unroll
                    for (int bj = 0; bj < 2; ++bj) { const int row = pml * 256 + ai * 128 + wr * 64 + m * 16 + fr, col = pnl * 256 + bj * 128 + wc * 32 + 8 * fq;
                        const v4u gg = g[m][bj]; const f32x4 v0 = acc[ai][bj][m][0] * (M8 ? 1.f / 256.f : 1.f), v1 = acc[ai][bj][m][1] * (M8 ? 1.f / 256.f : 1.f);
                        v4u w; w.x = cvt_pk_bf16(bflo(gg.x) * v0[0], bfhi(gg.x) * v0[1]); w.y = cvt_pk_bf16(bflo(gg.y) * v0[2], bfhi(gg.y) * v0[3]); w.z = cvt_pk_bf16(bflo(gg.z) * v1[0], bfhi(gg.z) * v1[1]); w.w = cvt_pk_bf16(bflo(gg.w) * v1[2], bfhi(gg.w) * v1[3]);
                        *(GAS v4u*)(MM + (size_t)row * 1024 + col) = w; }
            }
        }
        return which == 0;
    }
};
struct EpiV1 {
    static constexpr bool PERM = true;
    const GAS float* x; const GAS float* modF; GAS bf16* V1;
    __device__ __forceinline__ void operator()(const f32x4 (&acc)[2][2][4][2], const Unit& u, int wr, int wc, int fr, int fq) const {
        const int col0 = u.pn * 256 + wc * 32 + 8 * fq; const int b = u.pm >> 3;
        f32x4 g1[2][2];
#pragma unroll
        for (int bj = 0; bj < 2; ++bj)
#pragma unroll
            for (int n = 0; n < 2; ++n) g1[bj][n] = *(const GAS f32x4*)(modF + b * 6144 + 2048 + col0 + bj * 128 + n * 4);
#pragma unroll
        for (int ai = 0; ai < 2; ++ai) {
            f32x4 xv[4][2][2];
#pragma unroll
            for (int m = 0; m < 4; ++m) { const size_t off = (size_t)(u.pm * 256 + ai * 128 + wr * 64 + m * 16 + fr) * D + col0;
#pragma unroll
                for (int bj = 0; bj < 2; ++bj)
#pragma unroll
                    for (int n = 0; n < 2; ++n) xv[m][bj][n] = *(const GAS f32x4*)(x + off + bj * 128 + n * 4); }
#pragma unroll
            for (int m = 0; m < 4; ++m) { const size_t off = (size_t)(u.pm * 256 + ai * 128 + wr * 64 + m * 16 + fr) * D + col0;
#pragma unroll
                for (int bj = 0; bj < 2; ++bj) { const f32x4 r0 = xv[m][bj][0] * DN_ALPHA + g1[bj][0] * acc[ai][bj][m][0], r1 = xv[m][bj][1] * DN_ALPHA + g1[bj][1] * acc[ai][bj][m][1];
                    v4u w; w.x = cvt_pk_bf16(r0[0], r0[1]); w.y = cvt_pk_bf16(r0[2], r0[3]); w.z = cvt_pk_bf16(r1[0], r1[1]); w.w = cvt_pk_bf16(r1[2], r1[3]);
                    *(GAS v4u*)(V1 + off + bj * 128) = w; } }
        }
    }
};
struct EpiAct {
    static constexpr bool PERM = true, INIT = true;
    const GAS float* b1; GAS bf16* ACT;
    __device__ __forceinline__ void load_bias(const Unit& u, int wc, int fq, f32x4 (&bb)[2][2]) const {
        const int e = u.pn >> 3, pnl = u.pn & 7, colo = pnl * 128 + wc * 32 + 8 * fq;
#pragma unroll
        for (int n = 0; n < 2; ++n) { bb[0][n] = *(const GAS f32x4*)(b1 + e * 2048 + colo + 4 * n); bb[1][n] = *(const GAS f32x4*)(b1 + e * 2048 + 1024 + colo + 4 * n); }
    }
    __device__ __forceinline__ void set_acc(f32x4 (&acc)[2][2][4][2], const f32x4 (&bb)[2][2]) const {
#pragma unroll
        for (int ai = 0; ai < 2; ++ai)
#pragma unroll
            for (int bj = 0; bj < 2; ++bj)
#pragma unroll
                for (int m = 0; m < 4; ++m)
#pragma unroll
                    for (int n = 0; n < 2; ++n) acc[ai][bj][m][n] = bb[bj][n] * 256.f;
    }
    __device__ __forceinline__ void init(f32x4 (&acc)[2][2][4][2], const Unit& u, int wc, int fq) const { f32x4 bb[2][2]; load_bias(u, wc, fq, bb); set_acc(acc, bb); }
    __device__ __forceinline__ bool run(f32x4 (&acc)[2][2][4][2], const Unit& u, const Unit& nx, int wr, int wc, int fr, int fq) const {
        f32x4 nb[2][2]; load_bias(nx, wc, fq, nb); __builtin_amdgcn_sched_barrier(0);
        const int pnl = u.pn & 7, colo = pnl * 128 + wc * 32 + 8 * fq;
#pragma unroll
        for (int ai = 0; ai < 2; ++ai)
#pragma unroll
            for (int mp = 0; mp < 2; ++mp) { unsigned wx[2], wy[2];
#pragma unroll
                for (int q = 0; q < 2; ++q) { const int m = 2 * mp + q; float o[8];
#pragma unroll
                    for (int n = 0; n < 2; ++n)
#pragma unroll
                        for (int h = 0; h < 2; ++h) {
                            f32x2_t gl = {__builtin_amdgcn_fmed3f(acc[ai][0][m][n][2 * h], -3.0e38f, 1792.f), __builtin_amdgcn_fmed3f(acc[ai][0][m][n][2 * h + 1], -3.0e38f, 1792.f)};
                            f32x2_t li = {__builtin_amdgcn_fmed3f(acc[ai][1][m][n][2 * h], -1792.f, 1792.f), __builtin_amdgcn_fmed3f(acc[ai][1][m][n][2 * h + 1], -1792.f, 1792.f)};
                            asm volatile("" : "+v"(gl), "+v"(li));
                            f32x2_t arg = gl * (-1.702f * LOG2E / 256.f), u = gl * (li * (1.f / 65536.f) + (1.f / 256.f));
                            asm volatile("" : "+v"(arg), "+v"(u));
                            const float s0 = __builtin_amdgcn_rcpf(1.f + __builtin_amdgcn_exp2f(arg[0])), s1 = __builtin_amdgcn_rcpf(1.f + __builtin_amdgcn_exp2f(arg[1]));
                            o[4 * n + 2 * h] = u[0] * s0; o[4 * n + 2 * h + 1] = u[1] * s1; }
                    wx[q] = pk4_fp8(o[0], o[1], o[2], o[3]); wy[q] = pk4_fp8(o[4], o[5], o[6], o[7]); }
                auto rx = __builtin_amdgcn_permlane16_swap(wx[0], wx[1], false, false); auto ry = __builtin_amdgcn_permlane16_swap(wy[0], wy[1], false, false);
                const v4u w = {(unsigned)rx[0], (unsigned)ry[0], (unsigned)rx[1], (unsigned)ry[1]};
                const int row = u.pm * 256 + ai * 128 + wr * 64 + (2 * mp + (fq & 1)) * 16 + fr;
                *(GAS v4u*)((GAS unsigned char*)ACT + (size_t)row * 1024 + colo - 8 * (fq & 1)) = w; }
        __builtin_amdgcn_sched_barrier(0);
        set_acc(acc, nb); return true;
    }
};
#ifndef ABL_EPI
#define ABL_EPI 0
#endif
struct EpiYb {
    static constexpr bool PERM = true, INIT = true, WIDE16 = true;
    const GAS float* b2; GAS bf16* YB; int abl = 0;
    __device__ __forceinline__ void load_bias(const Unit& u, int wc, int fq, f32x4 (&bb)[2][2]) const {
        const int e = u.pn >> 2, pnl = u.pn & 3;
#pragma unroll
        for (int bj = 0; bj < 2; ++bj)
#pragma unroll
            for (int n = 0; n < 2; ++n) bb[bj][n] = *(const GAS f32x4*)(b2 + e * 1024 + pnl * 256 + wc * 64 + 16 * fq + 8 * bj + 4 * n);
    }
    __device__ __forceinline__ void set_acc(f32x4 (&acc)[2][2][4][2], const f32x4 (&bb)[2][2]) const {
#pragma unroll
        for (int ai = 0; ai < 2; ++ai)
#pragma unroll
            for (int bj = 0; bj < 2; ++bj)
#pragma unroll
                for (int m = 0; m < 4; ++m)
#pragma unroll
                    for (int n = 0; n < 2; ++n) acc[ai][bj][m][n] = bb[bj][n] * 256.f;
    }
    __device__ __forceinline__ void init(f32x4 (&acc)[2][2][4][2], const Unit& u, int wc, int fq) const { f32x4 bb[2][2]; load_bias(u, wc, fq, bb); set_acc(acc, bb); }
    __device__ __forceinline__ bool run(f32x4 (&acc)[2][2][4][2], const Unit& u, const Unit& nx, int wr, int wc, int fr, int fq) const {
        f32x4 nb[2][2]; load_bias(nx, wc, fq, nb); __builtin_amdgcn_sched_barrier(0);
        const int col = (u.pn & 3) * 256 + wc * 64 + 16 * fq;
#pragma unroll
        for (int ai = 0; ai < 2; ++ai)
#pragma unroll
            for (int m = 0; m < 4; ++m) { v4u w; unsigned ww[4];
#pragma unroll
                for (int bj = 0; bj < 2; ++bj)
#pragma unroll
                    for (int n = 0; n < 2; ++n) { const f32x4 v = acc[ai][bj][m][n] * (1.f / 256.f); ww[2 * bj + n] = pk4_fp8(v[0], v[1], v[2], v[3]); }
                w.x = ww[0]; w.y = ww[1]; w.z = ww[2]; w.w = ww[3];
                const int row = u.pm * 256 + ai * 128 + wr * 64 + m * 16 + fr;
                *(GAS v4u*)((GAS unsigned char*)YB + (size_t)row * 1024 + col) = w; }
        __builtin_amdgcn_sched_barrier(0);
        set_acc(acc, nb); return true;
    }
};
struct EpiYbW {
    static constexpr bool PERM = true, WIDE = true;
    const GAS float* b2; GAS bf16* YB; int abl = 0;
    __device__ __forceinline__ void operator()(const f32x4 (&acc)[2][2][4][2], const Unit& u, int wr, int wc, int fr, int fq) const {
        const int e = u.pn >> 2, pnl = u.pn & 3;
#pragma unroll
        for (int bj = 0; bj < 2; ++bj) { const int col = pnl * 256 + wc * 64 + bj * 32 + 8 * fq;
            f32x4 b0 = {0.f, 0.f, 0.f, 0.f}, b1v = {0.f, 0.f, 0.f, 0.f}; if (abl != 2) { b0 = *(const GAS f32x4*)(b2 + e * 1024 + col); b1v = *(const GAS f32x4*)(b2 + e * 1024 + col + 4); }
#pragma unroll
            for (int ai = 0; ai < 2; ++ai)
#pragma unroll
                for (int m = 0; m < 4; ++m) { const int row = u.pm * 256 + ai * 128 + wr * 64 + m * 16 + fr; const f32x4 v0 = acc[ai][bj][m][0] * (1.f / 256.f) + b0, v1 = acc[ai][bj][m][1] * (1.f / 256.f) + b1v;
                    u32x2 w; w.x = pk4_fp8(v0[0], v0[1], v0[2], v0[3]); w.y = pk4_fp8(v1[0], v1[1], v1[2], v1[3]);
                    if (abl != 1) *(GAS u32x2*)((GAS unsigned char*)YB + (size_t)row * 1024 + col) = w; else asm volatile("" :: "v"(w)); } }
    }
};

struct EpiYbX {
    static constexpr bool PERM = true;
    const GAS float* b2; GAS bf16* YB; int abl = 0;
    __device__ __forceinline__ void operator()(const f32x4 (&acc)[2][2][4][2], const Unit& u, int wr, int wc, int fr, int fq) const {
        const int e = u.pn >> 2, pnl = u.pn & 3;
#pragma unroll
        for (int bj = 0; bj < 2; ++bj) { const int col = pnl * 256 + bj * 128 + wc * 32 + 8 * fq;
            const f32x4 b0 = *(const GAS f32x4*)(b2 + e * 1024 + col), b1v = *(const GAS f32x4*)(b2 + e * 1024 + col + 4);
#pragma unroll
            for (int ai = 0; ai < 2; ++ai)
#pragma unroll
                for (int mp = 0; mp < 2; ++mp) { unsigned wx[2], wy[2];
#pragma unroll
                    for (int q = 0; q < 2; ++q) { const int m = 2 * mp + q; const f32x4 v0 = acc[ai][bj][m][0] * (1.f / 256.f) + b0, v1 = acc[ai][bj][m][1] * (1.f / 256.f) + b1v;
                        wx[q] = pk4_fp8(v0[0], v0[1], v0[2], v0[3]); wy[q] = pk4_fp8(v1[0], v1[1], v1[2], v1[3]); }
                    auto rx = __builtin_amdgcn_permlane16_swap(wx[0], wx[1], false, false); auto ry = __builtin_amdgcn_permlane16_swap(wy[0], wy[1], false, false);
                    const v4u o = {(unsigned)rx[0], (unsigned)ry[0], (unsigned)rx[1], (unsigned)ry[1]};
                    const int row = u.pm * 256 + ai * 128 + wr * 64 + (2 * mp + (fq & 1)) * 16 + fr;
                    *(GAS v4u*)((GAS unsigned char*)YB + (size_t)row * 1024 + col - 8 * (fq & 1)) = o; } }
    }
};


__device__ __forceinline__ int crow(int r, int hi) { return (r & 3) + 8 * (r >> 2) + 4 * hi; }
__device__ __forceinline__ void attn_step(const bool MASK, const LAS unsigned char* Kl, const LAS unsigned char* Vl, const int pitchV, const int kvoff, const bf16x8 (&qf)[2][4],
                                          float (&mrun)[2], float (&lrun)[2], f32x16 (&o)[2][2], const int r32, const int hi, const int dq0) {
    bf16x8 kf[4], vf[2][2];
#pragma unroll
    for (int ks = 0; ks < 4; ++ks) kf[ks] = *(const LAS bf16x8*)(Kl + (kvoff + r32) * 144 + ks * 32 + hi * 16);
#pragma unroll
    for (int dt = 0; dt < 2; ++dt)
#pragma unroll
        for (int s2 = 0; s2 < 2; ++s2) vf[dt][s2] = *(const LAS bf16x8*)(Vl + (32 * dt + r32) * pitchV + (kvoff + 16 * s2) * 2 + hi * 16);
#pragma unroll
    for (int qt = 0; qt < 2; ++qt) {
        f32x16 s = {0.f, 0.f, 0.f, 0.f, 0.f, 0.f, 0.f, 0.f, 0.f, 0.f, 0.f, 0.f, 0.f, 0.f, 0.f, 0.f};
#pragma unroll
        for (int ks = 0; ks < 4; ++ks) s = __builtin_amdgcn_mfma_f32_32x32x16_bf16(kf[ks], qf[qt][ks], s, 0, 0, 0);
        if (MASK) {
#pragma unroll
            for (int r = 0; r < 16; ++r) { const int dd = dq0 - 32 * qt + crow(r, hi); if (dd > 128 || dd < -128) s[r] = -INFINITY; }
        }
        float mx = fmaxf(fmaxf(s[0], s[1]), s[2]);
#pragma unroll
        for (int r = 3; r < 15; r += 2) mx = fmaxf(fmaxf(mx, s[r]), s[r + 1]);
        mx = fmaxf(mx, s[15]);
        { const unsigned u = __builtin_bit_cast(unsigned, mx); auto rr = __builtin_amdgcn_permlane32_swap(u, u, false, false); mx = fmaxf(__builtin_bit_cast(float, (unsigned)rr[0]), __builtin_bit_cast(float, (unsigned)rr[1])); }
        if (__any(mx > mrun[qt])) {
            const float mn = fmaxf(mrun[qt], mx), f = __builtin_amdgcn_exp2f(mrun[qt] - mn); mrun[qt] = mn; lrun[qt] *= f;
#pragma unroll
            for (int dt = 0; dt < 2; ++dt) o[qt][dt] = o[qt][dt] * f;
        }
        const float mn = mrun[qt];
        float ps = 0.f;
#pragma unroll
        for (int r = 0; r < 16; ++r) { const float p = __builtin_amdgcn_exp2f(s[r] - mn); s[r] = p; ps += p; }
        lrun[qt] += ps;
        bf16x8 pb[2];
#pragma unroll
        for (int s2 = 0; s2 < 2; ++s2) { v4u w; w.x = cvt_pk_bf16(s[8 * s2 + 0], s[8 * s2 + 1]); w.y = cvt_pk_bf16(s[8 * s2 + 2], s[8 * s2 + 3]); w.z = cvt_pk_bf16(s[8 * s2 + 4], s[8 * s2 + 5]); w.w = cvt_pk_bf16(s[8 * s2 + 6], s[8 * s2 + 7]);
            pb[s2] = __builtin_bit_cast(bf16x8, w); }
#pragma unroll
        for (int dt = 0; dt < 2; ++dt)
#pragma unroll
            for (int s2 = 0; s2 < 2; ++s2) o[qt][dt] = __builtin_amdgcn_mfma_f32_32x32x16_bf16(vf[dt][s2], pb[s2], o[qt][dt], 0, 0, 0);
    }
}
__device__ __forceinline__ void attn_unit(Frame& F, int b, int kvh, int qb) {
    LAS unsigned char* lds = F.lds;
    const int tid = F.tid, lane = F.lane, w = F.wave, r32 = lane & 31, hi = lane >> 5;
    const int h = kvh * 4 + (w >> 1), s0 = qb * 128, q0 = s0 + 64 * (w & 1);
    bf16x8 qf[2][4];
#pragma unroll
    for (int qt = 0; qt < 2; ++qt)
#pragma unroll
        for (int ks = 0; ks < 4; ++ks) qf[qt][ks] = *(const GAS bf16x8*)(F.Q + (size_t)(b * SEQ + q0 + 32 * qt + r32) * QW + h * 64 + 16 * ks + 8 * hi);
    float mrun[2] = {-INFINITY, -INFINITY}, lrun[2] = {0.f, 0.f};
    f32x16 o[2][2];
#pragma unroll
    for (int qt = 0; qt < 2; ++qt)
#pragma unroll
        for (int dt = 0; dt < 2; ++dt)
#pragma unroll
            for (int r = 0; r < 16; ++r) o[qt][dt][r] = 0.f;
    {
        HPT_B(30);
        LAS unsigned char* Kl = lds; LAS unsigned char* Vl = lds + 36864;
        v4u rk[4], rv[4];
#pragma unroll
        for (int i = 0; i < 4; ++i) { const int idx = tid + 512 * i; rk[i] = *(const GAS v4u*)(F.KC + (size_t)(b * CTXL + (idx >> 3)) * KVW + kvh * 64 + (idx & 7) * 8);
            rv[i] = *(const GAS v4u*)(F.VTC + (size_t)((b * 2 + kvh) * 64 + (idx >> 5)) * CTXL + (idx & 31) * 8); }
#pragma unroll
        for (int i = 0; i < 4; ++i) { const int idx = tid + 512 * i; *(LAS v4u*)(Kl + (idx >> 3) * 144 + (idx & 7) * 16) = rk[i]; { const int ch = idx & 31; LAS unsigned char* vd = Vl + (idx >> 5) * 528 + (ch >> 1) * 32 + (ch & 1) * 8; *(LAS u32x2*)vd = (u32x2){rv[i].x, rv[i].y}; *(LAS u32x2*)(vd + 16) = (u32x2){rv[i].z, rv[i].w}; } }
        __syncthreads(); HPT_E(30); HPT_B(31);
        for (int st = 0; st < 8; ++st) attn_step(false, Kl, Vl, 528, 32 * st, qf, mrun, lrun, o, r32, hi, 0);
        __syncthreads(); HPT_E(31);
    }
    {
        LAS unsigned char* Kl = lds; LAS unsigned char* Vl = lds + 55296; const int kbase = s0 - 128;
        HPT_B(32);
        v4u rk[6], rv[6];
#pragma unroll
        for (int i = 0; i < 6; ++i) { const int idx = tid + 512 * i; { const int row = idx >> 3, ch = idx & 7; int kp = kbase + row; kp = kp < 0 ? 0 : (kp >= SEQ ? SEQ - 1 : kp); rk[i] = *(const GAS v4u*)(F.K + (size_t)(b * SEQ + kp) * KVW + kvh * 64 + ch * 8); }
            { const int row = idx / 48, ch = idx % 48; int kp = kbase + 8 * ch; kp = kp < 0 ? 0 : (kp >= SEQ ? SEQ - 8 : kp); rv[i] = *(const GAS v4u*)(F.VT + (size_t)((b * 2 + kvh) * 64 + row) * SEQ + kp); } }
#pragma unroll
        for (int i = 0; i < 6; ++i) { const int idx = tid + 512 * i; *(LAS v4u*)(Kl + (idx >> 3) * 144 + (idx & 7) * 16) = rk[i]; { const int ch = idx % 48; LAS unsigned char* vd = Vl + (idx / 48) * 784 + (ch >> 1) * 32 + (ch & 1) * 8; *(LAS u32x2*)vd = (u32x2){rv[i].x, rv[i].y}; *(LAS u32x2*)(vd + 16) = (u32x2){rv[i].z, rv[i].w}; } }
        __syncthreads(); HPT_E(32); HPT_B(33);
        for (int st = 0; st < 10; ++st) { const int kp0 = q0 - 128 + 32 * st; if (kp0 < 0 || kp0 >= SEQ) continue;
            attn_step(st < 2 || st >= 8, Kl, Vl, 784, kp0 - kbase, qf, mrun, lrun, o, r32, hi, kp0 - q0 - r32); }
        __syncthreads();
    }
    HPT_E(33);
    const float sk = F.sink[h] * LOG2E;
#pragma unroll
    for (int qt = 0; qt < 2; ++qt) { float l = lrun[qt] + __shfl_xor(lrun[qt], 32); l += __builtin_amdgcn_exp2f(sk - mrun[qt]); const float inv = 1.f / l;
#if M8
        GAS unsigned char* op = (GAS unsigned char*)F.ATT + (size_t)(b * SEQ + q0 + 32 * qt + r32) * QW + h * 64;
#pragma unroll
        for (int dt = 0; dt < 2; ++dt)
#pragma unroll
            for (int rp = 0; rp < 2; ++rp) { unsigned wa[2];
#pragma unroll
                for (int q = 0; q < 2; ++q) { const int rg = 2 * rp + q; wa[q] = pk4_fp8(o[qt][dt][4 * rg] * inv, o[qt][dt][4 * rg + 1] * inv, o[qt][dt][4 * rg + 2] * inv, o[qt][dt][4 * rg + 3] * inv); }
                auto rr = __builtin_amdgcn_permlane32_swap(wa[0], wa[1], false, false);
                *(GAS u32x2*)(op + 32 * dt + 8 * (2 * rp + hi)) = (u32x2){(unsigned)rr[0], (unsigned)rr[1]}; } }
#else
        GAS bf16* op = F.ATT + (size_t)(b * SEQ + q0 + 32 * qt + r32) * QW + h * 64;
#pragma unroll
        for (int dt = 0; dt < 2; ++dt)
#pragma unroll
            for (int rg = 0; rg < 4; ++rg) { u32x2 wv; wv.x = cvt_pk_bf16(o[qt][dt][4 * rg] * inv, o[qt][dt][4 * rg + 1] * inv); wv.y = cvt_pk_bf16(o[qt][dt][4 * rg + 2] * inv, o[qt][dt][4 * rg + 3] * inv);
                *(GAS u32x2*)(op + 32 * dt + 8 * rg + 4 * hi) = wv; } }
#endif
}

constexpr int HZ_PITCH = 4112, HG_OFF = 16 * HZ_PITCH  , HG_PITCH = 8224;
__device__ __forceinline__ void hy_load_filter(LAS unsigned char* GC, const GAS bf16* G, int tid) {
    const GAS v4u* gp = (const GAS v4u*)G;
    const v4u a = gp[tid]; v4u b = {0u, 0u, 0u, 0u}; if (tid < 511) b = gp[tid + 1];
    const unsigned w[8] = {a.x, a.y, a.z, a.w, b.x, b.y, b.z, b.w};
#pragma unroll
    for (int rho = 0; rho < 8; ++rho) { v4u o; unsigned t[4];
#pragma unroll
        for (int dd = 0; dd < 4; ++dd) { const int base = (rho >> 1) + dd; t[dd] = (rho & 1) ? __builtin_amdgcn_alignbit(w[base + 1 > 7 ? 7 : base + 1], w[base], 16) : w[base]; }
        o.x = t[0]; o.y = t[1]; o.z = t[2]; o.w = t[3];
        *(LAS v4u*)(GC + rho * HG_PITCH + tid * 16) = o; }
}
__device__ __forceinline__ f32x4 hy_short4(const GAS bf16* up, int t, float w0, float w1, float w2, float bs) {
    const u32x2 v = *(const GAS u32x2*)(up + t);
    const float u0 = bflo(v.x), u1 = bfhi(v.x), u2 = bflo(v.y), u3 = bfhi(v.y);
    const float um = t > 0 ? bf2f(up[t - 1]) : 0.f, up4 = t + 4 < SEQ ? bf2f(up[t + 4]) : 0.f;
    f32x4 r; r[0] = bs + w0 * um + w1 * u0 + w2 * u1; r[1] = bs + w0 * u0 + w1 * u1 + w2 * u2; r[2] = bs + w0 * u1 + w1 * u2 + w2 * u3; r[3] = bs + w0 * u2 + w1 * u3 + w2 * up4; return r;
}
__device__ __forceinline__ void hy_conv(const LAS unsigned char* Z, const LAS unsigned char* GC, int T0, int fr, int fq, f32x4 (&acc)[16]) {
    const int rho = (8 - (fr & 7)) & 7;
    const LAS unsigned char* gb = GC + rho * HG_PITCH + (2048 - fr + 8 * fq - rho - T0) * 2;
    const LAS unsigned char* zb = Z + fr * HZ_PITCH + fq * 16;
    bf16x8 W[16], Bf, nA0, nA1, nB;
#pragma unroll
    for (int m = 0; m < 16; ++m) { W[m] = *(const LAS bf16x8*)(gb + (-16 * m) * 2); acc[m] = (f32x4){0.f, 0.f, 0.f, 0.f}; }
    Bf = *(const LAS bf16x8*)zb;
    for (int jj = 0; jj < 8; ++jj) {
#pragma unroll
        for (int ji = 0; ji < 8; ++ji) {
            const int j = 8 * jj + ji, jn = j + 1 < 64 ? j + 1 : 63;
            nA0 = *(const LAS bf16x8*)(gb + (32 * jn) * 2); nA1 = *(const LAS bf16x8*)(gb + (32 * jn - 16) * 2); nB = *(const LAS bf16x8*)(zb + 64 * jn);
            __builtin_amdgcn_sched_barrier(0);
#pragma unroll
            for (int m = 0; m < 16; ++m) acc[m] = __builtin_amdgcn_mfma_f32_16x16x32_bf16(W[(m - 2 * ji) & 15], Bf, acc[m], 0, 0, 0);
            W[(-2 * (ji + 1)) & 15] = nA0; W[(1 - 2 * (ji + 1)) & 15] = nA1; Bf = nB;
        }
    }
}
__device__ __forceinline__ void hyena_channel(Frame& F, int c) {
    LAS unsigned char* Z = F.lds; LAS unsigned char* GC = F.lds + HG_OFF;
    const int tid = F.tid, lane = F.lane, fr = lane & 15, fq = lane >> 4, T0 = 256 * F.wave;
    HPT_B(13);
    { const int cv = 1024 + c; const float w0 = F.cw[cv], w1 = F.cw[1536 + cv], w2 = F.cw[3072 + cv], bs = F.cb[cv];
#pragma unroll 1
      for (int i0 = 0; i0 < 8; i0 += 4) {
      v4u raw[4]; unsigned short hm1[4], hp8[4];
#pragma unroll
      for (int i = 0; i < 4; ++i) { const int chunk = tid + 512 * (i0 + i), b = chunk >> 8, tc = (chunk & 255) * 8; const GAS bf16* up = F.UT + (size_t)cv * T + b * SEQ;
          raw[i] = *(const GAS v4u*)(up + tc); hm1[i] = tc > 0 ? up[tc - 1] : (unsigned short)0; hp8[i] = tc + 8 < SEQ ? up[tc + 8] : (unsigned short)0; }
#pragma unroll
      for (int i = 0; i < 4; ++i) { const int chunk = tid + 512 * (i0 + i), b = chunk >> 8, tc = (chunk & 255) * 8;
          float u[10]; u[0] = bf2f(hm1[i]); u[1] = bflo(raw[i].x); u[2] = bfhi(raw[i].x); u[3] = bflo(raw[i].y); u[4] = bfhi(raw[i].y); u[5] = bflo(raw[i].z); u[6] = bfhi(raw[i].z); u[7] = bflo(raw[i].w); u[8] = bfhi(raw[i].w); u[9] = bf2f(hp8[i]);
          float r[8];
#pragma unroll
          for (int k = 0; k < 8; ++k) r[k] = bs + w0 * u[k] + w1 * u[k + 1] + w2 * u[k + 2];
          v4u o; o.x = pk2(r[0], r[1]); o.y = pk2(r[2], r[3]); o.z = pk2(r[4], r[5]); o.w = pk2(r[6], r[7]);
          *(LAS v4u*)(Z + b * HZ_PITCH + tc * 2) = o; } } }
    hy_load_filter(GC, F.G_ + (size_t)c * 4096, tid);
    __syncthreads(); HPT_E(13);
    f32x4 acc[16];
    HPT_B(11); hy_conv(Z, GC, T0, fr, fq, acc); HPT_E(11);
    HPT_B(14);
    { const float w0 = F.cw[c], w1 = F.cw[1536 + c], w2 = F.cw[3072 + c], bs = F.cb[c], sk = F.skip[c]; const GAS bf16* up = F.UT + (size_t)c * T + fr * SEQ;
#pragma unroll
      for (int m = 0; m < 16; ++m) { int t = T0 + 16 * m + 4 * fq; asm volatile("" : "+v"(t)); const u32x2 zo = *(const LAS u32x2*)(Z + fr * HZ_PITCH + t * 2); const f32x4 xs = hy_short4(up, t, w0, w1, w2, bs);
          acc[m][0] = xs[0] * (acc[m][0] + sk * bflo(zo.x)); acc[m][1] = xs[1] * (acc[m][1] + sk * bfhi(zo.x)); acc[m][2] = xs[2] * (acc[m][2] + sk * bflo(zo.y)); acc[m][3] = xs[3] * (acc[m][3] + sk * bfhi(zo.y)); } }
    HPT_E(14); HPT_B(15);
    __syncthreads();
#pragma unroll
    for (int m = 0; m < 16; ++m) { const int t = T0 + 16 * m + 4 * fq; u32x2 wv; wv.x = pk2(acc[m][0], acc[m][1]); wv.y = pk2(acc[m][2], acc[m][3]); *(LAS u32x2*)(Z + fr * HZ_PITCH + t * 2) = wv; }
    hy_load_filter(GC, F.G_ + (size_t)(512 + c) * 4096, tid);
    __syncthreads(); HPT_E(15);
    HPT_B(11); hy_conv(Z, GC, T0, fr, fq, acc); HPT_E(11);
    HPT_B(12);
    { const int cx = 512 + c; const float w0 = F.cw[cx], w1 = F.cw[1536 + cx], w2 = F.cw[3072 + cx], bs = F.cb[cx], sk = F.skip[512 + c]; const GAS bf16* up = F.UT + (size_t)cx * T + fr * SEQ;
      GAS bf16* hp = F.HYT + (size_t)c * T + fr * SEQ;
#pragma unroll
      for (int m = 0; m < 16; ++m) { int t = T0 + 16 * m + 4 * fq; asm volatile("" : "+v"(t)); const u32x2 zo = *(const LAS u32x2*)(Z + fr * HZ_PITCH + t * 2); const f32x4 xs = hy_short4(up, t, w0, w1, w2, bs);
          u32x2 wv; wv.x = pk2(xs[0] * (acc[m][0] + sk * bflo(zo.x)), xs[1] * (acc[m][1] + sk * bfhi(zo.x))); wv.y = pk2(xs[2] * (acc[m][2] + sk * bflo(zo.y)), xs[3] * (acc[m][3] + sk * bfhi(zo.y)));
          *(GAS u32x2*)(hp + t) = wv; } }
    __syncthreads();
    HPT_E(12);
}

__device__ __forceinline__ void hyt_transpose(Frame& F) {
    LAS unsigned short* scr = (LAS unsigned short*)(F.lds + F.wave * 16384);
    const int gw = F.vcu * NWAVES + F.wave, NGW = F.G * NWAVES, lane = F.lane, tcx = lane & 7, r8 = lane >> 3;
    GAS bf16* HY = M8 ? (GAS bf16*)((GAS unsigned char*)F.ATT + (size_t)T * QW) : F.ATT + (size_t)T * QW;
    for (int it = gw; it < 4096; it += NGW) {
        const int cb = it & 7, tb = it >> 3;
        v4u raw[8];
#pragma unroll
        for (int i = 0; i < 8; ++i) raw[i] = *(const GAS v4u*)(F.HYT + (size_t)(64 * cb + r8 + 8 * i) * T + 64 * tb + 8 * tcx);
#pragma unroll
        for (int i = 0; i < 8; ++i) { const int ch = r8 + 8 * i; LAS unsigned short* d = scr + (8 * tcx) * 66 + ch;
            d[0 * 66] = (unsigned short)raw[i].x; d[1 * 66] = (unsigned short)(raw[i].x >> 16); d[2 * 66] = (unsigned short)raw[i].y; d[3 * 66] = (unsigned short)(raw[i].y >> 16);
            d[4 * 66] = (unsigned short)raw[i].z; d[5 * 66] = (unsigned short)(raw[i].z >> 16); d[6 * 66] = (unsigned short)raw[i].w; d[7 * 66] = (unsigned short)(raw[i].w >> 16); }
        LDS_WAIT(); asm volatile("" ::: "memory");
#pragma unroll
        for (int i = 0; i < 8; ++i) { const int t = r8 + 8 * i; const LAS unsigned* sp = (const LAS unsigned*)(scr + t * 66 + 8 * tcx);
            v4u o; o.x = sp[0]; o.y = sp[1]; o.z = sp[2]; o.w = sp[3];
#if M8
            { u32x2 o8; o8.x = pk4_fp8(fminf(fmaxf(bflo(o.x), -448.f), 448.f), fminf(fmaxf(bfhi(o.x), -448.f), 448.f), fminf(fmaxf(bflo(o.y), -448.f), 448.f), fminf(fmaxf(bfhi(o.y), -448.f), 448.f));
              o8.y = pk4_fp8(fminf(fmaxf(bflo(o.z), -448.f), 448.f), fminf(fmaxf(bfhi(o.z), -448.f), 448.f), fminf(fmaxf(bflo(o.w), -448.f), 448.f), fminf(fmaxf(bfhi(o.w), -448.f), 448.f));
              *(GAS u32x2*)((GAS unsigned char*)HY + (size_t)(64 * tb + t) * HYW + 64 * cb + 8 * tcx) = o8; } }
#else
            *(GAS v4u*)(HY + (size_t)(64 * tb + t) * HYW + 64 * cb + 8 * tcx) = o; }
#endif
        LDS_WAIT(); asm volatile("" ::: "memory");
    }
}

__device__ __forceinline__ void load_row16_raw(const GAS bf16* base, int row, int lane, u32x2 (&t)[4]) {
    const GAS u32x2* vr = (const GAS u32x2*)(base + (size_t)row * D) + lane;
#pragma unroll
    for (int j = 0; j < 4; ++j) t[j] = vr[64 * j];
}
__device__ __forceinline__ void row16_cvt(const u32x2 (&t)[4], f32x4 (&v)[4]) {
#pragma unroll
    for (int j = 0; j < 4; ++j) v[j] = (f32x4){bflo(t[j].x), bfhi(t[j].x), bflo(t[j].y), bfhi(t[j].y)};
}
__device__ __forceinline__ void load_row8x2_raw(const GAS bf16* base, int row, int lane, v4u (&t)[2]) {
    const GAS v4u* vr = (const GAS v4u*)(base + (size_t)row * D) + lane; t[0] = vr[0]; t[1] = vr[64];
}
__device__ __forceinline__ void row8x2_cvt(const v4u (&t)[2], f32x4 (&v)[4]) {
#pragma unroll
    for (int p = 0; p < 2; ++p) { v[2 * p] = (f32x4){bflo(t[p].x), bfhi(t[p].x), bflo(t[p].y), bfhi(t[p].y)}; v[2 * p + 1] = (f32x4){bflo(t[p].z), bfhi(t[p].z), bflo(t[p].w), bfhi(t[p].w)}; }
}
__device__ __forceinline__ void load_row16(const GAS bf16* base, int row, int lane, f32x4 (&v)[4]) {
    u32x2 t[4]; load_row16_raw(base, row, lane, t); row16_cvt(t, v);
}
__device__ __forceinline__ void ln_inplace(f32x4 (&v)[4]) {
    float s = 0.f;
#pragma unroll
    for (int j = 0; j < 4; ++j) s += (v[j].x + v[j].y) + (v[j].z + v[j].w);
    const float mean = wave_sum(s) * (1.f / D); float s2 = 0.f;
#pragma unroll
    for (int j = 0; j < 4; ++j) { v[j] = v[j] - mean; s2 += (v[j].x * v[j].x + v[j].y * v[j].y) + (v[j].z * v[j].z + v[j].w * v[j].w); }
    const float rstd = 1.f / sqrtf(wave_sum(s2) * (1.f / D) + LN_EPS);
#pragma unroll
    for (int j = 0; j < 4; ++j) v[j] = v[j] * rstd;
}
typedef _Float16 f16x8 __attribute__((ext_vector_type(8)));
typedef _Float16 f16x4 __attribute__((ext_vector_type(4)));
__device__ __forceinline__ void ln_inplace4(f32x4 (&v)[4][4]) {
    float s[4], q[4];
#pragma unroll
    for (int r = 0; r < 4; ++r) { s[r] = 0.f;
#pragma unroll
        for (int j = 0; j < 4; ++j) s[r] += (v[r][j].x + v[r][j].y) + (v[r][j].z + v[r][j].w); }
#pragma unroll
    for (int r = 0; r < 4; ++r) s[r] = wave_sum(s[r]) * (1.f / D);
#pragma unroll
    for (int r = 0; r < 4; ++r) { q[r] = 0.f;
#pragma unroll
        for (int j = 0; j < 4; ++j) { v[r][j] = v[r][j] - s[r]; q[r] += (v[r][j].x * v[r][j].x + v[r][j].y * v[r][j].y) + (v[r][j].z * v[r][j].z + v[r][j].w * v[r][j].w); } }
#pragma unroll
    for (int r = 0; r < 4; ++r) q[r] = 1.f / sqrtf(wave_sum(q[r]) * (1.f / D) + LN_EPS);
#pragma unroll
    for (int r = 0; r < 4; ++r)
#pragma unroll
        for (int j = 0; j < 4; ++j) v[r][j] = v[r][j] * q[r];
}
__device__ __forceinline__ void p6_route(Frame& F) {
    constexpr int RP = 2064;
    LAS unsigned char* W16 = F.lds;
    LAS unsigned char* HT = F.lds + 32 * RP;
    LAS float* LG = (LAS float*)(F.lds + 64 * RP);
    LAS int* rec = (LAS int*)(F.lds + 64 * RP + 8192);
    LAS float* recg = (LAS float*)(F.lds + 64 * RP + 8192 + 2048);
    LAS int* lcnt = (LAS int*)(F.lds + 64 * RP + 8192 + 4096);
    LAS int* lbase = lcnt + 32;
    const int tid = F.tid, lane = F.lane, w = F.wave, fr = lane & 15, fq = lane >> 4;
    for (int i = tid; i < 32768; i += NWAVES * 64) { const int k = i >> 5, e = i & 31; *(LAS _Float16*)(W16 + e * RP + k * 2) = (_Float16)F.rw[i]; }
    if (tid < 32) lcnt[tid] = 0;
    __syncthreads();
    const float rbias = F.rb[lane & 31];
    const int mt = w & 1, nt = (w >> 1) & 1, kh = w >> 2;
    for (int chunk = blockIdx.x; chunk < 256; chunk += F.G) {
        const int b = chunk >> 4;
        v4u raw[4][2];
#pragma unroll
        for (int rr = 0; rr < 4; ++rr) load_row8x2_raw(F.V1, chunk * 128 + 4 * w + rr, lane, raw[rr]);
#pragma unroll 1
        for (int grp = 0; grp < 4; ++grp) {
            const int rg0 = chunk * 128 + grp * 32;
            {
                f32x4 v[4][4];
#pragma unroll
                for (int rr = 0; rr < 4; ++rr) row8x2_cvt(raw[rr], v[rr]);
                int lo = 8 * lane; asm volatile("" : "+v"(lo));
                ln_inplace4(v);
#pragma unroll
                for (int rr = 0; rr < 4; ++rr)
#pragma unroll
                    for (int j = 0; j < 4; ++j) v[rr][j] = v[rr][j] * *(const GAS f32x4*)(F.ln1g + lo + 512 * (j >> 1) + 4 * (j & 1)) + *(const GAS f32x4*)(F.ln1b + lo + 512 * (j >> 1) + 4 * (j & 1));
                ln_inplace4(v);
#pragma unroll
                for (int rr = 0; rr < 4; ++rr) { const int rl = 4 * w + rr;
#pragma unroll
                    for (int j = 0; j < 4; ++j) v[rr][j] = v[rr][j] * (*(const GAS f32x4*)(F.modF + b * 6144 + 4096 + lo + 512 * (j >> 1) + 4 * (j & 1)) + 1.f) + *(const GAS f32x4*)(F.modF + b * 6144 + 3072 + lo + 512 * (j >> 1) + 4 * (j & 1));
#pragma unroll
                    for (int p = 0; p < 2; ++p) { const f32x4 a = v[rr][2 * p], c = v[rr][2 * p + 1];
                        u32x2 w8; w8.x = pk4_fp8(a.x, a.y, a.z, a.w); w8.y = pk4_fp8(c.x, c.y, c.z, c.w);
                        *(GAS u32x2*)((GAS unsigned char*)F.HM + (size_t)(rg0 + rl) * D + 8 * lane + 512 * p) = w8;
                        const f16x8 hv = {(_Float16)a.x, (_Float16)a.y, (_Float16)a.z, (_Float16)a.w, (_Float16)c.x, (_Float16)c.y, (_Float16)c.z, (_Float16)c.w};
                        *(LAS f16x8*)(HT + rl * RP + (8 * lane + 512 * p) * 2) = hv; } }
                if (grp < 3) {
#pragma unroll
                    for (int rr = 0; rr < 4; ++rr) load_row8x2_raw(F.V1, rg0 + 32 + 4 * w + rr, lane, raw[rr]); }
            }
            __syncthreads();
            {
                f32x4 acc = {0.f, 0.f, 0.f, 0.f};
                const LAS unsigned char* wp = W16 + (16 * nt + fr) * RP + (512 * kh + 8 * fq) * 2; const LAS unsigned char* hp = HT + (16 * mt + fr) * RP + (512 * kh + 8 * fq) * 2;
#pragma unroll 4
                for (int s2 = 0; s2 < 16; ++s2) acc = __builtin_amdgcn_mfma_f32_16x16x32_f16(*(const LAS f16x8*)(wp + 64 * s2), *(const LAS f16x8*)(hp + 64 * s2), acc, 0, 0, 0);
#pragma unroll
                for (int k = 0; k < 4; ++k) LG[(kh * 32 + 16 * mt + fr) * 32 + 16 * nt + 4 * fq + k] = acc[k];
            }
            __syncthreads();
#pragma unroll 1
            for (int i = 0; i < 4; ++i) { const int rl = 4 * w + i;
                float cur = LG[rl * 32 + (lane & 31)] + LG[(32 + rl) * 32 + (lane & 31)] + rbias;
                float tv[4]; int te[4];
#pragma unroll
                for (int k = 0; k < 4; ++k) { const float mx = wave_max(cur);
                    const unsigned long long mask = __ballot(cur == mx); const int src = __ffsll((long long)mask) - 1; te[k] = src & 31; tv[k] = mx; if ((lane & 31) == te[k]) cur = -INFINITY; }
                const float p1 = __expf(tv[1] - tv[0]), p2 = __expf(tv[2] - tv[0]), p3 = __expf(tv[3] - tv[0]), inv = 1.f / (1.f + p1 + p2 + p3);
                if (lane < 4) { const int es = lane == 0 ? te[0] : lane == 1 ? te[1] : lane == 2 ? te[2] : te[3]; const float gs = (lane == 0 ? 1.f : lane == 1 ? p1 : lane == 2 ? p2 : p3) * inv;
                    const int rc = grp * 32 + rl;
                    const int rank = __hip_atomic_fetch_add(lcnt + es, 1, __ATOMIC_RELAXED, __HIP_MEMORY_SCOPE_WORKGROUP);
                    rec[rc * 4 + lane] = es | (rank << 5); recg[rc * 4 + lane] = gs; }
            }
            __syncthreads();
        }
        if (tid < 32) { gu32* cp = F.ctl; asm volatile("" : "+s"(cp)); const int cnt = lcnt[tid]; lbase[tid] = cnt ? (int)__hip_atomic_fetch_add(cp + CW_CNT + tid, (unsigned)cnt, RLX_AGENT) : 0; }
        __syncthreads();
        { const int r = rec[tid], e = r & 31, pos = lbase[e] + (r >> 5), row = chunk * 128 + (tid >> 2);
          F.tok[e * 32768 + pos] = row; F.asg[row * 4 + (tid & 3)] = e * 32768 + pos; F.gw[row * 4 + (tid & 3)] = recg[tid]; }
        __syncthreads();
        if (tid < 32) lcnt[tid] = 0;
        __syncthreads();
    }
}
__device__ __forceinline__ void moe_tables(Frame& F) {
    LAS int* tp = (LAS int*)(F.lds + TP_OFF);
    if (F.tid < 32) { gu32* cp = F.ctl; asm volatile("" : "+s"(cp)); const int cnt = (int)__hip_atomic_load(cp + CW_CNT + F.tid, RLX_AGENT);
        tp[33 + F.tid] = cnt; tp[65 + F.tid] = (cnt + 255) >> 8; }
    __syncthreads();
    if (F.tid < 33) { int a = 0;
        for (int e = 0; e < 32; ++e) a += (e < F.tid) ? tp[65 + e] : 0;
        tp[F.tid] = a; }
    __syncthreads();
}

typedef int i32x4 __attribute__((ext_vector_type(4)));
__device__ __forceinline__ void p9_final(Frame& F) {
    const LAS int* tp = (const LAS int*)(F.lds + TP_OFF);
    const int lane = F.lane;
    f32x4 g1v[4], b1v[4], g2v[4], b2v[4];
#pragma unroll
    for (int j = 0; j < 4; ++j) { const int col = 4 * lane + 256 * j; g1v[j] = *(const GAS f32x4*)(F.ln1g + col); b1v[j] = *(const GAS f32x4*)(F.ln1b + col); g2v[j] = *(const GAS f32x4*)(F.ln2g + col); b2v[j] = *(const GAS f32x4*)(F.ln2b + col); }
    for (int chunk = blockIdx.x; chunk < 256; chunk += F.G) {
        const int b = chunk >> 4, row0 = chunk * 128 + F.wave * 16;
        f32x4 gm[4];
#pragma unroll
        for (int j = 0; j < 4; ++j) gm[j] = *(const GAS f32x4*)(F.modF + b * 6144 + 5120 + 4 * lane + 256 * j);
        f32x4 v[4]; i32x4 a = *(const GAS i32x4*)(F.asg + row0 * 4); f32x4 g = *(const GAS f32x4*)(F.gw + row0 * 4);
        load_row16(F.V1, row0, lane, v);
        for (int it = 0; it < 16; ++it) {
            const int row = row0 + it, rn = it < 15 ? row + 1 : row;
            unsigned y[4][4];
#pragma unroll
            for (int k = 0; k < 4; ++k) { const int e = a[k] >> 15, pos = a[k] & 32767; const GAS unsigned char* yp = (const GAS unsigned char*)F.YB + (size_t)(256 * tp[e] + pos) * D + 4 * lane;
#pragma unroll
                for (int j = 0; j < 4; ++j) y[k][j] = __builtin_nontemporal_load((const GAS unsigned*)(yp + 256 * j)); }
            f32x4 nv[4]; load_row16(F.V1, rn, lane, nv);
            const i32x4 na = *(const GAS i32x4*)(F.asg + rn * 4); const f32x4 ng = *(const GAS f32x4*)(F.gw + rn * 4);
            ln_inplace(v);
#pragma unroll
            for (int j = 0; j < 4; ++j) { f32x4 f = {0.f, 0.f, 0.f, 0.f};
#pragma unroll
                for (int k = 0; k < 4; ++k) { const f32x2 lo = __builtin_amdgcn_cvt_pk_f32_fp8((int)y[k][j], false), hi = __builtin_amdgcn_cvt_pk_f32_fp8((int)y[k][j], true); f[0] += g[k] * lo[0]; f[1] += g[k] * lo[1]; f[2] += g[k] * hi[0]; f[3] += g[k] * hi[1]; }
                v[j] = (v[j] * g1v[j] + b1v[j]) * DN_ALPHA + gm[j] * f; }
            ln_inplace(v);
#pragma unroll
            for (int j = 0; j < 4; ++j) __builtin_nontemporal_store(v[j] * g2v[j] + b2v[j], (GAS f32x4*)(F.out + (size_t)row * D + 4 * lane + 256 * j));
#pragma unroll
            for (int j = 0; j < 4; ++j) v[j] = nv[j];
            a = na; g = ng;
        }
    }
}

struct Args { const float* in[29]; float* out; unsigned char* ws; int ph_lo, ph_hi; };
__global__ void __launch_bounds__(NWAVES * 64, 2) mk_fwd(Args args) {
    extern __shared__ __attribute__((aligned(16))) unsigned char lds[];
    Frame F;
    F.lds = (LAS unsigned char*)lds;
    F.MISC = (volatile LAS unsigned*)(F.lds + MISC_OFF);
    F.tid = threadIdx.x; F.lane = F.tid & 63; F.wave = __builtin_amdgcn_readfirstlane(F.tid >> 6);
    F.G = gridDim.x; { const int bx = blockIdx.x; F.vcu = (F.G % 8 == 0) ? (bx % 8) * (F.G / 8) + bx / 8 : bx; }
    unsigned char* ws = args.ws;
    F.ctl = (gu32*)(ws + WS_CTL);
    F.x = (const GAS float*)args.in[0]; F.c = (const GAS float*)args.in[1]; F.ctx = (const GAS float*)args.in[2]; F.c_ctx = (const GAS float*)args.in[3]; F.w_mod = (const GAS float*)args.in[4]; F.b_mod = (const GAS float*)args.in[5]; F.w_in = (const GAS float*)args.in[6]; F.sink = (const GAS float*)args.in[7];
    F.cw = (const GAS float*)args.in[8]; F.cb = (const GAS float*)args.in[9]; F.fw1 = (const GAS float*)args.in[10]; F.fb1 = (const GAS float*)args.in[11]; F.fw2 = (const GAS float*)args.in[12]; F.fb2 = (const GAS float*)args.in[13]; F.fw3 = (const GAS float*)args.in[14]; F.skip = (const GAS float*)args.in[15];
    F.w_ba = (const GAS float*)args.in[16]; F.w_bh = (const GAS float*)args.in[17]; F.w_out = (const GAS float*)args.in[18]; F.ln1g = (const GAS float*)args.in[19]; F.ln1b = (const GAS float*)args.in[20]; F.rw = (const GAS float*)args.in[21]; F.rb = (const GAS float*)args.in[22];
    F.ew1 = (const GAS float*)args.in[23]; F.eb1 = (const GAS float*)args.in[24]; F.ew2 = (const GAS float*)args.in[25]; F.eb2 = (const GAS float*)args.in[26]; F.ln2g = (const GAS float*)args.in[27]; F.ln2b = (const GAS float*)args.in[28]; F.out = (GAS float*)args.out;
    F.modP = (GAS float*)(ws + WS_MODP); F.modF = (GAS float*)(ws + WS_MODF); F.rope = (GAS float*)(ws + WS_ROPE); F.gw = (GAS float*)(ws + WS_GW); F.V1 = (GAS bf16*)(ws + WS_V1);
    F.asg = (GAS int*)(ws + WS_ASG); F.tok = (GAS int*)(ws + WS_TOK);
    F.G_ = (GAS bf16*)(ws + WS_G); F.WB = (GAS bf16*)(ws + WS_WB); F.WO = (GAS bf16*)(ws + WS_WO); F.WIN = (GAS bf16*)(ws + WS_WIN); F.W1 = (GAS bf16*)(ws + WS_W1); F.W2 = (GAS bf16*)(ws + WS_W2);
    F.HX8 = (GAS unsigned char*)(ws + WS_HX8); F.WIN8 = (GAS unsigned char*)(ws + WS_WIN + (size_t)2304 * 2048); F.WIN8U = (GAS unsigned char*)(ws + WS_WIN + (size_t)768 * 2048); F.WIN8Q = (GAS unsigned char*)(ws + WS_WIN);
    F.HM = (GAS bf16*)(ws + WS_HM); F.HX = (GAS bf16*)(ws + WS_HX); F.Q = (GAS bf16*)(ws + WS_Q); F.K = (GAS bf16*)(ws + WS_K); F.VT = (GAS bf16*)(ws + WS_VT); F.KC = (GAS bf16*)(ws + WS_KC); F.VTC = (GAS bf16*)(ws + WS_VTC);
    F.UT = (GAS bf16*)(ws + WS_UT); F.GATE = (GAS bf16*)(ws + WS_GATE); F.ATT = (GAS bf16*)(ws + WS_ATT); F.MM = (GAS bf16*)(ws + WS_MM); F.ACT = (GAS bf16*)(ws + WS_ACT); F.YB = (GAS bf16*)(ws + WS_YB); F.HYT = (GAS bf16*)(ws + WS_HYT);
    for (int u = F.tid; u < (LDS_BYTES - LDSCTL_OFF) / 4; u += NWAVES * 64) ((LAS unsigned*)(F.lds + LDSCTL_OFF))[u] = 0u;
    __syncthreads();
    XcdBarrier bar; bar.bar = (unsigned*)(F.ctl + CW_BAR); bar.x = 0; bar.st = nullptr;
    if (N_LAUNCHES == 1) bar = xcd_barrier_post((unsigned*)(F.ctl + CW_BAR), F.MISC + 8);
#define GRID_BAR() do { if (N_LAUNCHES == 1) { if (PROBE_SPIN == 20 || PROBE_SPIN == 21 + nbar_) pt0_ = rt(); xcd_barrier(bar); if (PROBE_SPIN == 20 || PROBE_SPIN == 21 + nbar_) ptacc_ += rt() - pt0_; ++nbar_; } } while (0)
    const int lo = args.ph_lo, hi = args.ph_hi;
#ifndef PHMASK
#define PHMASK 0x3ff
#endif
#define IN(k) (((PHMASK >> (k)) & 1) && lo <= (k) && (k) < hi)
#define BOTH(k) (IN(k) && IN((k) + 1))
#define FRESH() do { F.lane = pg8::lane_id_v(); F.tid = F.wave * 64 + F.lane; } while (0)
    const int bx = (int)blockIdx.x;
    unsigned long long pt0_ = 0, ptacc_ = 0; F.pt0 = 0; F.ptacc = 0; int nbar_ = 0;
#define PT_BEGIN(k) do { if (PROBE_SPIN == (k)) pt0_ = rt(); } while (0)
#define PT_END(k) do { if (PROBE_SPIN == (k)) ptacc_ += rt() - pt0_; } while (0)

    if (IN(0)) { FRESH(); PT_BEGIN(0); p0_prologue(F); if (IN(2)) GRID_BAR(); PT_END(0); }
    if (IN(2)) { FRESH();
        pg8::Gemm g{(const bf16*)F.HX, (const bf16*)F.WIN, 1024, F.wave}; PT_BEGIN(2);
#if U8
        { pg8::Gemm g8u{(const bf16*)F.HX8, (const bf16*)F.WIN8U, 512, F.wave}; SchedPlain S; S.so.init(128, 6, F.G, bx); EpiUT E{F.UT, 1.f / 256.f, 0};
          pg8::gemm_phase<EpiUT, SchedPlain, true, false, true>(F.lds, g8u, S, E); }
#else
        { SchedUhy S; S.so.init(128, 6, F.G, bx); EpiUT E{F.UT, 1.f, 3}; pg8::gemm_phase<EpiUT, SchedUhy, true, false>(F.lds, g, S, E); }
#endif
        FRESH();
        { pg8::Gemm g8{(const bf16*)F.HX8, (const bf16*)F.WIN8, 512, F.wave}; SchedPlain S; S.so.init(128, 8, F.G, bx); EpiGate8 E{F.GATE};
          pg8::gemm_phase<EpiGate8, SchedPlain, true, false, true>(F.lds, g8, S, E); }
        FRESH();
        { SchedInProj S; S.so.init(128, 3, F.G, bx); S.G = F.G; S.c = bx; EpiInProj E{F.Q, F.K, F.VT, F.KC, F.VTC, F.rope};
#if Q8
          pg8::Gemm g8q{(const bf16*)F.HX8, (const bf16*)F.WIN8Q, 512, F.wave}; pg8::gemm_phase<EpiInProj, SchedInProj, true, false, true>(F.lds, g8q, S, E); }
#else
          pg8::gemm_phase<EpiInProj, SchedInProj, true, false>(F.lds, g, S, E); }
#endif
        if (BOTH(2)) GRID_BAR(); PT_END(2);
    }
    if (IN(3)) { FRESH();
        PT_BEGIN(3); for (int u = bx; u < 512; u += F.G) attn_unit(F, u >> 5, (u >> 4) & 1, u & 15); PT_END(3);
        FRESH(); PT_BEGIN(10); for (int ch = F.vcu; ch < 512; ch += F.G) hyena_channel(F, ch);
        if (BOTH(3)) GRID_BAR(); PT_END(10);
    }
    if (IN(4)) { FRESH();
        PT_BEGIN(4); hyt_transpose(F); GRID_BAR(); PT_END(4);
        pg8::Gemm g{(const bf16*)F.ATT, (const bf16*)F.WB, M8 ? 256 : 512, F.wave}; SchedPair S; S.so.init(128, 4, F.G, bx);
        EpiMerge E{F.GATE, F.MM};
        PT_BEGIN(17); pg8::gemm_phase<EpiMerge, SchedPair, true, false, M8 != 0>(F.lds, g, S, E);
        if (BOTH(4)) GRID_BAR(); PT_END(17);
    }
    if (IN(5)) { FRESH();
        pg8::Gemm g{(const bf16*)F.MM, (const bf16*)F.WO, 1024, F.wave}; SchedPlain S; S.so.init(128, 4, F.G, bx);
        EpiV1 E{F.x, F.modF, F.V1};
        PT_BEGIN(5); pg8::gemm_phase<EpiV1, SchedPlain, true, false>(F.lds, g, S, E);
        if (BOTH(5)) GRID_BAR(); PT_END(5);
    }
    if (IN(6)) { FRESH(); PT_BEGIN(6); p6_route(F); if (BOTH(6)) GRID_BAR(); PT_END(6); }
    if (IN(7)) { FRESH();
        moe_tables(F);
        pg8::Gemm g{(const bf16*)F.HM, (const bf16*)F.W1, 512, F.wave}; SchedMoe S{(const LAS int*)(F.lds + TP_OFF), F.tok, 8, F.G, bx};
        EpiAct E{F.eb1, F.ACT};
        PT_BEGIN(7); pg8::gemm_phase<EpiAct, SchedMoe, true, true, true>(F.lds, g, S, E);
        if (BOTH(7)) GRID_BAR(); PT_END(7);
    }
    if (IN(8)) { FRESH();
        moe_tables(F);
        pg8::Gemm g{(const bf16*)F.ACT, (const bf16*)F.W2, 512, F.wave}; SchedMoe S{(const LAS int*)(F.lds + TP_OFF), F.tok, 4, F.G, bx};
        EpiYb E{F.eb2, F.YB};
        PT_BEGIN(8); pg8::gemm_phase<EpiYb, SchedMoe, true, false, true>(F.lds, g, S, E);
        if (BOTH(8)) GRID_BAR(); PT_END(8);
    }
    if (IN(9)) { FRESH(); PT_BEGIN(9); moe_tables(F); p9_final(F); PT_END(9); }
#ifdef ABL_VAR
    if (IN(9)) { GRID_BAR(); FRESH();
#ifdef ABL_STAGGER
        { const unsigned long long t0s = rt(), dl = (unsigned long long)((bx >> 3) & 3) * ABL_STAGGER; while (rt() - t0s < dl) __builtin_amdgcn_s_sleep(4); }
#endif
        pg8::Gemm g{(const bf16*)F.ACT, (const bf16*)F.W2, 512, F.wave}; SchedMoe S{(const LAS int*)(F.lds + TP_OFF), F.tok, 4, F.G, bx};
#if defined(ABL_X16)
        EpiYbX E{F.eb2, F.YB, ABL_EPI};
        pg8::gemm_phase<EpiYbX, SchedMoe, true, false, true, ABL_VAR>(F.lds, g, S, E); }
#elif defined(ABL_WIDE)
        EpiYbW E{F.eb2, F.YB, ABL_EPI};
        pg8::gemm_phase<EpiYbW, SchedMoe, true, false, true, ABL_VAR>(F.lds, g, S, E); }
#else
        EpiYb E{F.eb2, F.YB, ABL_EPI};
        pg8::gemm_phase<EpiYb, SchedMoe, true, false, true, ABL_VAR>(F.lds, g, S, E); }
#endif
#endif
    if (PROBE_SPIN >= 0 && bx == 0) { const unsigned long long t0_ = rt(); const unsigned long long gacc_ = (PROBE_SPIN == 18 || PROBE_SPIN == 19) ? *(volatile LAS unsigned long long*)(F.lds + 153600) : 0ull; while (rt() - t0_ < ptacc_ + F.ptacc + gacc_) __builtin_amdgcn_s_sleep(8); }
#undef IN
#undef BOTH
#undef GRID_BAR
}

extern "C" void kernel_launch(void* const* d_in, const int* in_sizes, int n_in, void* d_out, int out_size, void* d_ws, size_t ws_size, hipStream_t stream) {
    static int grid = 0;
    if (grid == 0) {
        if (n_in != 29 || in_sizes[0] != T * D || out_size != T * D || ws_size < WS_END) { fprintf(stderr, "kernel_launch: unexpected shapes (n_in %d, in0 %d, out %d, ws %zu); nothing launched\n", n_in, n_in > 0 ? in_sizes[0] : -1, out_size, ws_size); grid = -1; return; }
        int dev = 0, cus = 0, per_cu = 0;
        if (hipGetDevice(&dev) != hipSuccess || hipDeviceGetAttribute(&cus, hipDeviceAttributeMultiprocessorCount, dev) != hipSuccess) { grid = -1; return; }
        if (hipFuncSetAttribute((const void*)mk_fwd, hipFuncAttributeMaxDynamicSharedMemorySize, LDS_BYTES) != hipSuccess) { fprintf(stderr, "kernel_launch: hipFuncSetAttribute failed\n"); grid = -1; return; }
        if (hipOccupancyMaxActiveBlocksPerMultiprocessor(&per_cu, (const void*)mk_fwd, NWAVES * 64, LDS_BYTES) != hipSuccess || per_cu < 1) { fprintf(stderr, "kernel_launch: occupancy query reports %d workgroups per CU\n", per_cu); }
        (void)hipGetLastError();
        grid = cus < 256 ? cus : 256;
    }
    if (grid < 0) return;
    if (hipMemsetAsync((char*)d_ws + WS_CTL, 0, CTL_ZERO_BYTES, stream) != hipSuccess) return;
    Args a{};
    for (int i = 0; i < 29; ++i) a.in[i] = (const float*)d_in[i];
    a.out = (float*)d_out; a.ws = (unsigned char*)d_ws;
    if (N_LAUNCHES == 1) { a.ph_lo = 0; a.ph_hi = NPH; hipLaunchKernelGGL(mk_fwd, dim3(grid), dim3(NWAVES * 64), LDS_BYTES, stream, a); }
    else for (int p = 0; p < NPH; ++p) { a.ph_lo = p; a.ph_hi = p + 1; hipLaunchKernelGGL(mk_fwd, dim3(grid), dim3(NWAVES * 64), LDS_BYTES, stream, a); }
}
```
